# Optimizing an MI355X kernel written in HIP

```python
import math
import jax, jax.numpy as jnp
from jax import lax
import numpy as np

D_MODEL = 2048
BATCH = 2
SEQ = 8192
DEPTH = 2
DEC_BATCH = 8
DEC_SEQ = 4096
PAST_LEN = 128

GRID_W = 64
MIX_W = D_MODEL
GROUP_W = MIX_W // 4
D_FF = 5632
NORM_EPS = 1e-6

MLSTM_HEADS = 4
MLSTM_DH = GROUP_W // MLSTM_HEADS
MLSTM_CHUNK = 64
MLSTM_CONV = 5
MLSTM_GATES = 4 * MLSTM_HEADS

DIFF_HEADS = 4
DIFF_DH = GROUP_W // (2 * DIFF_HEADS)
Q_BLOCK = 128
ROPE_THETA = 10000.0

NA_HEADS = 8
NA_DH = GROUP_W // NA_HEADS
NA_WIN_ROWS = 8
NA_WIN_W = 16

S5_GROUP_CH = 16
S5_GROUPS = GROUP_W // S5_GROUP_CH
S5_STATE = 64

SPLIT_SIZES = (GROUP_W, GROUP_W, GROUP_W, GROUP_W, MLSTM_GATES, GROUP_W, GROUP_W, GROUP_W, GROUP_W, GROUP_W, GROUP_W, GROUP_W)
IN_W = 11 * GROUP_W + MLSTM_GATES

kernel_name = 'hybrid_parallel_head_encoder'


def rmsnorm(x, g):
    xf = x.astype(jnp.float32)
    y = xf * lax.rsqrt(jnp.mean(xf * xf, axis=-1, keepdims=True) + NORM_EPS)
    return (y * g.astype(jnp.float32)).astype(x.dtype)


def swiglu(x, wg, wu, wd):
    return (jax.nn.silu(x @ wg) * (x @ wu)) @ wd


def rope_tables(T):
    inv = 1.0 / (ROPE_THETA ** (jnp.arange(0, DIFF_DH, 2, dtype=jnp.float32) / DIFF_DH))
    ang = jnp.arange(T, dtype=jnp.float32)[:, None] * inv[None, :]
    return jnp.cos(ang), jnp.sin(ang)


def apply_rope(x, cos, sin):
    half = DIFF_DH // 2
    xf = x.astype(jnp.float32)
    x1, x2 = xf[..., :half], xf[..., half:]
    c = cos[None, :, None, None, :]
    s = sin[None, :, None, None, :]
    return jnp.concatenate([x1 * c - x2 * s, x2 * c + x1 * s], axis=-1).astype(x.dtype)


def centred_dwconv(x, w, b):
    K = w.shape[0]
    pad = K // 2
    T = x.shape[1]
    xp = jnp.pad(x, ((0, 0), (pad, pad), (0, 0)))
    acc = xp[:, 0:T] * w[0]
    for j in range(1, K):
        acc = acc + xp[:, j:j + T] * w[j]
    return acc + b


def mlstm_direction(q, k, v, ig, fg):
    Bsz, H, T, d = q.shape
    L = MLSTM_CHUNK
    nc = T // L
    qc = q.reshape(Bsz, H, nc, L, d)
    kc = k.reshape(Bsz, H, nc, L, d)
    vc = v.reshape(Bsz, H, nc, L, d)
    ic = ig.reshape(Bsz, H, nc, L)
    b = jnp.cumsum(jax.nn.log_sigmoid(fg).reshape(Bsz, H, nc, L), axis=-1)
    g = b[..., -1]
    a = g[..., None] - b + ic

    def step(carry, xs):
        C, n, m = carry
        k_j, v_j, a_j, g_j = xs
        m_new = jnp.maximum(g_j + m, jnp.max(a_j, axis=-1))
        decay = jnp.exp(g_j + m - m_new)
        w = jnp.exp(a_j - m_new[..., None])
        C_new = decay[..., None, None] * C + jnp.einsum('bhl,bhld,bhle->bhde', w, k_j, v_j)
        n_new = decay[..., None] * n + jnp.einsum('bhl,bhld->bhd', w, k_j)
        return (C_new, n_new, m_new), (C, n, m)

    init = (jnp.zeros((Bsz, H, d, d), jnp.float32), jnp.zeros((Bsz, H, d), jnp.float32), jnp.zeros((Bsz, H), jnp.float32))
    xs = (jnp.moveaxis(kc, 2, 0), jnp.moveaxis(vc, 2, 0), jnp.moveaxis(a, 2, 0), jnp.moveaxis(g, 2, 0))
    _, (C_prev, n_prev, m_prev) = lax.scan(step, init, xs)
    C_prev = jnp.moveaxis(C_prev, 0, 2)
    n_prev = jnp.moveaxis(n_prev, 0, 2)
    m_prev = jnp.moveaxis(m_prev, 0, 2)

    inter = b + m_prev[..., None]
    mask = jnp.tril(jnp.ones((L, L), dtype=bool))
    dlog = jnp.where(mask, b[..., :, None] - b[..., None, :] + ic[..., None, :], -jnp.inf)
    m_t = jnp.maximum(inter, jnp.max(dlog, axis=-1))
    S = jnp.einsum('bhnld,bhnsd->bhnls', qc, kc) * jnp.exp(dlog - m_t[..., None])
    s_inter = jnp.exp(inter - m_t)
    num = s_inter[..., None] * jnp.einsum('bhnld,bhnde->bhnle', qc, C_prev) + jnp.einsum('bhnls,bhnse->bhnle', S, vc)
    den = jnp.abs(s_inter * jnp.einsum('bhnld,bhnd->bhnl', qc, n_prev) + jnp.sum(S, axis=-1))
    den = jnp.maximum(den, jnp.exp(-m_t))
    return (num / den[..., None]).reshape(Bsz, H, T, d)


def mlstm_mixer(q, k, v, o, gates, conv_w, conv_b, gate_bias, norm_g):
    Bsz, T, _ = q.shape
    qk = jax.nn.silu(centred_dwconv(jnp.concatenate([q, k], axis=-1), conv_w, conv_b))
    q, k = qk[..., :GROUP_W], qk[..., GROUP_W:]

    def heads(t):
        return t.astype(jnp.float32).reshape(Bsz, T, MLSTM_HEADS, MLSTM_DH).transpose(0, 2, 1, 3)

    qh, kh, vh = heads(q), heads(k) * (MLSTM_DH ** -0.5), heads(v)
    gt = (gates.astype(jnp.float32) + gate_bias.astype(jnp.float32)).transpose(0, 2, 1)
    ig_f, fg_f, ig_b, fg_b = jnp.split(gt, 4, axis=1)
    h_f = mlstm_direction(qh, kh, vh, ig_f, fg_f)
    fl = lambda t: jnp.flip(t, axis=2)
    h_b = fl(mlstm_direction(fl(qh), fl(kh), fl(vh), fl(ig_b), fl(fg_b)))
    h = (h_f + h_b).transpose(0, 2, 1, 3)
    h = h * lax.rsqrt(jnp.mean(h * h, axis=-1, keepdims=True) + NORM_EPS)
    h = h * norm_g.astype(jnp.float32).reshape(MLSTM_HEADS, MLSTM_DH)
    h = h.reshape(Bsz, T, GROUP_W)
    return (h * jax.nn.sigmoid(o.astype(jnp.float32))).astype(o.dtype)


def diff_attention(q, k, v, lam_params, norm_g, cos, sin, layer_idx):
    Bsz, T, _ = q.shape
    qh = apply_rope(q.reshape(Bsz, T, DIFF_HEADS, 2, DIFF_DH), cos, sin)
    kh = apply_rope(k.reshape(Bsz, T, DIFF_HEADS, 2, DIFF_DH), cos, sin)
    vh = v.reshape(Bsz, T, DIFF_HEADS, 2 * DIFF_DH)
    lam_init = 0.8 - 0.6 * math.exp(-0.3 * layer_idx)
    lp = lam_params.astype(jnp.float32)
    lam = jnp.exp(jnp.sum(lp[0] * lp[1])) - jnp.exp(jnp.sum(lp[2] * lp[3])) + lam_init
    scale = DIFF_DH ** -0.5
    nb = T // Q_BLOCK
    qb = jnp.moveaxis(qh.reshape(Bsz, nb, Q_BLOCK, DIFF_HEADS, 2, DIFF_DH), 1, 0)

    def block(q_blk):
        s = jnp.einsum('bqhid,bkhid->bhiqk', q_blk, kh).astype(jnp.float32) * scale
        p = jax.nn.softmax(s, axis=-1)
        w = p[:, :, 0] - lam * p[:, :, 1]
        return jnp.einsum('bhqk,bkhe->bqhe', w.astype(vh.dtype), vh)

    out = lax.map(block, qb)
    out = jnp.moveaxis(out, 0, 1).reshape(Bsz, T, DIFF_HEADS, 2 * DIFF_DH)
    out = rmsnorm(out, norm_g) * (1.0 - lam_init)
    return out.reshape(Bsz, T, GROUP_W)


def neighbourhood_attention(q, k, v, rpb):
    Bsz, T, _ = q.shape
    rows = T // GRID_W
    kr = min(NA_WIN_ROWS, rows)
    qg = q.reshape(Bsz, rows, GRID_W, NA_HEADS, NA_DH)
    kg = k.reshape(Bsz, rows, GRID_W, NA_HEADS, NA_DH)
    vg = v.reshape(Bsz, rows, GRID_W, NA_HEADS, NA_DH)
    r_idx = jnp.arange(rows)
    row_start = jnp.clip(r_idx - kr // 2, 0, rows - kr)
    c_idx = jnp.arange(GRID_W)
    col_start = jnp.clip(c_idx - NA_WIN_W // 2, 0, GRID_W - NA_WIN_W)
    col_idx = col_start[:, None] + jnp.arange(NA_WIN_W)[None, :]
    col_off = col_idx - c_idx[:, None] + (NA_WIN_W - 1)
    col_bias = rpb.astype(jnp.float32)[:, :, col_off]
    scale = NA_DH ** -0.5

    def row_block(args):
        r, rs, q_r = args
        k_rows = lax.dynamic_slice_in_dim(kg, rs, kr, axis=1)
        v_rows = lax.dynamic_slice_in_dim(vg, rs, kr, axis=1)
        k_sel = k_rows[:, :, col_idx]
        v_sel = v_rows[:, :, col_idx]
        row_off = rs + jnp.arange(kr) - r + (NA_WIN_ROWS - 1)
        bias = col_bias[:, row_off].transpose(0, 2, 1, 3)
        s = jnp.einsum('bchd,bkcwhd->bhckw', q_r, k_sel).astype(jnp.float32) * scale + bias[None]
        p = jax.nn.softmax(s.reshape(Bsz, NA_HEADS, GRID_W, kr * NA_WIN_W), axis=-1)
        p = p.reshape(Bsz, NA_HEADS, GRID_W, kr, NA_WIN_W)
        return jnp.einsum('bhckw,bkcwhd->bchd', p.astype(v_sel.dtype), v_sel)

    out = lax.map(row_block, (r_idx, row_start, jnp.moveaxis(qg, 1, 0)))
    return jnp.moveaxis(out, 0, 1).reshape(Bsz, T, GROUP_W)


def ssm_combine(e1, e2):
    a1, b1 = e1
    a2, b2 = e2
    return a2 * a1, a2 * b1 + b2


def s5_mixer(u, lam_re, lam_im, log_step, b_re, b_im, c_re, c_im, d_skip, glu_w, glu_b):
    Bsz, T, _ = u.shape
    f32 = jnp.float32
    u_t = jnp.moveaxis(u.astype(f32).reshape(Bsz, T, S5_GROUPS, S5_GROUP_CH), 1, 0)
    u_c = u_t.astype(jnp.complex64)
    b_mat = lax.complex(b_re.astype(f32), b_im.astype(f32))
    c_mat = lax.complex(c_re.astype(f32), c_im.astype(f32))

    def run(direction, seq):
        lam = lax.complex(lam_re[direction].astype(f32), lam_im[direction].astype(f32))
        step = jnp.exp(log_step[direction].astype(f32))[:, None]
        lam_bar = jnp.exp(lam * step)
        b_bar = ((lam_bar - 1.0) / lam)[..., None] * b_mat
        bu = jnp.einsum('tbgc,gpc->tbgp', seq, b_bar)
        a = jnp.broadcast_to(lam_bar[None, None], (T, 1, S5_GROUPS, S5_STATE))
        _, states = lax.associative_scan(ssm_combine, (a, bu), axis=0)
        return states

    s = run(0, u_c) + jnp.flip(run(1, jnp.flip(u_c, axis=0)), axis=0)
    y = jnp.einsum('tbgp,gcp->tbgc', s, c_mat).real + d_skip.astype(f32) * u_t
    y = jnp.moveaxis(y, 0, 1).reshape(Bsz, T, GROUP_W)
    z = jax.nn.gelu(y)
    out = z * jax.nn.sigmoid(z @ glu_w.astype(f32) + glu_b.astype(f32))
    return out.astype(u.dtype)


def encoder_trunk(x, w):
    T = x.shape[1]
    cos, sin = rope_tables(T)
    split_points = [int(p) for p in np.cumsum(SPLIT_SIZES)[:-1]]
    for l in range(DEPTH):
        x = x + 0.5 * swiglu(rmsnorm(x, w['ffn1_norm'][l]), w['ffn1_w_gate'][l], w['ffn1_w_up'][l], w['ffn1_w_down'][l])
        h = rmsnorm(x, w['mix_norm'][l])
        proj = h @ w['w_in'][l]
        mq, mk, mv, mo, mg, dq, dk, dv, nq, nk, nv, su = jnp.split(proj, split_points, axis=-1)
        y_a = mlstm_mixer(mq, mk, mv, mo, mg, w['mlstm_conv_w'][l], w['mlstm_conv_b'][l], w['mlstm_gate_bias'][l], w['mlstm_norm'][l])
        y_b = diff_attention(dq, dk, dv, w['diff_lambda'][l], w['diff_norm'][l], cos, sin, l)
        y_c = neighbourhood_attention(nq, nk, nv, w['na_rpb'][l])
        y_d = s5_mixer(su, w['s5_lambda_re'][l], w['s5_lambda_im'][l], w['s5_log_step'][l], w['s5_b_re'][l], w['s5_b_im'][l], w['s5_c_re'][l], w['s5_c_im'][l], w['s5_d'][l], w['s5_glu_w'][l], w['s5_glu_b'][l])
        mixed = jnp.concatenate([y_a, y_b.astype(x.dtype), y_c.astype(x.dtype), y_d], axis=-1)
        x = x + mixed @ w['w_out'][l]
        x = x + 0.5 * swiglu(rmsnorm(x, w['ffn2_norm'][l]), w['ffn2_w_gate'][l], w['ffn2_w_up'][l], w['ffn2_w_down'][l])
    return rmsnorm(x, w['final_norm'])


def setup_inputs(seed: int = 0) -> dict:
    key = jax.random.key(seed)
    ks = jax.random.split(key, 40)
    f32 = jnp.float32
    nrm = lambda k, shape, scale: jax.random.normal(k, shape, f32) * scale
    gain = lambda k, shape: 1.0 + 0.02 * jax.random.normal(k, shape, f32)
    ib = nrm(ks[10], (DEPTH, 2, MLSTM_HEADS), 0.1)
    fb = jnp.linspace(3.0, 6.0, MLSTM_HEADS, dtype=f32)[None, None, :] + nrm(ks[11], (DEPTH, 2, MLSTM_HEADS), 0.1)
    mlstm_gate_bias = jnp.concatenate([ib[:, 0], fb[:, 0], ib[:, 1], fb[:, 1]], axis=-1)
    s5_lambda_im = math.pi * jnp.arange(S5_STATE, dtype=f32) + nrm(ks[16], (DEPTH, 2, S5_GROUPS, S5_STATE), 0.01)
    return {
        'x_prompt': nrm(ks[0], (BATCH, SEQ, D_MODEL), 1.0),
        'x_sample': nrm(ks[1], (DEC_BATCH, DEC_SEQ, D_MODEL), 1.0),
        'ffn1_norm': gain(ks[2], (DEPTH, D_MODEL)),
        'ffn1_w_gate': nrm(ks[3], (DEPTH, D_MODEL, D_FF), D_MODEL ** -0.5),
        'ffn1_w_up': nrm(ks[4], (DEPTH, D_MODEL, D_FF), D_MODEL ** -0.5),
        'ffn1_w_down': nrm(ks[5], (DEPTH, D_FF, D_MODEL), D_FF ** -0.5),
        'mix_norm': gain(ks[6], (DEPTH, D_MODEL)),
        'w_in': nrm(ks[7], (DEPTH, D_MODEL, IN_W), D_MODEL ** -0.5),
        'mlstm_conv_w': nrm(ks[8], (DEPTH, MLSTM_CONV, 2 * GROUP_W), MLSTM_CONV ** -0.5),
        'mlstm_conv_b': nrm(ks[9], (DEPTH, 2 * GROUP_W), 0.02),
        'mlstm_gate_bias': mlstm_gate_bias,
        'mlstm_norm': gain(ks[12], (DEPTH, GROUP_W)),
        'diff_lambda': nrm(ks[13], (DEPTH, 4, DIFF_DH), 0.1),
        'diff_norm': gain(ks[14], (DEPTH, 2 * DIFF_DH)),
        'na_rpb': nrm(ks[15], (DEPTH, NA_HEADS, 2 * NA_WIN_ROWS - 1, 2 * NA_WIN_W - 1), 0.02),
        's5_lambda_re': -0.5 + nrm(ks[17], (DEPTH, 2, S5_GROUPS, S5_STATE), 0.01),
        's5_lambda_im': s5_lambda_im,
        's5_log_step': jax.random.uniform(ks[18], (DEPTH, 2, S5_GROUPS), f32, math.log(1e-3), math.log(1e-1)),
        's5_b_re': nrm(ks[19], (DEPTH, S5_GROUPS, S5_STATE, S5_GROUP_CH), (2 * S5_GROUP_CH) ** -0.5),
        's5_b_im': nrm(ks[20], (DEPTH, S5_GROUPS, S5_STATE, S5_GROUP_CH), (2 * S5_GROUP_CH) ** -0.5),
        's5_c_re': nrm(ks[21], (DEPTH, S5_GROUPS, S5_GROUP_CH, S5_STATE), (2 * S5_STATE) ** -0.5),
        's5_c_im': nrm(ks[22], (DEPTH, S5_GROUPS, S5_GROUP_CH, S5_STATE), (2 * S5_STATE) ** -0.5),
        's5_d': nrm(ks[23], (DEPTH, S5_GROUPS, S5_GROUP_CH), 1.0),
        's5_glu_w': nrm(ks[24], (DEPTH, GROUP_W, GROUP_W), GROUP_W ** -0.5),
        's5_glu_b': nrm(ks[25], (DEPTH, GROUP_W), 0.02),
        'w_out': nrm(ks[26], (DEPTH, MIX_W, D_MODEL), MIX_W ** -0.5),
        'ffn2_norm': gain(ks[27], (DEPTH, D_MODEL)),
        'ffn2_w_gate': nrm(ks[28], (DEPTH, D_MODEL, D_FF), D_MODEL ** -0.5),
        'ffn2_w_up': nrm(ks[29], (DEPTH, D_MODEL, D_FF), D_MODEL ** -0.5),
        'ffn2_w_down': nrm(ks[30], (DEPTH, D_FF, D_MODEL), D_FF ** -0.5),
        'final_norm': gain(ks[31], (D_MODEL,)),
    }


def reference(x_prompt, x_sample, ffn1_norm, ffn1_w_gate, ffn1_w_up, ffn1_w_down, mix_norm, w_in, mlstm_conv_w, mlstm_conv_b, mlstm_gate_bias, mlstm_norm, diff_lambda, diff_norm, na_rpb, s5_lambda_re, s5_lambda_im, s5_log_step, s5_b_re, s5_b_im, s5_c_re, s5_c_im, s5_d, s5_glu_w, s5_glu_b, w_out, ffn2_norm, ffn2_w_gate, ffn2_w_up, ffn2_w_down, final_norm):
    weights = dict(ffn1_norm=ffn1_norm, ffn1_w_gate=ffn1_w_gate, ffn1_w_up=ffn1_w_up, ffn1_w_down=ffn1_w_down,
                   mix_norm=mix_norm, w_in=w_in, mlstm_conv_w=mlstm_conv_w, mlstm_conv_b=mlstm_conv_b,
                   mlstm_gate_bias=mlstm_gate_bias, mlstm_norm=mlstm_norm, diff_lambda=diff_lambda, diff_norm=diff_norm,
                   na_rpb=na_rpb, s5_lambda_re=s5_lambda_re, s5_lambda_im=s5_lambda_im, s5_log_step=s5_log_step,
                   s5_b_re=s5_b_re, s5_b_im=s5_b_im, s5_c_re=s5_c_re, s5_c_im=s5_c_im, s5_d=s5_d,
                   s5_glu_w=s5_glu_w, s5_glu_b=s5_glu_b, w_out=w_out, ffn2_norm=ffn2_norm, ffn2_w_gate=ffn2_w_gate,
                   ffn2_w_up=ffn2_w_up, ffn2_w_down=ffn2_w_down, final_norm=final_norm)
    y_prompt = encoder_trunk(x_prompt, weights)
    y_sample = encoder_trunk(x_sample, weights)
    return (y_prompt, y_sample)
```

```cpp
#include <hip/hip_runtime.h>
#include <cstdio>
#include <cstdint>

#define GAS __attribute__((address_space(1)))
#define LAS __attribute__((address_space(3)))
typedef unsigned short bf16_t;
typedef short bf16x8 __attribute__((ext_vector_type(8)));
typedef float f32x4 __attribute__((ext_vector_type(4)));
typedef float f32x2 __attribute__((ext_vector_type(2)));
typedef float f32x16 __attribute__((ext_vector_type(16)));
typedef unsigned u32x4 __attribute__((ext_vector_type(4)));
typedef unsigned u32x2 __attribute__((ext_vector_type(2)));

constexpr int DM = 2048, DFF = 5632, DEPTH = 2, GWID = 512;
constexpr int T_P = 8192, B_P = 2, T_S = 4096, B_S = 8;
constexpr int M_P = B_P * T_P, M_S = B_S * T_S, MTOT = M_P + M_S;
constexpr float NORM_EPS = 1e-6f;
constexpr int NWAVES = 8;

constexpr size_t MiB = 1u << 20;
constexpr size_t WS_CTL = 0, CTL_ZERO_BYTES = 32 * 1024;
constexpr size_t WS_ROPE = 1 * MiB;
constexpr size_t WS_W = 4 * MiB;
constexpr size_t W_GU1 = WS_W, W_D1 = W_GU1 + 44 * MiB, W_GU2 = W_D1 + 22 * MiB, W_D2 = W_GU2 + 44 * MiB;
constexpr size_t W_IN = W_D2 + 22 * MiB, W_OUT = W_IN + 23 * MiB, W_GLU = W_OUT + 8 * MiB, W_S5MR = W_GLU + 1 * MiB, W_S5P = W_S5MR + 24 * MiB, W_END = W_S5P + 8 * MiB;
constexpr size_t WS_XN = 200 * MiB;
constexpr size_t WS_BIG = 392 * MiB;
constexpr size_t WS_SPARE = 920 * MiB;
constexpr size_t WS_END = 1016 * MiB;
static_assert(W_END <= WS_XN, "weights fit");
constexpr int CW_BAR = 4096;
static_assert((CW_BAR + 3456) * 4 <= (int)CTL_ZERO_BYTES, "barrier words inside the per-call memset");

constexpr int RING_BYTES = 131072;
constexpr int LDSCTL_OFF = RING_BYTES, MISC_OFF = LDSCTL_OFF + 320;
constexpr int LDS_BYTES = 147456;

#define RLX_AGENT __ATOMIC_RELAXED, __HIP_MEMORY_SCOPE_AGENT
#define LDS_WAIT() asm volatile("s_waitcnt lgkmcnt(0)" ::: "memory")
#define VM_WAIT() asm volatile("s_waitcnt vmcnt(0)" ::: "memory")
__device__ __forceinline__ unsigned f2bf(float f) { unsigned u = __builtin_bit_cast(unsigned, f); return (u + 0x7fffu + ((u >> 16) & 1u)) >> 16; }
__device__ __forceinline__ unsigned pk2(float lo, float hi) { return f2bf(lo) | (f2bf(hi) << 16); }
__device__ __forceinline__ float bf2f(unsigned short b) { return __builtin_bit_cast(float, (unsigned)b << 16); }
__device__ __forceinline__ unsigned cvt_pk_bf16(float lo, float hi) { unsigned r; asm volatile("v_cvt_pk_bf16_f32 %0, %1, %2" : "=v"(r) : "v"(lo), "v"(hi)); return r; }
__device__ __forceinline__ float wave_sum(float v) {
#pragma unroll
    for (int o = 1; o < 64; o <<= 1) v += __shfl_xor(v, o);
    return v;
}
__device__ __forceinline__ int opaque_tid(int wave) { int l_; asm volatile("v_mbcnt_lo_u32_b32 %0, -1, 0\n\tv_mbcnt_hi_u32_b32 %0, -1, %0" : "=v"(l_)); return wave * 64 + l_; }
__device__ __forceinline__ float fast_silu(float g) { return g * __builtin_amdgcn_rcpf(1.f + __expf(-g)); }

namespace pg8 {
constexpr int BM = 256, BK = 64, HALF = 128, HTB = HALF * BK * 2, STAGE_BYTES = 8 * HTB, NXCD = 8, WGM = 8;
__host__ __device__ __forceinline__ int lds_byte(int r, int c) { const int st = (r >> 4) * 2 + (c >> 5), rr = r & 15, cc = c & 31, ob = rr * 64 + cc * 2; return st * 1024 + (ob ^ (((ob >> 9) & 1) << 5)); }
__host__ __device__ __forceinline__ void stage_rc(int b, int& R, int& C) { const int st = b / 1024, sb = b % 1024, swz = sb ^ (((sb >> 9) & 1) << 5); R = (st >> 1) * 16 + swz / 64; C = (st & 1) * 32 + (swz % 64) / 2; }
__host__ __device__ __forceinline__ int perm32(int rho) { const int n = rho >> 4, i = rho & 15; return 8 * (i >> 2) + 4 * n + (i & 3); }

struct Unit { int pm, pn; };
struct Gemm { const bf16_t* A; const bf16_t* Bt; int K, lda, ldb; };

struct StaticOrder {
    int nM, nN, nwg, G, c, wgm, rev;
    __host__ __device__ void init(int nM_, int nN_, int G_, int c_, int wgm_ = WGM, int rev_ = 0) { nM = nM_; nN = nN_; nwg = nM * nN; G = G_; c = c_; wgm = wgm_; rev = rev_; }
    __host__ __device__ bool next(int i, Unit& u) const {
        const long L = (long)i * G + c; if (L >= nwg) return false;
        int wgid = rev ? nwg - 1 - (int)L : (int)L;
        const int nig = wgm * nN, gid = wgid / nig, fm = gid * wgm, gsz = (nM - fm) < wgm ? (nM - fm) : wgm;
        u.pm = fm + ((wgid % nig) % gsz); u.pn = (wgid % nig) / gsz; return true;
    }
    __device__ __forceinline__ void a_ready(const Unit&) const {}
    __device__ __forceinline__ void done(const Unit&) const {}
};

template <class Epi, class Sched, bool ALIGN_EPI = false, bool SP2 = false>
__device__ __forceinline__ void gemm_phase(LAS unsigned char* lds, const Gemm g, const Sched& S, const Epi& E, const int wave0) {
    const int tid = opaque_tid(wave0), wid = wave0, lane = tid & 63, wr = wid >> 2, wc = wid & 3, fr = lane & 15, fq = lane >> 4;
    const int K = g.K, nt = K / BK;
    unsigned voffA[2], voffB[2];
#pragma unroll
    for (int i = 0; i < 2; ++i) { int R, C; stage_rc(tid * 16 + i * 8192, R, C); const int Rb = Epi::PERM ? ((R & ~31) + perm32(R & 31)) : R;
        voffA[i] = (unsigned)(R * g.lda + C) * 2u; voffB[i] = (unsigned)(Rb * g.ldb + C) * 2u; }
    const size_t kstep = (size_t)(BK * 2);
    const size_t hstepA = (size_t)HALF * g.lda * 2, hstepB = (size_t)HALF * g.ldb * 2;
    const size_t tstepA = 2 * hstepA, tstepB = 2 * hstepB;
    const unsigned ldsw = (unsigned)wid * 1024u;
    const int aoff = lds_byte(wr * 64 + fr, fq * 8), boff = lds_byte(wc * 32 + fr, fq * 8);
#define PG8_SA(b, h) (((b) * 2 + (h)) * HTB)
#define PG8_SB(b, h) ((4 + (b) * 2 + (h)) * HTB)
#define PG8_STAGE(bufoff, gbase, voff) do { _Pragma("unroll") for (int _i = 0; _i < 2; ++_i) \
        __builtin_amdgcn_global_load_lds((const unsigned*)((const char*)(gbase) + (voff)[_i]), (LAS unsigned*)(lds + (bufoff) + ldsw + _i * 8192), 16, 0, 0); } while (0)
#define PG8_LDA(dst, b, h) do { _Pragma("unroll") for (int m = 0; m < 4; ++m) _Pragma("unroll") for (int k = 0; k < 2; ++k) dst[m][k] = *(const LAS bf16x8*)(lds + PG8_SA(b, h) + aoff + m * 2048 + k * 1024); } while (0)
#define PG8_LDB(dst, b, h) do { _Pragma("unroll") for (int n = 0; n < 2; ++n) _Pragma("unroll") for (int k = 0; k < 2; ++k) dst[n][k] = *(const LAS bf16x8*)(lds + PG8_SB(b, h) + boff + n * 2048 + k * 1024); } while (0)
#define PG8_MMA(ai, bj, At, Bt) do { __builtin_amdgcn_s_setprio(1); _Pragma("unroll") for (int m = 0; m < 4; ++m) _Pragma("unroll") for (int n = 0; n < 2; ++n) _Pragma("unroll") for (int k = 0; k < 2; ++k) \
        acc[ai][bj][m][n] = __builtin_amdgcn_mfma_f32_16x16x32_bf16(Bt[n][k], At[m][k], acc[ai][bj][m][n], 0, 0, 0); __builtin_amdgcn_s_setprio(0); } while (0)
#define PG8_WAIT_V(n) asm volatile("s_waitcnt vmcnt(" #n ")" ::: "memory")
#define PG8_WAIT_L(n) asm volatile("s_waitcnt lgkmcnt(" #n ")" ::: "memory")
#define PG8_BAR __builtin_amdgcn_s_barrier()
#define PG8_SCHED __builtin_amdgcn_sched_barrier(0)
    Unit cur, nxt; int ui = 0;
    if (!S.next(0, cur)) return;
    f32x4 acc[2][2][4][2];
#pragma unroll
    for (int a = 0; a < 2; ++a)
#pragma unroll
        for (int b = 0; b < 2; ++b)
#pragma unroll
            for (int m = 0; m < 4; ++m)
#pragma unroll
                for (int n = 0; n < 2; ++n) acc[a][b][m][n] = (f32x4){0.f, 0.f, 0.f, 0.f};
    bf16x8 At[4][2], B0[2][2], B1[2][2];
    const char* cA = (const char*)g.A + (size_t)cur.pm * tstepA; const char* cB = (const char*)g.Bt + (size_t)cur.pn * tstepB;
    S.a_ready(cur);
    if constexpr (SP2) {
        PG8_STAGE(PG8_SB(0, 0), cB, voffB); PG8_STAGE(PG8_SB(0, 1), cB + hstepB, voffB); PG8_STAGE(PG8_SA(0, 0), cA, voffA); PG8_STAGE(PG8_SA(0, 1), cA + hstepA, voffA);
        if (wr == 1) PG8_BAR;
        PG8_WAIT_V(2); PG8_BAR;
        PG8_STAGE(PG8_SB(1, 0), cB + kstep, voffB); PG8_STAGE(PG8_SA(1, 0), cA + kstep, voffA); PG8_STAGE(PG8_SB(1, 1), cB + hstepB + kstep, voffB);
        PG8_WAIT_V(6); PG8_BAR;
    } else {
        PG8_STAGE(PG8_SB(0, 0), cB, voffB); PG8_STAGE(PG8_SA(0, 0), cA, voffA); PG8_STAGE(PG8_SB(0, 1), cB + hstepB, voffB); PG8_STAGE(PG8_SA(0, 1), cA + hstepA, voffA);
        if (wr == 1) PG8_BAR;
        PG8_WAIT_V(4); PG8_BAR;
        PG8_STAGE(PG8_SB(1, 0), cB + kstep, voffB); PG8_STAGE(PG8_SA(1, 0), cA + kstep, voffA); PG8_STAGE(PG8_SB(1, 1), cB + hstepB + kstep, voffB);
        PG8_WAIT_V(6); PG8_BAR;
    }
    for (;;) {
        const bool has_next = S.next(ui + 1, nxt);
        const char* nA = has_next ? (const char*)g.A + (size_t)nxt.pm * tstepA : cA; const char* nB = has_next ? (const char*)g.Bt + (size_t)nxt.pn * tstepB : cB;
        for (int t = 0; t < nt; t += 2) {
            const bool last = (t == nt - 2);
            const char* a1 = cA + (size_t)(t + 1) * kstep;
            const char* a2 = last ? nA : cA + (size_t)(t + 2) * kstep; const char* b2 = last ? nB : cB + (size_t)(t + 2) * kstep;
            const char* a3 = a2 + kstep; const char* b3 = b2 + kstep;
            if (last && has_next) S.a_ready(nxt);
            if constexpr (SP2) {
            PG8_LDB(B0, 0, 0); PG8_LDB(B1, 0, 1); PG8_SCHED; PG8_LDA(At, 0, 0); PG8_STAGE(PG8_SA(1, 1), a1 + hstepA, voffA);
            PG8_WAIT_V(8); PG8_WAIT_L(0); PG8_BAR; PG8_MMA(0, 0, At, B0); PG8_MMA(0, 1, At, B1); PG8_BAR; PG8_SCHED;
            PG8_LDA(At, 0, 1); PG8_STAGE(PG8_SB(0, 0), b2, voffB); PG8_STAGE(PG8_SB(0, 1), b2 + hstepB, voffB); PG8_STAGE(PG8_SA(0, 0), a2, voffA);
            PG8_WAIT_V(8); PG8_WAIT_L(0); PG8_BAR; PG8_MMA(1, 0, At, B0); PG8_MMA(1, 1, At, B1); PG8_BAR; PG8_SCHED;
            PG8_LDB(B0, 1, 0); PG8_LDB(B1, 1, 1); PG8_SCHED; PG8_LDA(At, 1, 0); PG8_STAGE(PG8_SA(0, 1), a2 + hstepA, voffA);
            PG8_WAIT_V(8); PG8_WAIT_L(0); PG8_BAR; PG8_MMA(0, 0, At, B0); PG8_MMA(0, 1, At, B1); PG8_BAR; PG8_SCHED;
            PG8_LDA(At, 1, 1); PG8_STAGE(PG8_SB(1, 0), b3, voffB); PG8_STAGE(PG8_SB(1, 1), b3 + hstepB, voffB); PG8_STAGE(PG8_SA(1, 0), a3, voffA);
            PG8_WAIT_V(8); PG8_WAIT_L(0); PG8_BAR; PG8_MMA(1, 0, At, B0); PG8_MMA(1, 1, At, B1); PG8_BAR; PG8_SCHED;
            } else {
            PG8_LDB(B0, 0, 0); PG8_SCHED; PG8_LDA(At, 0, 0); PG8_STAGE(PG8_SA(1, 1), a1 + hstepA, voffA);
            PG8_WAIT_L(8); PG8_BAR; PG8_WAIT_L(0); PG8_MMA(0, 0, At, B0); PG8_BAR; PG8_SCHED;
            PG8_LDB(B1, 0, 1); PG8_STAGE(PG8_SB(0, 0), b2, voffB);
            PG8_BAR; PG8_WAIT_L(0); PG8_MMA(0, 1, At, B1); PG8_BAR;
            PG8_LDA(At, 0, 1); PG8_STAGE(PG8_SA(0, 0), a2, voffA);
            PG8_BAR; PG8_WAIT_L(0); PG8_MMA(1, 0, At, B0); PG8_BAR; PG8_SCHED;
            PG8_STAGE(PG8_SB(0, 1), b2 + hstepB, voffB);
            PG8_WAIT_V(6); PG8_BAR; PG8_MMA(1, 1, At, B1); PG8_BAR;
            PG8_LDB(B0, 1, 0); PG8_SCHED; PG8_LDA(At, 1, 0); PG8_STAGE(PG8_SA(0, 1), a2 + hstepA, voffA);
            PG8_WAIT_L(8); PG8_BAR; PG8_WAIT_L(0); PG8_MMA(0, 0, At, B0); PG8_BAR; PG8_SCHED;
            PG8_LDB(B1, 1, 1); PG8_STAGE(PG8_SB(1, 0), b3, voffB);
            PG8_BAR; PG8_WAIT_L(0); PG8_MMA(0, 1, At, B1); PG8_BAR;
            PG8_LDA(At, 1, 1); PG8_STAGE(PG8_SA(1, 0), a3, voffA);
            PG8_BAR; PG8_WAIT_L(0); PG8_MMA(1, 0, At, B0); PG8_BAR; PG8_SCHED;
            PG8_STAGE(PG8_SB(1, 1), b3 + hstepB, voffB);
            PG8_WAIT_V(6); PG8_BAR; PG8_MMA(1, 1, At, B1); PG8_BAR;
            }
        }
        if constexpr (ALIGN_EPI) { if (wr == 0) PG8_BAR; }
        E(acc, cur, wr, wc, fr, fq); S.done(cur);
        if (!has_next) break;
#pragma unroll
        for (int a = 0; a < 2; ++a)
#pragma unroll
            for (int b = 0; b < 2; ++b)
#pragma unroll
                for (int m = 0; m < 4; ++m)
#pragma unroll
                    for (int n = 0; n < 2; ++n) acc[a][b][m][n] = (f32x4){0.f, 0.f, 0.f, 0.f};
        cur = nxt; cA = nA; cB = nB; ++ui;
        if constexpr (ALIGN_EPI) { if (wr == 1) PG8_BAR; }
    }
    PG8_WAIT_V(0);
    if constexpr (!ALIGN_EPI) { if (wr == 0) PG8_BAR; }
    PG8_BAR;
#undef PG8_SA
#undef PG8_SB
#undef PG8_STAGE
#undef PG8_LDA
#undef PG8_LDB
#undef PG8_MMA
#undef PG8_WAIT_V
#undef PG8_WAIT_L
#undef PG8_BAR
#undef PG8_SCHED
}

struct EpiSwiglu {
    static constexpr bool PERM = true;
    bf16_t* H; int ldh;
    __device__ __forceinline__ void operator()(const f32x4 (&acc)[2][2][4][2], const Unit& u, int wr, int wc, int fr, int fq) const {
        const int row0 = u.pm * BM + wr * 64 + fr, col0 = u.pn * HALF + wc * 32 + 8 * fq;
#pragma unroll
        for (int ai = 0; ai < 2; ++ai)
#pragma unroll
            for (int m = 0; m < 4; ++m) {
                bf16_t* rowp = H + (size_t)(row0 + ai * HALF + m * 16) * ldh + col0;
                const f32x4 g0 = acc[ai][0][m][0], g1 = acc[ai][0][m][1], u0 = acc[ai][1][m][0], u1 = acc[ai][1][m][1];
                u32x4 w;
                w.x = cvt_pk_bf16(fast_silu(g0[0]) * u0[0], fast_silu(g0[1]) * u0[1]); w.y = cvt_pk_bf16(fast_silu(g0[2]) * u0[2], fast_silu(g0[3]) * u0[3]);
                w.z = cvt_pk_bf16(fast_silu(g1[0]) * u1[0], fast_silu(g1[1]) * u1[1]); w.w = cvt_pk_bf16(fast_silu(g1[2]) * u1[2], fast_silu(g1[3]) * u1[3]);
                *(u32x4*)rowp = w;
            }
    }
};
struct EpiDelta {
    static constexpr bool PERM = true;
    bf16_t* D; int ldd; float s;
    __device__ __forceinline__ void operator()(const f32x4 (&acc)[2][2][4][2], const Unit& u, int wr, int wc, int fr, int fq) const {
        const int row0 = u.pm * BM + wr * 64 + fr, col0 = u.pn * BM + wc * 32 + 8 * fq;
#pragma unroll
        for (int ai = 0; ai < 2; ++ai)
#pragma unroll
            for (int m = 0; m < 4; ++m) { bf16_t* rowp = D + (size_t)(row0 + ai * HALF + m * 16) * ldd + col0;
#pragma unroll
                for (int bj = 0; bj < 2; ++bj) { const f32x4 v0 = acc[ai][bj][m][0] * s, v1 = acc[ai][bj][m][1] * s;
                    u32x4 w; w.x = cvt_pk_bf16(v0[0], v0[1]); w.y = cvt_pk_bf16(v0[2], v0[3]); w.z = cvt_pk_bf16(v1[0], v1[1]); w.w = cvt_pk_bf16(v1[2], v1[3]);
                    *(u32x4*)(rowp + bj * HALF) = w; } }
    }
};
struct EpiResid {
    static constexpr bool PERM = true;
    float* X; int ldx; float s;
    __device__ __forceinline__ void operator()(const f32x4 (&acc)[2][2][4][2], const Unit& u, int wr, int wc, int fr, int fq) const {
        const int row0 = u.pm * BM + wr * 64 + fr, col0 = u.pn * BM + wc * 32 + 8 * fq;
#pragma unroll
        for (int ai = 0; ai < 2; ++ai)
#pragma unroll
            for (int m = 0; m < 4; ++m) {
                float* rowp = X + (size_t)(row0 + ai * HALF + m * 16) * ldx + col0;
#pragma unroll
                for (int bj = 0; bj < 2; ++bj) {
                    f32x4 a = *(const f32x4*)(rowp + bj * HALF), b = *(const f32x4*)(rowp + bj * HALF + 4);
                    a = a + acc[ai][bj][m][0] * s; b = b + acc[ai][bj][m][1] * s;
                    *(f32x4*)(rowp + bj * HALF) = a; *(f32x4*)(rowp + bj * HALF + 4) = b;
                }
            }
    }
};
}

#define XB_TMO      128
#define XB_XCNT(j)  (256  + 64 * (j))
#define XB_XSUB(j)  (1280 + 64 * (j))
#define XB_XGEN(j)  (2304 + 64 * (j))
#define XB_TOP      3328
#define XB_TOPGEN   3392
#define XCD_BAR_WORDS 3456
#define XB_SPIN_CAP (1u << 18)
__device__ __forceinline__ unsigned xb_ld(unsigned* p)              { return __hip_atomic_load(p, __ATOMIC_RELAXED, __HIP_MEMORY_SCOPE_AGENT); }
__device__ __forceinline__ unsigned xb_add(unsigned* p, unsigned v) { return __hip_atomic_fetch_add(p, v, __ATOMIC_RELAXED, __HIP_MEMORY_SCOPE_AGENT); }
__device__ __forceinline__ unsigned xb_xcc_id() { return (unsigned)__builtin_amdgcn_s_getreg((3 << 11) | 20) & 0xFu; }
#define XB_SPIN(cond, bar) do { unsigned _sp = 0; while (cond) { __builtin_amdgcn_s_sleep(1); \
    if ((++_sp & 255u) == 0u) { if (xb_ld(&(bar)[XB_TMO])) break; if (_sp > XB_SPIN_CAP) { atomicAdd(&(bar)[XB_TMO], 1u); break; } } } } while (0)
struct XcdBarrier { unsigned* bar; unsigned x; volatile LAS unsigned* st; };
__device__ __forceinline__ XcdBarrier xcd_barrier_post(unsigned* bar, volatile LAS unsigned* st) {
    XcdBarrier b; b.bar = bar; b.x = xb_xcc_id(); b.st = st;
    if (threadIdx.x == 0) (void)xb_add(&bar[XB_XCNT(b.x)], 1u);
    return b;
}
__device__ __forceinline__ void xcd_barrier_complete(unsigned* bar, unsigned x, unsigned& nloc, unsigned& nx) {
    const unsigned G = gridDim.x * gridDim.y * gridDim.z;
    unsigned sum, cnt, mine, sp = 0u;
    for (;;) {
        sum = 0u; cnt = 0u; mine = 0u;
#pragma unroll
        for (unsigned j = 0; j < 16; ++j) { const unsigned c = xb_ld(&bar[XB_XCNT(j)]); sum += c; cnt += (c > 0u) ? 1u : 0u; mine = (j == x) ? c : mine; }
        if (sum == G) break;
        __builtin_amdgcn_s_sleep(1);
        if ((++sp & 255u) == 0u) { if (xb_ld(&bar[XB_TMO])) break; if (sp > XB_SPIN_CAP) { atomicAdd(&bar[XB_TMO], 1u); break; } }
    }
    nloc = mine > 0u ? mine : 1u; nx = cnt > 0u ? cnt : 1u;
}
__device__ __forceinline__ void xcd_barrier(const XcdBarrier& b, const int wave) {
    asm volatile("s_waitcnt vmcnt(0)" ::: "memory");
    __syncthreads();
    if (opaque_tid(wave) == 0) {
        unsigned* bar = b.bar;
        __builtin_amdgcn_s_waitcnt(0);
        unsigned nloc = b.st[0], nx = b.st[1];
        if (nloc == 0u) { xcd_barrier_complete(bar, b.x, nloc, nx); b.st[0] = nloc; b.st[1] = nx; }
        const unsigned old = xb_add(&bar[XB_XSUB(b.x)], 1u);
        const unsigned gen = old / nloc;
        if (old + 1u == (gen + 1u) * nloc) {
            __builtin_amdgcn_fence(__ATOMIC_RELEASE, "agent");
            asm volatile("s_waitcnt vmcnt(0)" ::: "memory");
            const unsigned og = xb_add(&bar[XB_TOP], 1u);
            const unsigned tg = og / nx;
            if (og + 1u == (tg + 1u) * nx) xb_add(&bar[XB_TOPGEN], 1u);
            else XB_SPIN(xb_ld(&bar[XB_TOPGEN]) == tg, bar);
            __builtin_amdgcn_fence(__ATOMIC_ACQUIRE, "agent");
            xb_add(&bar[XB_XGEN(b.x)], 1u);
            asm volatile("s_waitcnt vmcnt(0)" ::: "memory");
        } else {
            XB_SPIN(xb_ld(&bar[XB_XGEN(b.x)]) == gen, bar);
            __builtin_amdgcn_fence(__ATOMIC_ACQUIRE, "agent");
            asm volatile("s_waitcnt vmcnt(0)" ::: "memory");
        }
    }
    __syncthreads();
}

struct Frame {
    LAS unsigned char* lds;
    volatile LAS unsigned* MISC;
    int tid, lane, wave, vcu, G;
};
#define PHASE_FRAME(F0) Frame F = (F0); { const int t_ = opaque_tid(F.wave); F.tid = t_; F.lane = t_ & 63; }

__device__ __forceinline__ void tr_item(const float* W, int ldw, bf16_t* WT, int ldt, int k0, int s0, int d0, int nvalid, LAS float* scr, int lane, bool perm = false) {
    if (!perm && nvalid == 32) {
        const int r8 = lane >> 3, n4 = (lane & 7) * 4;
        f32x4 v[8];
#pragma unroll
        for (int i = 0; i < 8; ++i) v[i] = *(const f32x4*)(W + (size_t)(k0 + 8 * i + r8) * ldw + s0 + n4);
#pragma unroll
        for (int i = 0; i < 8; ++i) { LAS float* p = scr + (8 * i + r8) * 33 + n4; p[0] = v[i].x; p[1] = v[i].y; p[2] = v[i].z; p[3] = v[i].w; }
    } else {
        const int c32 = lane & 31, sc = perm ? s0 + (c32 >> 1) + 32 * (c32 & 1) : s0 + c32;
#pragma unroll 8
        for (int i = 0; i < 32; ++i) { const int kk = 2 * i + (lane >> 5); scr[kk * 33 + c32] = (c32 < nvalid) ? W[(size_t)(k0 + kk) * ldw + sc] : 0.f; }
    }
    LDS_WAIT(); asm volatile("" ::: "memory");
    const int c = lane & 7;
#pragma unroll
    for (int j = 0; j < 4; ++j) { const int n = (lane >> 3) + 8 * j; const LAS float* s = scr + (8 * c) * 33 + n;
        u32x4 o; o.x = pk2(s[0 * 33], s[1 * 33]); o.y = pk2(s[2 * 33], s[3 * 33]); o.z = pk2(s[4 * 33], s[5 * 33]); o.w = pk2(s[6 * 33], s[7 * 33]);
        *(u32x4*)(WT + (size_t)(d0 + n) * ldt + k0 + 8 * c) = o; }
    LDS_WAIT(); asm volatile("" ::: "memory");
}

typedef _Float16 f16x4 __attribute__((ext_vector_type(4)));
__device__ __forceinline__ void rms_phase(const Frame& F0, const float* srcP, const float* srcS, const _Float16* srcH, const bf16_t* deltaLo, const bf16_t* deltaHi, const float* g, bf16_t* dst, _Float16* xout) {
    PHASE_FRAME(F0);
    const int gw = F.vcu * NWAVES + F.wave, NGW = F.G * NWAVES;
    f32x4 gv[8];
#pragma unroll
    for (int j = 0; j < 8; ++j) gv[j] = *(const f32x4*)(g + 4 * F.lane + 256 * j);
    for (int m = gw; m < MTOT; m += NGW) {
        f32x4 v[8]; float s = 0.f;
        if (srcH) {
#pragma unroll
            for (int j = 0; j < 8; ++j) { const f16x4 h = *(const f16x4*)(srcH + (size_t)m * DM + 4 * F.lane + 256 * j); v[j] = (f32x4){(float)h.x, (float)h.y, (float)h.z, (float)h.w}; }
        } else {
            const float* xrow = (m < M_P) ? srcP + (size_t)m * DM : srcS + (size_t)(m - M_P) * DM;
#pragma unroll
            for (int j = 0; j < 8; ++j) v[j] = *(const f32x4*)(xrow + 4 * F.lane + 256 * j);
        }
        if (deltaLo) {
            const bf16_t* delta = m < MTOT / 2 ? deltaLo : deltaHi;
#pragma unroll
            for (int j = 0; j < 8; ++j) { const u32x2 d = *(const u32x2*)(delta + (size_t)m * DM + 4 * F.lane + 256 * j);
                v[j].x += __builtin_bit_cast(float, d.x << 16); v[j].y += __builtin_bit_cast(float, d.x & 0xffff0000u); v[j].z += __builtin_bit_cast(float, d.y << 16); v[j].w += __builtin_bit_cast(float, d.y & 0xffff0000u); }
        }
#pragma unroll
        for (int j = 0; j < 8; ++j) s += (v[j].x * v[j].x + v[j].y * v[j].y) + (v[j].z * v[j].z + v[j].w * v[j].w);
        const float r = 1.f / sqrtf(wave_sum(s) * (1.f / DM) + NORM_EPS);
        bf16_t* orow = dst + (size_t)m * DM;
#pragma unroll
        for (int j = 0; j < 8; ++j) {
            if (xout) *(f16x4*)(xout + (size_t)m * DM + 4 * F.lane + 256 * j) = (f16x4){(_Float16)v[j].x, (_Float16)v[j].y, (_Float16)v[j].z, (_Float16)v[j].w};
            const f32x4 y = v[j] * r * gv[j];
            u32x2 o; o.x = pk2(y.x, y.y); o.y = pk2(y.z, y.w);
            *(u32x2*)(orow + 4 * F.lane + 256 * j) = o;
        }
    }
}
__device__ __forceinline__ void final_norm_rows(const Frame& F0, float* OUT, const _Float16* XH, const bf16_t* delta, const float* g, int m0, int m1, int src_base) {
    PHASE_FRAME(F0);
    const int gw = F.vcu * NWAVES + F.wave, NGW = F.G * NWAVES;
    for (int m = m0 + gw; m < m1; m += NGW) {
        f32x4 v[8]; float s = 0.f;
#pragma unroll
        for (int j = 0; j < 8; ++j) { const f16x4 h = *(const f16x4*)(XH + (size_t)(m - src_base) * DM + 4 * F.lane + 256 * j); const u32x2 d = *(const u32x2*)(delta + (size_t)m * DM + 4 * F.lane + 256 * j);
            v[j].x = (float)h.x + __builtin_bit_cast(float, d.x << 16); v[j].y = (float)h.y + __builtin_bit_cast(float, d.x & 0xffff0000u);
            v[j].z = (float)h.z + __builtin_bit_cast(float, d.y << 16); v[j].w = (float)h.w + __builtin_bit_cast(float, d.y & 0xffff0000u);
            s += (v[j].x * v[j].x + v[j].y * v[j].y) + (v[j].z * v[j].z + v[j].w * v[j].w); }
        const float r = 1.f / sqrtf(wave_sum(s) * (1.f / DM) + NORM_EPS);
#pragma unroll
        for (int j = 0; j < 8; ++j) *(f32x4*)(OUT + (size_t)m * DM + 4 * F.lane + 256 * j) = v[j] * r * (*(const f32x4*)(g + 4 * F.lane + 256 * j));
    }
}

__device__ __forceinline__ void convert_ffn_weights(const Frame& F0, const float* wg, const float* wu, const float* wd, bf16_t* GU, bf16_t* D) {
    PHASE_FRAME(F0);
    LAS float* scr = (LAS float*)(F.lds + F.wave * 16384);
    const int gw = F.vcu * NWAVES + F.wave, NGW = F.G * NWAVES;
    constexpr int NB_FF = DFF / 32, KB_DM = DM / 64, I_G = KB_DM * NB_FF;
    constexpr int NB_DM = DM / 32, KB_FF = DFF / 64, I_D = KB_FF * NB_DM;
    for (int it = gw; it < 2 * I_G + I_D; it += NGW) {
        if (it < 2 * I_G) {
            const int up = it >= I_G, r = it - up * I_G, kb = r / NB_FF, nb = r % NB_FF, n0 = nb * 32;
            const int d0 = 256 * (n0 >> 7) + (n0 & 127) + up * 128;
            tr_item(up ? wu : wg, DFF, GU, DM, kb * 64, n0, d0, 32, scr, F.lane);
        } else {
            const int r = it - 2 * I_G, kb = r / NB_DM, nb = r % NB_DM;
            tr_item(wd, DM, D, DFF, kb * 64, nb * 32, nb * 32, 32, scr, F.lane);
        }
    }
}

constexpr int MH = MTOT / 2;
constexpr int IN_W = 5648, IN_WP = 5888, PRJ_LD = 5120;
constexpr int PC_MQ = 0, PC_MK = 512, PC_MV = 1024, PC_MO = 1536, PC_DQ = 2048, PC_DK = 2560, PC_DV = 3072, PC_NQ = 3584, PC_NK = 4096, PC_NV = 4608;
constexpr int S5L = 32, S5NCH = MH / S5L, S5K = 16 * S5L + 256;
constexpr size_t MX_PROJ = WS_BIG, MX_UG = MX_PROJ + 240 * MiB, MX_QKC = MX_UG + 36 * MiB, MX_CST = MX_QKC + 48 * MiB, MX_E = MX_CST + 96 * MiB, MX_Z = MX_E + 24 * MiB;
constexpr size_t MX_GATES = MX_Z + 24 * MiB, MX_NST = MX_GATES + 2 * MiB, MX_MSC = MX_NST + 2 * MiB, MX_END = MX_MSC + 4 * MiB;
static_assert(MX_END <= WS_END, "mixer buffers fit in BIG");
constexpr float QSCALE = 0.125f * 1.4426950408889634f;

__device__ __forceinline__ int tpos(int half, int row) { return (half == 0 && row < 16384) ? (row & 8191) : (row & 4095); }

typedef short v4i16_t __attribute__((ext_vector_type(4)));
__device__ __forceinline__ unsigned off_a(unsigned row, unsigned ch) { return 2048u * (row >> 3) + 512u * (ch >> 2) + 64u * (row & 7) + 16u * ((ch & 3) ^ ((row >> 2) & 3)); }
struct FragBase { unsigned r0, r1, t0, t1; };
__device__ __forceinline__ FragBase make_fragbase(int lane) {
    const unsigned r32 = lane & 31, h = lane >> 5, blk = (lane >> 4) & 1, q = (lane & 15) >> 2, p = lane & 3;
    FragBase fb;
    fb.r0 = 2048u * (r32 >> 3) + 64u * (r32 & 7) + 16u * (((0u + h) & 3) ^ ((r32 >> 2) & 3));
    fb.r1 = 2048u * (r32 >> 3) + 64u * (r32 & 7) + 16u * (((2u + h) & 3) ^ ((r32 >> 2) & 3));
    fb.t0 = 2048u * h + 64u * q + 16u * ((2u * blk + (p >> 1)) ^ ((2u * h) & 3)) + 8u * (p & 1);
    fb.t1 = 2048u * h + 256u + 64u * q + 16u * ((2u * blk + (p >> 1)) ^ ((2u * h + 1u) & 3)) + 8u * (p & 1);
    return fb;
}
__device__ __forceinline__ bf16x8 rowfrag(const LAS unsigned char* tile, int rb, int s, const FragBase& fb) {
    return *(const LAS bf16x8*)(tile + rb * 8192 + (s >> 1) * 512 + ((s & 1) ? fb.r1 : fb.r0));
}
__device__ __forceinline__ bf16x8 trfrag(const LAS unsigned char* tile, int c, int ks, const FragBase& fb) {
    const v4i16_t lo = __builtin_amdgcn_ds_read_tr16_b64_v4i16((LAS v4i16_t*)(tile + ks * 4096 + c * 512 + fb.t0));
    const v4i16_t hi = __builtin_amdgcn_ds_read_tr16_b64_v4i16((LAS v4i16_t*)(tile + ks * 4096 + c * 512 + fb.t1));
    return (bf16x8){lo[0], lo[1], lo[2], lo[3], hi[0], hi[1], hi[2], hi[3]};
}
__device__ __forceinline__ float max3f(float a, float b, float c) { float r; asm("v_max3_f32 %0, %1, %2, %3" : "=v"(r) : "v"(a), "v"(b), "v"(c)); return r; }
#define SBAR() __builtin_amdgcn_sched_barrier(0)
__device__ __forceinline__ int crow(int r, int hi) { return (r & 3) + 8 * (r >> 2) + 4 * hi; }
#define MFMA32(a, b, c) __builtin_amdgcn_mfma_f32_32x32x16_bf16((a), (b), (c), 0, 0, 0)
__device__ __forceinline__ float swap_max(float v) { auto rr = __builtin_amdgcn_permlane32_swap(__float_as_uint(v), __float_as_uint(v), false, false); return fmaxf(__uint_as_float(rr[0]), __uint_as_float(rr[1])); }
__device__ __forceinline__ float swap_add(float v) { auto rr = __builtin_amdgcn_permlane32_swap(__float_as_uint(v), __float_as_uint(v), false, false); return __uint_as_float(rr[0]) + __uint_as_float(rr[1]); }
#define PK4(P, BASE, OUT) do { unsigned a0_ = cvt_pk_bf16(P[BASE + 0], P[BASE + 1]), a1_ = cvt_pk_bf16(P[BASE + 2], P[BASE + 3]); \
    unsigned b0_ = cvt_pk_bf16(P[BASE + 4], P[BASE + 5]), b1_ = cvt_pk_bf16(P[BASE + 6], P[BASE + 7]); \
    auto r0_ = __builtin_amdgcn_permlane32_swap(a0_, b0_, false, false); auto r1_ = __builtin_amdgcn_permlane32_swap(a1_, b1_, false, false); \
    u32x4 w_ = {r0_[0], r1_[0], r0_[1], r1_[1]}; OUT = __builtin_bit_cast(bf16x8, w_); } while (0)

namespace pg8 {
struct EpiInProj {
    static constexpr bool PERM = true;
    bf16_t* P; bf16_t* UG; float* GT; const float* gbias; const float* rope; int half;
    __device__ __forceinline__ void operator()(const f32x4 (&acc)[2][2][4][2], const Unit& u, int wr, int wc, int fr, int fq) const {
        const int row0 = u.pm * BM + wr * 64 + fr;
        if (u.pn >= 8 && u.pn < 12) {
            const float sc = u.pn < 10 ? QSCALE : 1.f;
#pragma unroll
            for (int ai = 0; ai < 2; ++ai)
#pragma unroll
                for (int m = 0; m < 4; ++m) { const int row = row0 + ai * HALF + m * 16; bf16_t* rowp = P + (size_t)row * PRJ_LD + u.pn * BM + wc * 32 + 8 * fq;
                    const float* tb = rope + ((size_t)tpos(half, row) * 32 + (((wc * 32 + 8 * fq) & 63) >> 1)) * 2;
                    const f32x4 cs0 = *(const f32x4*)tb, cs1 = *(const f32x4*)(tb + 4);
#pragma unroll
                    for (int bj = 0; bj < 2; ++bj) { const f32x4 v0 = acc[ai][bj][m][0], v1 = acc[ai][bj][m][1];
                        u32x4 w;
                        w.x = cvt_pk_bf16((v0[0] * cs0[0] - v0[1] * cs0[1]) * sc, (v0[1] * cs0[0] + v0[0] * cs0[1]) * sc);
                        w.y = cvt_pk_bf16((v0[2] * cs0[2] - v0[3] * cs0[3]) * sc, (v0[3] * cs0[2] + v0[2] * cs0[3]) * sc);
                        w.z = cvt_pk_bf16((v1[0] * cs1[0] - v1[1] * cs1[1]) * sc, (v1[1] * cs1[0] + v1[0] * cs1[1]) * sc);
                        w.w = cvt_pk_bf16((v1[2] * cs1[2] - v1[3] * cs1[3]) * sc, (v1[3] * cs1[2] + v1[2] * cs1[3]) * sc);
                        *(u32x4*)(rowp + bj * HALF) = w; } }
        } else if (u.pn < 20) {
            const int col0 = u.pn * BM + wc * 32 + 8 * fq;
#pragma unroll
            for (int ai = 0; ai < 2; ++ai)
#pragma unroll
                for (int m = 0; m < 4; ++m) { bf16_t* rowp = P + (size_t)(row0 + ai * HALF + m * 16) * PRJ_LD + col0;
#pragma unroll
                    for (int bj = 0; bj < 2; ++bj) { const f32x4 v0 = acc[ai][bj][m][0], v1 = acc[ai][bj][m][1];
                        u32x4 w; w.x = cvt_pk_bf16(v0[0], v0[1]); w.y = cvt_pk_bf16(v0[2], v0[3]); w.z = cvt_pk_bf16(v1[0], v1[1]); w.w = cvt_pk_bf16(v1[2], v1[3]);
                        *(u32x4*)(rowp + bj * HALF) = w; } }
        } else if (u.pn < 22) {
#pragma unroll
            for (int ai = 0; ai < 2; ++ai)
#pragma unroll
                for (int m = 0; m < 4; ++m) { const int row = row0 + ai * HALF + m * 16, chunk = row / S5L, i = row % S5L;
#pragma unroll
                    for (int bj = 0; bj < 2; ++bj) { const int col = (u.pn - 20) * BM + bj * HALF + wc * 32 + 8 * fq, g = col >> 4, c0 = col & 15;
                        const f32x4 v0 = acc[ai][bj][m][0], v1 = acc[ai][bj][m][1];
                        u32x4 w; w.x = cvt_pk_bf16(v0[0], v0[1]); w.y = cvt_pk_bf16(v0[2], v0[3]); w.z = cvt_pk_bf16(v1[0], v1[1]); w.w = cvt_pk_bf16(v1[2], v1[3]);
                        *(u32x4*)(UG + ((size_t)g * S5NCH + chunk) * S5K + i * 16 + c0) = w; } }
        } else {
            if (wc == 0 && fq < 2) {
                const f32x4 b0 = *(const f32x4*)(gbias + 8 * fq), b1 = *(const f32x4*)(gbias + 8 * fq + 4);
#pragma unroll
                for (int ai = 0; ai < 2; ++ai)
#pragma unroll
                    for (int m = 0; m < 4; ++m) { float* gp = GT + (size_t)(row0 + ai * HALF + m * 16) * 16 + 8 * fq;
                        *(f32x4*)gp = acc[ai][0][m][0] + b0; *(f32x4*)(gp + 4) = acc[ai][0][m][1] + b1; }
            }
        }
    }
};
}

__device__ __forceinline__ void convert_mixer_weights(const Frame& F0, const float* win, const float* wout, const float* glu, bf16_t* WIN, bf16_t* WOUT, bf16_t* GLU) {
    PHASE_FRAME(F0);
    LAS float* scr = (LAS float*)(F.lds + F.wave * 16384);
    const int gw = F.vcu * NWAVES + F.wave, NGW = F.G * NWAVES;
    constexpr int I_IN = (DM / 64) * (IN_WP / 32), I_OUT = (DM / 64) * (DM / 32), I_GLU = (GWID / 64) * (GWID / 32);
    for (int it = gw; it < I_IN + I_OUT + I_GLU; it += NGW) {
        if (it < I_IN) {
            const int kb = it / (IN_WP / 32), db = it % (IN_WP / 32), d0 = db * 32;
            int s0, nv; bool perm = false;
            if (d0 < 2048) { s0 = d0; nv = 32; } else if (d0 < 3072) { s0 = (d0 & ~63) + 16 + ((d0 >> 5) & 1) * 16; nv = 32; perm = true; }
            else if (d0 < 5632) { s0 = d0 + 16; nv = 32; } else if (d0 == 5632) { s0 = 2048; nv = 16; } else { s0 = 0; nv = 0; }
            tr_item(win, IN_W, WIN, DM, kb * 64, s0, d0, nv, scr, F.lane, perm);
        } else if (it < I_IN + I_OUT) {
            const int r = it - I_IN, kb = r / (DM / 32), nb = r % (DM / 32);
            tr_item(wout, DM, WOUT, DM, kb * 64, nb * 32, nb * 32, 32, scr, F.lane);
        } else {
            const int r = it - I_IN - I_OUT, kb = r / (GWID / 32), nb = r % (GWID / 32);
            tr_item(glu, GWID, GLU, GWID, kb * 64, nb * 32, nb * 32, 32, scr, F.lane);
        }
    }
}

__device__ __forceinline__ void rope_table_phase(const Frame& F0, float* tab) {
    PHASE_FRAME(F0);
    const int gt = F.vcu * (NWAVES * 64) + F.tid, NT = F.G * NWAVES * 64;
    for (int idx = gt; idx < 8192 * 32; idx += NT) {
        const int t = idx >> 5, i = idx & 31;
        const float inv = powf(10000.f, -(float)(2 * i) / 64.f);
        float s, c; sincosf((float)t * inv, &s, &c);
        tab[2 * idx] = c; tab[2 * idx + 1] = s;
    }
}
__device__ __forceinline__ void rope_apply_phase(const Frame& F0, int half, bf16_t* PR, const float* tab) {
    PHASE_FRAME(F0);
    const long gt = (long)F.vcu * (NWAVES * 64) + F.tid, NT = (long)F.G * NWAVES * 64;
    for (long it = gt; it < (long)MH * 64; it += NT) {
        const int row = (int)(it >> 6), x = (int)(it & 63), vec = x >> 2, ig = x & 3;
        bf16_t* p = PR + (size_t)row * PRJ_LD + PC_DQ + vec * 64 + ig * 8;
        const u32x4 a = *(const u32x4*)p, b = *(const u32x4*)(p + 32);
        const float* tb = tab + ((size_t)tpos(half, row) * 32 + ig * 8) * 2;
        const float sc = vec < 8 ? QSCALE : 1.f;
        u32x4 oa, ob;
#pragma unroll
        for (int e = 0; e < 4; ++e) {
            const f32x4 cs = *(const f32x4*)(tb + 4 * e);
            const float x1a = __builtin_bit_cast(float, a[e] << 16), x1b = __builtin_bit_cast(float, a[e] & 0xffff0000u);
            const float x2a = __builtin_bit_cast(float, b[e] << 16), x2b = __builtin_bit_cast(float, b[e] & 0xffff0000u);
            oa[e] = pk2((x1a * cs[0] - x2a * cs[1]) * sc, (x1b * cs[2] - x2b * cs[3]) * sc);
            ob[e] = pk2((x2a * cs[0] + x1a * cs[1]) * sc, (x2b * cs[2] + x1b * cs[3]) * sc);
        }
        *(u32x4*)p = oa; *(u32x4*)(p + 32) = ob;
    }
}

__device__ __forceinline__ void diffattn_phase(const Frame& F, int half, int layer, const bf16_t* PR, bf16_t* MIXh, const float* lamp, const float* normg) {
    const int tid = opaque_tid(F.wave), lane = tid & 63, wave = F.wave;
    const int map = wave >> 2, qw = wave & 3, r32 = lane & 31, hi = lane >> 5;
    const FragBase fb = make_fragbase(lane);
    LAS unsigned char* lds = F.lds;
    float d01 = 0.f, d23 = 0.f;
    for (int i = 0; i < 64; ++i) { d01 += lamp[i] * lamp[64 + i]; d23 += lamp[128 + i] * lamp[192 + i]; }
    const float lam_init = 0.8f - 0.6f * expf(-0.3f * (float)layer);
    const float lam = expf(d01) - expf(d23) + lam_init, oscale = 1.f - lam_init;
    LAS unsigned char* KB = lds; LAS unsigned char* VB = lds + 32768;
    LAS float* wsf = (LAS float*)(lds + 69632 + wave * 256);
    LAS float* OS = (LAS float*)lds;
    const int srow = tid >> 4, sch = tid & 15;
    const unsigned so0 = off_a(srow, sch), so1 = off_a(srow + 32, sch);
    for (int ui = 0; ; ++ui) {
        int row0, T, head, qb;
        if (gridDim.x == 256) {
            if (ui >= 3) break;
            const int x = blockIdx.x & 7, r = blockIdx.x >> 3;
            if (half == 0) { if (ui < 2) { row0 = (x >> 2) * 8192; T = 8192; head = x & 3; qb = r + 32 * ui; } else { row0 = 16384 + (x >> 2) * 4096; T = 4096; head = x & 3; qb = r; } }
            else { const int p = x + 8 * ui; row0 = (p >> 2) * 4096; T = 4096; head = p & 3; qb = r; }
        } else {
            const int u = blockIdx.x + ui * gridDim.x; if (u >= 768) break;
            if (half == 0) { if (u < 512) { row0 = (u >> 8) * 8192; T = 8192; head = (u >> 6) & 3; qb = u & 63; } else { const int v = u - 512; row0 = 16384 + (v >> 7) * 4096; T = 4096; head = (v >> 5) & 3; qb = v & 31; } }
            else { row0 = (u >> 7) * 4096; T = 4096; head = (u >> 5) & 3; qb = u & 31; }
        }
        const int NT = T / 64;
        const bf16_t* Kg = PR + (size_t)row0 * PRJ_LD + PC_DK + head * 128;
        const bf16_t* Vg = PR + (size_t)row0 * PRJ_LD + PC_DV + head * 128;
        const int qrow = row0 + qb * 128 + qw * 32 + r32;
        bf16x8 qf[4];
#pragma unroll
        for (int kk = 0; kk < 4; ++kk) qf[kk] = *(const bf16x8*)(PR + (size_t)qrow * PRJ_LD + PC_DQ + head * 128 + map * 64 + kk * 16 + hi * 8);
        u32x4 sk0, sk1, sv0, sv1, tk0, tk1, tv0, tv1;
#define DA_LOAD(j) do { const size_t ro_ = (size_t)((j) * 64 + srow) * PRJ_LD + sch * 8; sk0 = *(const u32x4*)(Kg + ro_); sk1 = *(const u32x4*)(Kg + ro_ + 32 * PRJ_LD); \
        sv0 = *(const u32x4*)(Vg + ro_); sv1 = *(const u32x4*)(Vg + ro_ + 32 * PRJ_LD); } while (0)
#define DA_LOAD2(j) do { const size_t ro_ = (size_t)((j) * 64 + srow) * PRJ_LD + sch * 8; tk0 = *(const u32x4*)(Kg + ro_); tk1 = *(const u32x4*)(Kg + ro_ + 32 * PRJ_LD); \
        tv0 = *(const u32x4*)(Vg + ro_); tv1 = *(const u32x4*)(Vg + ro_ + 32 * PRJ_LD); } while (0)
#define DA_WRITE(b) do { *(LAS u32x4*)(KB + (b) * 16384 + so0) = sk0; *(LAS u32x4*)(KB + (b) * 16384 + so1) = sk1; \
        *(LAS u32x4*)(VB + (b) * 16384 + so0) = sv0; *(LAS u32x4*)(VB + (b) * 16384 + so1) = sv1; } while (0)
#define DA_WRITE2(b) do { *(LAS u32x4*)(KB + (b) * 16384 + so0) = tk0; *(LAS u32x4*)(KB + (b) * 16384 + so1) = tk1; \
        *(LAS u32x4*)(VB + (b) * 16384 + so0) = tv0; *(LAS u32x4*)(VB + (b) * 16384 + so1) = tv1; } while (0)
        DA_LOAD(0); DA_WRITE(0); DA_LOAD2(1); __syncthreads();
        constexpr float DTHR = 10.f;
        float m_run = 0.f;
        f32x16 o[4], lacc, negm;
#pragma unroll
        for (int r = 0; r < 16; ++r) { lacc[r] = 0.f; negm[r] = 0.f; }
#pragma unroll
        for (int d = 0; d < 4; ++d)
#pragma unroll
            for (int r = 0; r < 16; ++r) o[d][r] = 0.f;
        const bf16x8 ones = {0x3F80, 0x3F80, 0x3F80, 0x3F80, 0x3F80, 0x3F80, 0x3F80, 0x3F80};
        for (int j = 0; j < NT; j += 2) {
          { const int b = 0;
            if (j + 2 < NT) DA_LOAD(j + 2);
            const LAS unsigned char* Kt = KB + b * 16384; const LAS unsigned char* Vt = VB + b * 16384;
            f32x16 p0, p1;
            {
                bf16x8 ka[4], kb[4];
#pragma unroll
                for (int kk = 0; kk < 4; ++kk) { ka[kk] = rowfrag(Kt + map * 1024, 0, kk, fb); kb[kk] = rowfrag(Kt + map * 1024, 1, kk, fb); }
                SBAR();
                p0 = MFMA32(ka[0], qf[0], negm); p1 = MFMA32(kb[0], qf[0], negm);
#pragma unroll
                for (int kk = 1; kk < 4; ++kk) { p0 = MFMA32(ka[kk], qf[kk], p0); p1 = MFMA32(kb[kk], qf[kk], p1); }
            }
            bf16x8 vA[4], vB[4];
#pragma unroll
            for (int d = 0; d < 4; ++d) vA[d] = trfrag(Vt, d, 0, fb);
            float pmax = max3f(p0[0], p1[0], p0[1]);
            pmax = max3f(pmax, p1[1], p0[2]);
#pragma unroll
            for (int r = 2; r < 15; ++r) pmax = max3f(pmax, p1[r], p0[r + 1]);
            pmax = fmaxf(pmax, p1[15]);
            pmax = swap_max(pmax);
            if (__builtin_expect(!__all(pmax <= DTHR) || j == 0, 0)) {
                const float dlt = j == 0 ? pmax : fmaxf(pmax, 0.f), alpha = j == 0 ? 1.f : __builtin_amdgcn_exp2f(-dlt);
                m_run += dlt;
#pragma unroll
                for (int r = 0; r < 16; ++r) { p0[r] -= dlt; p1[r] -= dlt; negm[r] = -m_run; }
                if (hi == 0) wsf[r32] = alpha;
#pragma unroll
                for (int r = 0; r < 16; ++r) { const float al = wsf[crow(r, hi)]; lacc[r] *= al;
#pragma unroll
                    for (int d = 0; d < 4; ++d) o[d][r] *= al; }
            }
#pragma unroll
            for (int r = 0; r < 16; ++r) { p0[r] = __builtin_amdgcn_exp2f(p0[r]); p1[r] = __builtin_amdgcn_exp2f(p1[r]); }
            bf16x8 pa[4];
            PK4(p0, 0, pa[0]); PK4(p0, 8, pa[1]); PK4(p1, 0, pa[2]); PK4(p1, 8, pa[3]);
#define DA_PV_STEP(KS, VC, VN) do { if ((KS) < 3) { _Pragma("unroll") for (int d = 0; d < 4; ++d) VN[d] = trfrag(Vt, d, (KS) + 1, fb); } SBAR(); \
                lacc = MFMA32(pa[KS], ones, lacc); _Pragma("unroll") for (int d = 0; d < 4; ++d) o[d] = MFMA32(pa[KS], VC[d], o[d]); SBAR(); } while (0)
            DA_PV_STEP(0, vA, vB); DA_PV_STEP(1, vB, vA); DA_PV_STEP(2, vA, vB); DA_PV_STEP(3, vB, vA);
#undef DA_PV_STEP
            DA_WRITE2(1);
            __syncthreads();
          }
          { const int b = 1;
            if (j + 3 < NT) DA_LOAD2(j + 3);
            const LAS unsigned char* Kt = KB + b * 16384; const LAS unsigned char* Vt = VB + b * 16384;
            f32x16 p0, p1;
            {
                bf16x8 ka[4], kb[4];
#pragma unroll
                for (int kk = 0; kk < 4; ++kk) { ka[kk] = rowfrag(Kt + map * 1024, 0, kk, fb); kb[kk] = rowfrag(Kt + map * 1024, 1, kk, fb); }
                SBAR();
                p0 = MFMA32(ka[0], qf[0], negm); p1 = MFMA32(kb[0], qf[0], negm);
#pragma unroll
                for (int kk = 1; kk < 4; ++kk) { p0 = MFMA32(ka[kk], qf[kk], p0); p1 = MFMA32(kb[kk], qf[kk], p1); }
            }
            bf16x8 vA[4], vB[4];
#pragma unroll
            for (int d = 0; d < 4; ++d) vA[d] = trfrag(Vt, d, 0, fb);
            float pmax = max3f(p0[0], p1[0], p0[1]);
            pmax = max3f(pmax, p1[1], p0[2]);
#pragma unroll
            for (int r = 2; r < 15; ++r) pmax = max3f(pmax, p1[r], p0[r + 1]);
            pmax = fmaxf(pmax, p1[15]);
            pmax = swap_max(pmax);
            if (__builtin_expect(!__all(pmax <= DTHR) || false, 0)) {
                const float dlt = false ? pmax : fmaxf(pmax, 0.f), alpha = false ? 1.f : __builtin_amdgcn_exp2f(-dlt);
                m_run += dlt;
#pragma unroll
                for (int r = 0; r < 16; ++r) { p0[r] -= dlt; p1[r] -= dlt; negm[r] = -m_run; }
                if (hi == 0) wsf[r32] = alpha;
#pragma unroll
                for (int r = 0; r < 16; ++r) { const float al = wsf[crow(r, hi)]; lacc[r] *= al;
#pragma unroll
                    for (int d = 0; d < 4; ++d) o[d][r] *= al; }
            }
#pragma unroll
            for (int r = 0; r < 16; ++r) { p0[r] = __builtin_amdgcn_exp2f(p0[r]); p1[r] = __builtin_amdgcn_exp2f(p1[r]); }
            bf16x8 pa[4];
            PK4(p0, 0, pa[0]); PK4(p0, 8, pa[1]); PK4(p1, 0, pa[2]); PK4(p1, 8, pa[3]);
#define DA_PV_STEP(KS, VC, VN) do { if ((KS) < 3) { _Pragma("unroll") for (int d = 0; d < 4; ++d) VN[d] = trfrag(Vt, d, (KS) + 1, fb); } SBAR(); \
                lacc = MFMA32(pa[KS], ones, lacc); _Pragma("unroll") for (int d = 0; d < 4; ++d) o[d] = MFMA32(pa[KS], VC[d], o[d]); SBAR(); } while (0)
            DA_PV_STEP(0, vA, vB); DA_PV_STEP(1, vB, vA); DA_PV_STEP(2, vA, vB); DA_PV_STEP(3, vB, vA);
#undef DA_PV_STEP
            if (j + 2 < NT) DA_WRITE(0);
            __syncthreads();
          }
        }
        float rl[16];
#pragma unroll
        for (int r = 0; r < 16; ++r) rl[r] = 1.f / lacc[r];
        if (map == 1) {
#pragma unroll
            for (int d = 0; d < 4; ++d)
#pragma unroll
                for (int r = 0; r < 16; ++r) OS[(qw * 32 + crow(r, hi)) * 132 + d * 32 + r32] = -lam * o[d][r] * rl[r];
        }
        __syncthreads();
        if (map == 0) {
#pragma unroll
            for (int d = 0; d < 4; ++d)
#pragma unroll
                for (int r = 0; r < 16; ++r) OS[(qw * 32 + crow(r, hi)) * 132 + d * 32 + r32] += o[d][r] * rl[r];
        }
        __syncthreads();
        const float g0 = normg[lane], g1 = normg[64 + lane];
        for (int i = 0; i < 16; ++i) {
            const int row = wave * 16 + i;
            const float v0 = OS[row * 132 + lane], v1 = OS[row * 132 + 64 + lane];
            const float rs = 1.f / sqrtf(wave_sum(v0 * v0 + v1 * v1) * (1.f / 128.f) + NORM_EPS) * oscale;
            bf16_t* orow = MIXh + (size_t)(row0 + qb * 128 + row) * DM + 512 + head * 128;
            orow[lane] = (bf16_t)f2bf(v0 * rs * g0); orow[64 + lane] = (bf16_t)f2bf(v1 * rs * g1);
        }
        __syncthreads();
#undef DA_LOAD
#undef DA_WRITE
#undef DA_LOAD2
#undef DA_WRITE2
    }
}

constexpr int ML_NCH = MH / 64;
constexpr int MSC_B = 0, MSC_ICB = 8 * MH, MSC_PMX = 16 * MH, MSC_WL = 24 * MH, MSC_G = 32 * MH, MSC_AMAX = MSC_G + 8 * ML_NCH, MSC_MPREV = MSC_AMAX + 8 * ML_NCH;
static_assert((size_t)(MSC_MPREV + 8 * ML_NCH) * 4 <= 4 * MiB, "MSC fits");
__device__ __forceinline__ void unpack8(const u32x4 v, float (&f)[8]) {
#pragma unroll
    for (int e = 0; e < 4; ++e) { f[2 * e] = __builtin_bit_cast(float, v[e] << 16); f[2 * e + 1] = __builtin_bit_cast(float, v[e] & 0xffff0000u); }
}
__device__ __forceinline__ void mlstm_conv_phase(const Frame& F0, int half, const bf16_t* PR, bf16_t* QKC, const float* cw, const float* cb) {
    PHASE_FRAME(F0);
    const long gt = (long)F.vcu * (NWAVES * 64) + F.tid, NT = (long)F.G * NWAVES * 64;
    for (long it = gt; it < (long)(MH / 16) * 128; it += NT) {
        const int cg = (int)(it & 127), tb = (int)(it >> 7), c0 = cg * 8;
        float w[5][8], bias[8];
#pragma unroll
        for (int j = 0; j < 5; ++j) { const f32x4 a = *(const f32x4*)(cw + j * 1024 + c0), b = *(const f32x4*)(cw + j * 1024 + c0 + 4);
            w[j][0] = a[0]; w[j][1] = a[1]; w[j][2] = a[2]; w[j][3] = a[3]; w[j][4] = b[0]; w[j][5] = b[1]; w[j][6] = b[2]; w[j][7] = b[3]; }
        { const f32x4 a = *(const f32x4*)(cb + c0), b = *(const f32x4*)(cb + c0 + 4); bias[0] = a[0]; bias[1] = a[1]; bias[2] = a[2]; bias[3] = a[3]; bias[4] = b[0]; bias[5] = b[1]; bias[6] = b[2]; bias[7] = b[3]; }
        const float osc = cg >= 64 ? 0.08838834764831845f : 1.f;
        const int rowb = tb * 16, posb = tpos(half, rowb), T = (half == 0 && rowb < 16384) ? 8192 : 4096;
        u32x4 rr[20];
#pragma unroll
        for (int q = 0; q < 20; ++q) { const int pp = posb + q - 2;
            rr[q] = (pp >= 0 && pp < T) ? *(const u32x4*)(PR + (size_t)(rowb + q - 2) * PRJ_LD + c0) : (u32x4){0u, 0u, 0u, 0u}; }
#pragma unroll
        for (int i = 0; i < 16; ++i) {
            float acc[8];
#pragma unroll
            for (int e = 0; e < 8; ++e) acc[e] = bias[e];
#pragma unroll
            for (int j = 0; j < 5; ++j) { float x[8]; unpack8(rr[i + j], x);
#pragma unroll
                for (int e = 0; e < 8; ++e) acc[e] += w[j][e] * x[e]; }
            u32x4 o;
#pragma unroll
            for (int e = 0; e < 4; ++e) o[e] = pk2(fast_silu(acc[2 * e]) * osc, fast_silu(acc[2 * e + 1]) * osc);
            *(u32x4*)(QKC + (size_t)(rowb + i) * 1024 + c0) = o;
        }
    }
}
__device__ __forceinline__ float log_sigmoid(float x) { return fminf(x, 0.f) - log1pf(expf(-fabsf(x))); }
__device__ __forceinline__ void mlstm_scalar_phase(const Frame& F0, const float* GT, float* MSC) {
    PHASE_FRAME(F0);
    const int gw = F.vcu * NWAVES + F.wave, NGW = F.G * NWAVES, lane = F.lane;
    for (int it = gw; it < ML_NCH * 8; it += NGW) {
        const int jc = it >> 3, hd = it & 7, h = hd >> 1, dir = hd & 1, row = jc * 64 + lane;
        const float ic = GT[(size_t)row * 16 + dir * 8 + h], fg = GT[(size_t)row * 16 + dir * 8 + 4 + h];
        const float lf = log_sigmoid(fg);
        float b = lf;
#pragma unroll
        for (int o = 1; o < 64; o <<= 1) { const float t = dir == 0 ? __shfl_up(b, o) : __shfl_down(b, o); if (dir == 0 ? (lane >= o) : (lane + o < 64)) b += t; }
        const float g = dir == 0 ? __shfl(b, 63) : __shfl(b, 0);
        const float a = g - b + ic;
        float amax = a;
#pragma unroll
        for (int o = 1; o < 64; o <<= 1) amax = fmaxf(amax, __shfl_xor(amax, o));
        const float icb = ic - b;
        float pm = icb;
#pragma unroll
        for (int o = 1; o < 64; o <<= 1) { const float t = dir == 0 ? __shfl_up(pm, o) : __shfl_down(pm, o); if (dir == 0 ? (lane >= o) : (lane + o < 64)) pm = fmaxf(pm, t); }
        MSC[MSC_B + hd * MH + row] = b; MSC[MSC_ICB + hd * MH + row] = icb; MSC[MSC_PMX + hd * MH + row] = pm; MSC[MSC_WL + hd * MH + row] = expf(a - amax);
        if (lane == 0) { MSC[MSC_G + hd * ML_NCH + jc] = g; MSC[MSC_AMAX + hd * ML_NCH + jc] = amax; }
    }
}
__device__ __forceinline__ void mlstm_state_phase(const Frame& F0, const bf16_t* PR, const bf16_t* QKC, const float* MSC, bf16_t* CST, float* NST) {
    PHASE_FRAME(F0);
    const int tid = F.tid, lane = F.lane, wave = F.wave, r32 = lane & 31, hi = lane >> 5;
    LAS unsigned char* Vt = F.lds; LAS unsigned char* Kt = F.lds + 16384;
    const int srow = tid >> 4, sch = tid & 15;
    const unsigned so0 = off_a(srow, sch), so1 = off_a(srow + 32, sch);
    const int eb = wave >> 1, db0 = 2 * (wave & 1);
    const FragBase fb = make_fragbase(lane);
    for (int u = blockIdx.x; u < ML_NCH * 4; u += gridDim.x) {
        const int jc = u >> 2, h = u & 3, row0 = jc * 64;
        *(LAS u32x4*)(Vt + so0) = *(const u32x4*)(PR + (size_t)(row0 + srow) * PRJ_LD + PC_MV + h * 128 + sch * 8);
        *(LAS u32x4*)(Vt + so1) = *(const u32x4*)(PR + (size_t)(row0 + srow + 32) * PRJ_LD + PC_MV + h * 128 + sch * 8);
        const u32x4 k0 = *(const u32x4*)(QKC + (size_t)(row0 + srow) * 1024 + 512 + h * 128 + sch * 8);
        const u32x4 k1 = *(const u32x4*)(QKC + (size_t)(row0 + srow + 32) * 1024 + 512 + h * 128 + sch * 8);
        for (int dir = 0; dir < 2; ++dir) {
            const int hd = h * 2 + dir, unit = u * 2 + dir;
            const float w0 = MSC[MSC_WL + hd * MH + row0 + srow], w1 = MSC[MSC_WL + hd * MH + row0 + srow + 32];
            { float x[8]; unpack8(k0, x); u32x4 o;
#pragma unroll
              for (int e = 0; e < 4; ++e) o[e] = pk2(x[2 * e] * w0, x[2 * e + 1] * w0);
              *(LAS u32x4*)(Kt + so0) = o; }
            { float x[8]; unpack8(k1, x); u32x4 o;
#pragma unroll
              for (int e = 0; e < 4; ++e) o[e] = pk2(x[2 * e] * w1, x[2 * e + 1] * w1);
              *(LAS u32x4*)(Kt + so1) = o; }
            __syncthreads();
            f32x16 acc0, acc1;
#pragma unroll
            for (int r = 0; r < 16; ++r) { acc0[r] = 0.f; acc1[r] = 0.f; }
#pragma unroll
            for (int ks = 0; ks < 4; ++ks) {
                const bf16x8 a = trfrag(Vt + eb * 512, 0, ks, fb), b0 = trfrag(Kt + db0 * 512, 0, ks, fb), b1 = trfrag(Kt + db0 * 512, 1, ks, fb);
                acc0 = MFMA32(a, b0, acc0); acc1 = MFMA32(a, b1, acc1);
            }
            bf16_t* cs = CST + (size_t)unit * 16384;
#pragma unroll
            for (int r = 0; r < 16; ++r) { const int e = 32 * eb + crow(r, hi);
                cs[e * 128 + 32 * db0 + r32] = (bf16_t)f2bf(acc0[r]); cs[e * 128 + 32 * (db0 + 1) + r32] = (bf16_t)f2bf(acc1[r]); }
            if (tid < 128) {
                float sum = 0.f;
                for (int l = 0; l < 64; ++l) sum += bf2f(*(const LAS unsigned short*)(Kt + off_a(l, tid >> 3) + (tid & 7) * 2));
                NST[(size_t)unit * 128 + tid] = sum;
            }
            __syncthreads();
        }
    }
}
__device__ __forceinline__ void mlstm_scan_phase(const Frame& F0, int half, float* MSC, bf16_t* CST, float* NST) {
    PHASE_FRAME(F0);
    const int gw = F.vcu * NWAVES + F.wave, NGW = F.G * NWAVES, lane = F.lane;
    const int nchain = (half == 0 ? 4 : 6) * 8;
    for (int it = gw; it < nchain * 33; it += NGW) {
        const int chain = it / 33, wi = it % 33, s = chain >> 3, hd = chain & 7, h = hd >> 1, dir = hd & 1;
        const int row0 = half == 0 ? (s < 2 ? s * 8192 : 16384 + (s - 2) * 4096) : s * 4096, T = (half == 0 && s < 2) ? 8192 : 4096;
        const int c0 = row0 / 64, nc = T / 64;
        float m = 0.f;
        if (wi < 32) {
            const int grp = wi * 64 + lane;
            float C[8];
#pragma unroll
            for (int e = 0; e < 8; ++e) C[e] = 0.f;
            for (int j0 = 0; j0 < nc; j0 += 16) {
                u32x4 U[16];
#pragma unroll
                for (int q = 0; q < 16; ++q) { const int jc = dir == 0 ? c0 + j0 + q : c0 + nc - 1 - (j0 + q); U[q] = *(const u32x4*)(CST + ((size_t)(jc * 4 + h) * 2 + dir) * 16384 + grp * 8); }
#pragma unroll
                for (int q = 0; q < 16; ++q) {
                    const int jc = dir == 0 ? c0 + j0 + q : c0 + nc - 1 - (j0 + q);
                    const float g = MSC[MSC_G + hd * ML_NCH + jc], am = MSC[MSC_AMAX + hd * ML_NCH + jc];
                    const float mn = fmaxf(g + m, am), dec = expf(g + m - mn), inc = expf(am - mn);
                    if (wi == 0 && lane == 0) MSC[MSC_MPREV + hd * ML_NCH + jc] = m;
                    m = mn;
                    u32x4 o;
#pragma unroll
                    for (int e = 0; e < 4; ++e) o[e] = pk2(C[2 * e], C[2 * e + 1]);
                    *(u32x4*)(CST + ((size_t)(jc * 4 + h) * 2 + dir) * 16384 + grp * 8) = o;
                    float x[8]; unpack8(U[q], x);
#pragma unroll
                    for (int e = 0; e < 8; ++e) C[e] = dec * C[e] + inc * x[e];
                }
            }
        } else {
            float n0 = 0.f, n1 = 0.f;
            for (int j = 0; j < nc; ++j) {
                const int jc = dir == 0 ? c0 + j : c0 + nc - 1 - j;
                const float g = MSC[MSC_G + hd * ML_NCH + jc], am = MSC[MSC_AMAX + hd * ML_NCH + jc];
                const float mn = fmaxf(g + m, am), dec = expf(g + m - mn), inc = expf(am - mn);
                m = mn;
                float* np = NST + ((size_t)(jc * 4 + h) * 2 + dir) * 128 + lane * 2;
                const f32x2 uu = *(const f32x2*)np;
                *(f32x2*)np = (f32x2){n0, n1};
                n0 = dec * n0 + inc * uu[0]; n1 = dec * n1 + inc * uu[1];
            }
        }
    }
}
__device__ __forceinline__ void mlstm_out_phase(const Frame& F0, const bf16_t* PR, const bf16_t* QKC, const float* MSC, const bf16_t* CST, const float* NST, const float* normg, bf16_t* MIXh) {
    PHASE_FRAME(F0);
    const int tid = F.tid, lane = F.lane, wave = F.wave, r32 = lane & 31, hi = lane >> 5;
    LAS unsigned char* Qt = F.lds; LAS unsigned char* Kt = F.lds + 16384; LAS unsigned char* Vt = F.lds + 32768; LAS unsigned char* CT0 = F.lds + 49152;
    LAS float* HS = (LAS float*)F.lds;
    LAS float* SC = (LAS float*)(F.lds + 114688);
    LAS float* wsx = (LAS float*)(F.lds + 118784 + wave * 512);
    const int lb = wave & 1, eb = wave >> 1, l = 32 * lb + r32;
    const FragBase fb = make_fragbase(lane);
    const int NU = ML_NCH * 4;
    u32x4 gq0, gq1, gk0, gk1, gv0, gv1, gc0[4], gc1[4]; float gs0, gs1; unsigned go[8];
#define MO_GATES(uu) do { const int jc_ = (uu) >> 2, h_ = (uu) & 3, l_ = opaque_tid(wave) & 63; \
        _Pragma("unroll") for (int i = 0; i < 8; ++i) go[i] = *(const unsigned*)(PR + (size_t)(jc_ * 64 + wave * 8 + i) * PRJ_LD + PC_MO + h_ * 128 + 2 * l_); } while (0)
#define MO_LOADS(uu) do { const int jc_ = (uu) >> 2, h_ = (uu) & 3, t_ = opaque_tid(wave), srow = t_ >> 4, sch = t_ & 15; const size_t r0_ = (size_t)(jc_ * 64 + srow), r1_ = r0_ + 32; \
        gq0 = *(const u32x4*)(QKC + r0_ * 1024 + h_ * 128 + sch * 8);       gq1 = *(const u32x4*)(QKC + r1_ * 1024 + h_ * 128 + sch * 8); \
        gk0 = *(const u32x4*)(QKC + r0_ * 1024 + 512 + h_ * 128 + sch * 8); gk1 = *(const u32x4*)(QKC + r1_ * 1024 + 512 + h_ * 128 + sch * 8); \
        gv0 = *(const u32x4*)(PR + r0_ * PRJ_LD + PC_MV + h_ * 128 + sch * 8); gv1 = *(const u32x4*)(PR + r1_ * PRJ_LD + PC_MV + h_ * 128 + sch * 8); \
        { const bf16_t* cs_ = CST + (size_t)(uu) * 2 * 16384; \
          _Pragma("unroll") for (int i = 0; i < 4; ++i) { const int id = t_ + 512 * i; gc0[i] = *(const u32x4*)(cs_ + id * 8); gc1[i] = *(const u32x4*)(cs_ + 16384 + id * 8); } } \
        { const int d_ = t_ / 320, j_ = t_ % 320, hd_ = h_ * 2 + d_; \
          gs0 = j_ < 64 ? MSC[MSC_B + hd_ * MH + jc_ * 64 + j_] : j_ < 128 ? MSC[MSC_ICB + hd_ * MH + jc_ * 64 + j_ - 64] : j_ < 192 ? MSC[MSC_PMX + hd_ * MH + jc_ * 64 + j_ - 128] : NST[((size_t)(uu) * 2 + d_) * 128 + j_ - 192]; } \
        if (t_ < 128) gs1 = NST[((size_t)(uu) * 2 + 1) * 128 + t_]; } while (0)
#define MO_WRITE() do { const int t_ = opaque_tid(wave), srow = t_ >> 4, sch = t_ & 15; const unsigned so0 = off_a(srow, sch), so1 = off_a(srow + 32, sch); \
        *(LAS u32x4*)(Qt + so0) = gq0; *(LAS u32x4*)(Qt + so1) = gq1; *(LAS u32x4*)(Kt + so0) = gk0; *(LAS u32x4*)(Kt + so1) = gk1; *(LAS u32x4*)(Vt + so0) = gv0; *(LAS u32x4*)(Vt + so1) = gv1; \
        _Pragma("unroll") for (int i = 0; i < 4; ++i) { const int id = t_ + 512 * i, e = id >> 4, ch = id & 15; *(LAS u32x4*)(CT0 + off_a(e, ch)) = gc0[i]; *(LAS u32x4*)(CT0 + 32768 + off_a(e, ch)) = gc1[i]; } \
        SC[t_] = gs0; if (t_ < 128) SC[512 + t_] = gs1; } while (0)
    int u = blockIdx.x;
    if (u < NU) { MO_LOADS(u); MO_GATES(u); }
    for (; u < NU; u += gridDim.x) {
        const int jc = u >> 2, h = u & 3, row0 = jc * 64;
        MO_WRITE();
        const float m_prev0 = MSC[MSC_MPREV + (h * 2) * ML_NCH + jc], m_prev1 = MSC[MSC_MPREV + (h * 2 + 1) * ML_NCH + jc];
        __syncthreads();
        if (u + (int)gridDim.x < NU) MO_LOADS(u + (int)gridDim.x);
        f32x16 hsum;
#pragma unroll
        for (int r = 0; r < 16; ++r) hsum[r] = 0.f;
#pragma unroll 1
        for (int dir = 0; dir < 2; ++dir) {
            const LAS unsigned char* CT = CT0 + dir * 32768;
            const LAS float* SCb = SC + dir * 320; const LAS float* SCi = SCb + 64; const LAS float* SCp = SCb + 128; const LAS float* SCn = SCb + 192;
            const float m_prev = dir == 0 ? m_prev0 : m_prev1;
            f32x16 s0, s1;
#pragma unroll
            for (int r = 0; r < 16; ++r) { s0[r] = 0.f; s1[r] = 0.f; }
#pragma unroll
            for (int ks = 0; ks < 8; ++ks) { const bf16x8 bq = rowfrag(Qt + lb * 8192, 0, ks, fb); s0 = MFMA32(rowfrag(Kt, 0, ks, fb), bq, s0); s1 = MFMA32(rowfrag(Kt, 1, ks, fb), bq, s1); }
            int l_ = l; asm volatile("" : "+v"(l_));
            const float b_l = SCb[l], m_t = b_l + fmaxf(m_prev, SCp[l]), sint = __expf(b_l + m_prev - m_t), bm = b_l - m_t;
            float rs = 0.f;
#pragma unroll
            for (int r = 0; r < 16; ++r) {
                const int sa = crow(r, hi), sb = 32 + sa;
                const bool va = dir == 0 ? (sa <= l_) : (sa >= l_), vb = dir == 0 ? (sb <= l_) : (sb >= l_);
                const float ia = SCi[sa], ib = SCi[sb];
                s0[r] *= __expf(va ? bm + ia : -1e30f); s1[r] *= __expf(vb ? bm + ib : -1e30f);
                rs += s0[r] + s1[r];
            }
            rs = swap_add(rs);
            float qn = 0.f;
#pragma unroll
            for (int c = 0; c < 8; ++c) { float x[8]; unpack8(*(const LAS u32x4*)(Qt + off_a(l, 8 * hi + c)), x);
#pragma unroll
                for (int e = 0; e < 8; ++e) qn += x[e] * SCn[64 * hi + 8 * c + e]; }
            qn = swap_add(qn);
            const float den = fmaxf(fabsf(sint * qn + rs), __expf(-m_t)), dinv = 1.f / den;
            if (hi == 0) { wsx[r32] = sint * dinv; wsx[32 + r32] = dinv; }
            bf16x8 pa[4];
            PK4(s0, 0, pa[0]); PK4(s0, 8, pa[1]); PK4(s1, 0, pa[2]); PK4(s1, 8, pa[3]);
            f32x16 ao, ai;
#pragma unroll
            for (int r = 0; r < 16; ++r) { ao[r] = 0.f; ai[r] = 0.f; }
#pragma unroll
            for (int ks = 0; ks < 4; ++ks) ao = MFMA32(pa[ks], trfrag(Vt + eb * 512, 0, ks, fb), ao);
#pragma unroll
            for (int ks = 0; ks < 8; ++ks) ai = MFMA32(rowfrag(Qt + lb * 8192, 0, ks, fb), rowfrag(CT + eb * 8192, 0, ks, fb), ai);
#pragma unroll
            for (int r = 0; r < 16; ++r) { const int lr = crow(r, hi); hsum[r] += ai[r] * wsx[lr] + ao[r] * wsx[32 + lr]; }
        }
        __syncthreads();
#pragma unroll
        for (int r = 0; r < 16; ++r) HS[(32 * lb + crow(r, hi)) * 132 + 32 * eb + r32] = hsum[r];
        __syncthreads();
        { const f32x2 gg = *(const f32x2*)(normg + h * 128 + 2 * lane);
#pragma unroll
          for (int i = 0; i < 8; ++i) {
            const int row = wave * 8 + i;
            const f32x2 v = *(const LAS f32x2*)(HS + row * 132 + 2 * lane);
            const float rr = 1.f / sqrtf(wave_sum(v.x * v.x + v.y * v.y) * (1.f / 128.f) + NORM_EPS);
            const float o0 = __builtin_bit_cast(float, go[i] << 16), o1 = __builtin_bit_cast(float, go[i] & 0xffff0000u);
            *(unsigned*)(MIXh + (size_t)(row0 + row) * DM + h * 128 + 2 * lane) = pk2(v.x * rr * gg.x / (1.f + __expf(-o0)), v.y * rr * gg.y / (1.f + __expf(-o1)));
          } }
        __syncthreads();
        if (u + (int)gridDim.x < NU) MO_GATES(u + (int)gridDim.x);
    }
#undef MO_LOADS
#undef MO_WRITE
#undef MO_GATES
}

constexpr size_t W_LBL = W_GLU + 512 * 1024;
__device__ __forceinline__ void s5_build_phase(const Frame& F0, int layer, const float* const* in, bf16_t* MR, bf16_t* PM, float* LBL) {
    PHASE_FRAME(F0);
    const int tid = F.tid;
    LAS float* PWr = (LAS float*)F.lds; LAS float* PWi = PWr + 2 * 34 * 64;
    LAS float* BBr = PWi + 2 * 34 * 64; LAS float* BBi = BBr + 2 * 64 * 16;
    LAS float* CCr = BBi + 2 * 64 * 16; LAS float* CCi = CCr + 16 * 64;
    LAS float* KT = CCi + 16 * 64;
    for (int ug = blockIdx.x; ug < 256; ug += gridDim.x) {
        const int g = ug >> 3, part = ug & 7;
        const float* lre = in[15] + (size_t)layer * 2 * 32 * 64; const float* lim = in[16] + (size_t)layer * 2 * 32 * 64; const float* lst = in[17] + layer * 2 * 32;
        const float* bre = in[18] + ((size_t)layer * 32 + g) * 64 * 16; const float* bim = in[19] + ((size_t)layer * 32 + g) * 64 * 16;
        const float* cre = in[20] + ((size_t)layer * 32 + g) * 16 * 64; const float* cim = in[21] + ((size_t)layer * 32 + g) * 16 * 64;
        const float* dsk = in[22] + ((size_t)layer * 32 + g) * 16;
        for (int idx = tid; idx < 2 * 34 * 64; idx += NWAVES * 64) {
            const int dir = idx / (34 * 64), tau = (idx / 64) % 34, p = idx & 63;
            const float st = expf(lst[dir * 32 + g]), x = lre[(dir * 32 + g) * 64 + p] * st * (float)tau, y = lim[(dir * 32 + g) * 64 + p] * st * (float)tau;
            float sn, cs; sincosf(y, &sn, &cs); const float ex = expf(x);
            PWr[idx] = ex * cs; PWi[idx] = ex * sn;
        }
        for (int idx = tid; idx < 2 * 64 * 16; idx += NWAVES * 64) {
            const int dir = idx >> 10, p = (idx >> 4) & 63, c = idx & 15;
            const float lr = lre[(dir * 32 + g) * 64 + p], li = lim[(dir * 32 + g) * 64 + p], st = expf(lst[dir * 32 + g]), x = lr * st, y = li * st;
            float sn, cs; sincosf(y, &sn, &cs); float sh, ch; sincosf(0.5f * y, &sh, &ch);
            const float er = expm1f(x) * cs - 2.f * sh * sh, ei = expf(x) * sn;
            const float dn = 1.f / (lr * lr + li * li), qr = (er * lr + ei * li) * dn, qi = (ei * lr - er * li) * dn;
            const float br = bre[p * 16 + c], bi = bim[p * 16 + c];
            BBr[idx] = qr * br - qi * bi; BBi[idx] = qr * bi + qi * br;
        }
        for (int idx = tid; idx < 16 * 64; idx += NWAVES * 64) { CCr[idx] = cre[idx]; CCi[idx] = cim[idx]; }
        __syncthreads();
        for (int idx = tid; idx < 2 * 32 * 16; idx += NWAVES * 64) {
            const int dir = idx >> 9, tau = (idx >> 4) & 31, c = idx & 15;
            f32x4 a0 = {0.f, 0.f, 0.f, 0.f}, a1 = a0, a2 = a0, a3 = a0;
            for (int p = 0; p < 64; ++p) {
                const float pr = PWr[(dir * 34 + tau) * 64 + p], pi = PWi[(dir * 34 + tau) * 64 + p], cr = CCr[c * 64 + p], ci = CCi[c * 64 + p];
                const float wr = cr * pr - ci * pi, wi = cr * pi + ci * pr;
                const LAS f32x4* br = (const LAS f32x4*)(BBr + (dir * 64 + p) * 16); const LAS f32x4* bi = (const LAS f32x4*)(BBi + (dir * 64 + p) * 16);
                a0 += br[0] * wr - bi[0] * wi; a1 += br[1] * wr - bi[1] * wi; a2 += br[2] * wr - bi[2] * wi; a3 += br[3] * wr - bi[3] * wi;
            }
            LAS f32x4* kt = (LAS f32x4*)(KT + ((dir * 32 + tau) * 16 + c) * 16);
            kt[0] = a0; kt[1] = a1; kt[2] = a2; kt[3] = a3;
        }
        __syncthreads();
        bf16_t* mr = MR + (size_t)g * 512 * S5K;
        for (int idx = tid; idx < 64 * (S5K / 2); idx += NWAVES * 64) {
            const int row = part * 64 + idx / (S5K / 2), col = (idx % (S5K / 2)) * 2, i = row >> 4, c = row & 15;
            float v[2];
#pragma unroll
            for (int e = 0; e < 2; ++e) {
                const int cc = col + e;
                if (cc < 512) {
                    const int k = cc >> 4, c2 = cc & 15; float a = 0.f;
                    if (k <= i) a += KT[((0 * 32 + (i - k)) * 16 + c) * 16 + c2];
                    if (k >= i) a += KT[((1 * 32 + (k - i)) * 16 + c) * 16 + c2];
                    if (k == i && c == c2) a += dsk[c];
                    v[e] = a;
                } else {
                    const int x = cc - 512, dir = x >> 7, p = (x >> 1) & 63, ri = x & 1, tau = dir == 0 ? i + 1 : S5L - i;
                    const float pr = PWr[(dir * 34 + tau) * 64 + p], pi = PWi[(dir * 34 + tau) * 64 + p], cr = CCr[c * 64 + p], ci = CCi[c * 64 + p];
                    v[e] = ri == 0 ? (cr * pr - ci * pi) : -(cr * pi + ci * pr);
                }
            }
            *(unsigned*)(mr + (size_t)row * S5K + col) = pk2(v[0], v[1]);
        }
        bf16_t* pm = PM + (size_t)g * 256 * 512;
        for (int idx = tid; idx < 32 * 256; idx += NWAVES * 64) {
            const int n = part * 32 + (idx >> 8), col = (idx & 255) * 2, dir = n >> 7, p = (n >> 1) & 63, ri = n & 1;
            float v[2];
#pragma unroll
            for (int e = 0; e < 2; ++e) {
                const int cc = col + e, k = cc >> 4, c2 = cc & 15, tau = dir == 0 ? S5L - 1 - k : k;
                const float pr = PWr[(dir * 34 + tau) * 64 + p], pi = PWi[(dir * 34 + tau) * 64 + p], br = BBr[(dir * 64 + p) * 16 + c2], bi = BBi[(dir * 64 + p) * 16 + c2];
                v[e] = ri == 0 ? (pr * br - pi * bi) : (pr * bi + pi * br);
            }
            *(unsigned*)(pm + (size_t)n * 512 + col) = pk2(v[0], v[1]);
        }
        if (part == 0 && tid < 128) { const int dir = tid >> 6, p = tid & 63; LBL[((g * 2 + dir) * 64 + p) * 2] = PWr[(dir * 34 + S5L) * 64 + p]; LBL[((g * 2 + dir) * 64 + p) * 2 + 1] = PWi[(dir * 34 + S5L) * 64 + p]; }
        __syncthreads();
    }
}
namespace pg8 {
struct S5OrderA { int G, c;
    __device__ bool next(int i, Unit& u) const { const int L = i * G + c; if (L >= 96) return false; const int g = L / 3; u.pm = L; u.pn = g; return true; }
    __device__ __forceinline__ void a_ready(const Unit&) const {} __device__ __forceinline__ void done(const Unit&) const {} };
struct S5OrderB { int G, c;
    __device__ bool next(int i, Unit& u) const { const int L = i * G + c; if (L >= 192) return false; const int g = L / 6, r = L % 6; u.pm = g * 3 + r % 3; u.pn = g * 2 + r / 3; return true; }
    __device__ __forceinline__ void a_ready(const Unit&) const {} __device__ __forceinline__ void done(const Unit&) const {} };
struct EpiS5E {
    static constexpr bool PERM = true; float* E;
    __device__ __forceinline__ void operator()(const f32x4 (&acc)[2][2][4][2], const Unit& u, int wr, int wc, int fr, int fq) const {
        const int row0 = u.pm * BM + wr * 64 + fr, col0 = wc * 32 + 8 * fq;
#pragma unroll
        for (int ai = 0; ai < 2; ++ai)
#pragma unroll
            for (int m = 0; m < 4; ++m) { float* rowp = E + (size_t)(row0 + ai * HALF + m * 16) * 256 + col0;
#pragma unroll
                for (int bj = 0; bj < 2; ++bj) { *(f32x4*)(rowp + bj * HALF) = acc[ai][bj][m][0]; *(f32x4*)(rowp + bj * HALF + 4) = acc[ai][bj][m][1]; } }
    }
};
__device__ __forceinline__ float gelu_tanh(float x) { const float t = 1.5957691216057308f * (x + 0.044715f * x * x * x); return x * __builtin_amdgcn_rcpf(1.f + __expf(-t)); }
struct EpiS5Z {
    static constexpr bool PERM = true; bf16_t* Z;
    __device__ __forceinline__ void operator()(const f32x4 (&acc)[2][2][4][2], const Unit& u, int wr, int wc, int fr, int fq) const {
        const int g = u.pn >> 1, row0 = u.pm * BM + wr * 64 + fr - g * S5NCH;
#pragma unroll
        for (int ai = 0; ai < 2; ++ai)
#pragma unroll
            for (int m = 0; m < 4; ++m) { const int chunk = row0 + ai * HALF + m * 16;
#pragma unroll
                for (int bj = 0; bj < 2; ++bj) { const int col = (u.pn & 1) * BM + bj * HALF + wc * 32 + 8 * fq, i = col >> 4, c0 = col & 15;
                    const f32x4 v0 = acc[ai][bj][m][0], v1 = acc[ai][bj][m][1];
                    u32x4 w; w.x = cvt_pk_bf16(gelu_tanh(v0[0]), gelu_tanh(v0[1])); w.y = cvt_pk_bf16(gelu_tanh(v0[2]), gelu_tanh(v0[3]));
                    w.z = cvt_pk_bf16(gelu_tanh(v1[0]), gelu_tanh(v1[1])); w.w = cvt_pk_bf16(gelu_tanh(v1[2]), gelu_tanh(v1[3]));
                    *(u32x4*)(Z + (size_t)(chunk * S5L + i) * GWID + 16 * g + c0) = w; } }
    }
};
struct EpiGlu {
    static constexpr bool PERM = true; const bf16_t* Z; const float* bias; bf16_t* O;
    __device__ __forceinline__ void operator()(const f32x4 (&acc)[2][2][4][2], const Unit& u, int wr, int wc, int fr, int fq) const {
        const int row0 = u.pm * BM + wr * 64 + fr, col0 = u.pn * BM + wc * 32 + 8 * fq;
#pragma unroll
        for (int ai = 0; ai < 2; ++ai)
#pragma unroll
            for (int m = 0; m < 4; ++m) { const size_t row = (size_t)(row0 + ai * HALF + m * 16);
#pragma unroll
                for (int bj = 0; bj < 2; ++bj) { const int col = col0 + bj * HALF;
                    const u32x4 zz = *(const u32x4*)(Z + row * GWID + col);
                    const f32x4 b0 = *(const f32x4*)(bias + col), b1 = *(const f32x4*)(bias + col + 4);
                    const f32x4 v0 = acc[ai][bj][m][0] + b0, v1 = acc[ai][bj][m][1] + b1;
                    float z[8];
#pragma unroll
                    for (int e = 0; e < 4; ++e) { z[2 * e] = __builtin_bit_cast(float, zz[e] << 16); z[2 * e + 1] = __builtin_bit_cast(float, zz[e] & 0xffff0000u); }
                    u32x4 w;
                    w.x = cvt_pk_bf16(z[0] * __builtin_amdgcn_rcpf(1.f + __expf(-v0[0])), z[1] * __builtin_amdgcn_rcpf(1.f + __expf(-v0[1])));
                    w.y = cvt_pk_bf16(z[2] * __builtin_amdgcn_rcpf(1.f + __expf(-v0[2])), z[3] * __builtin_amdgcn_rcpf(1.f + __expf(-v0[3])));
                    w.z = cvt_pk_bf16(z[4] * __builtin_amdgcn_rcpf(1.f + __expf(-v1[0])), z[5] * __builtin_amdgcn_rcpf(1.f + __expf(-v1[1])));
                    w.w = cvt_pk_bf16(z[6] * __builtin_amdgcn_rcpf(1.f + __expf(-v1[2])), z[7] * __builtin_amdgcn_rcpf(1.f + __expf(-v1[3])));
                    *(u32x4*)(O + row * DM + 1536 + col) = w; } }
    }
};
}
__device__ __forceinline__ void s5_scan_phase(const Frame& F0, int half, const float* E, const float* LBL, bf16_t* UG) {
    PHASE_FRAME(F0);
    const int gt = F.vcu * (NWAVES * 64) + F.tid, NT = F.G * NWAVES * 64;
    const int nseq = half == 0 ? 4 : 6;
    for (int it = gt; it < nseq * 4096; it += NT) {
        const int s = it >> 12, g = (it >> 7) & 31, dir = (it >> 6) & 1, p = it & 63;
        const int row0 = half == 0 ? (s < 2 ? s * 8192 : 16384 + (s - 2) * 4096) : s * 4096, T = (half == 0 && s < 2) ? 8192 : 4096;
        const int c0 = row0 / S5L, ncs = T / S5L;
        const float ar = LBL[((g * 2 + dir) * 64 + p) * 2], ai = LBL[((g * 2 + dir) * 64 + p) * 2 + 1];
        float sr = 0.f, si = 0.f;
        for (int j0 = 0; j0 < ncs; j0 += 32) {
            f32x2 ev[32];
#pragma unroll
            for (int q = 0; q < 32; ++q) { const int ch = dir == 0 ? c0 + j0 + q : c0 + ncs - 1 - (j0 + q); ev[q] = *(const f32x2*)(E + ((size_t)g * S5NCH + ch) * 256 + dir * 128 + 2 * p); }
#pragma unroll
            for (int q = 0; q < 32; ++q) { const int ch = dir == 0 ? c0 + j0 + q : c0 + ncs - 1 - (j0 + q);
                *(unsigned*)(UG + ((size_t)g * S5NCH + ch) * S5K + 512 + dir * 128 + 2 * p) = pk2(sr, si);
                const float nr = ar * sr - ai * si + ev[q][0], ni = ar * si + ai * sr + ev[q][1]; sr = nr; si = ni; }
        }
    }
}

__device__ __forceinline__ void na_phase(const Frame& F0, int half, const bf16_t* PR, const float* rpb, bf16_t* MIXh) {
    PHASE_FRAME(F0);
    const int tid = F.tid, lane = F.lane, wave = F.wave, r32 = lane & 31, hi = lane >> 5;
    LAS unsigned char* Qt = F.lds; LAS unsigned char* Kt = F.lds + 32768; LAS unsigned char* Vt = F.lds + 65536;
    LAS float* RP = (LAS float*)(F.lds + 98304);
    LAS float* wsx = (LAS float*)(F.lds + 114688 + wave * 256);
    const int hl = wave >> 1, qb = wave & 1, qc = 32 * qb + r32, cs = min(max(qc - 8, 0), 48);
    const FragBase fb = make_fragbase(lane);
    constexpr float QS2 = 0.125f * 1.4426950408889634f, LOG2E = 1.4426950408889634f;
    { const int t1 = opaque_tid(wave); for (int i = t1; i < 8 * 465; i += NWAVES * 64) RP[i] = rpb[i]; }
    for (int u = F.vcu; u < (MH / 64) * 2; u += gridDim.x) {
        const int gr = u >> 1, hq = u & 1;
        int row0, r, rows;
        if (half == 0) { if (gr < 256) { row0 = (gr >> 7) * 8192; r = gr & 127; rows = 128; } else { const int g2 = gr - 256; row0 = 16384 + (g2 >> 6) * 4096; r = g2 & 63; rows = 64; } }
        else { row0 = (gr >> 6) * 4096; r = gr & 63; rows = 64; }
        const int rs = min(max(r - 4, 0), rows - 8);
        { const int t2 = opaque_tid(wave);
#pragma unroll
        for (int i = 0; i < 4; ++i) { const int id = t2 + 512 * i, row = id >> 5, c32 = id & 31;
            *(LAS u32x4*)(Qt + (c32 >> 4) * 16384 + off_a(row, c32 & 15)) = *(const u32x4*)(PR + (size_t)(row0 + r * 64 + row) * PRJ_LD + PC_NQ + hq * 256 + c32 * 8); }
        }
        u32x4 kA[4], vA[4], kB[4], vB[4];
#define NA_LOAD(KS, VS, kr) do { _Pragma("unroll") for (int i = 0; i < 4; ++i) { const int id = tid + 512 * i, row = id >> 5, c32 = id & 31; \
            const bf16_t* gp = PR + (size_t)(row0 + (rs + (kr)) * 64 + row) * PRJ_LD + hq * 256 + c32 * 8; KS[i] = *(const u32x4*)(gp + PC_NK); VS[i] = *(const u32x4*)(gp + PC_NV); } } while (0)
#define NA_WRITE(KS, VS) do { _Pragma("unroll") for (int i = 0; i < 4; ++i) { const int id = tid + 512 * i, row = id >> 5, c32 = id & 31; const unsigned o_ = (c32 >> 4) * 16384 + off_a(row, c32 & 15); \
            *(LAS u32x4*)(Kt + o_) = KS[i]; *(LAS u32x4*)(Vt + o_) = VS[i]; } } while (0)
        NA_LOAD(kA, vA, 0); NA_LOAD(kB, vB, 1);
        float m_run = -1e30f, l_run = 0.f;
        f32x16 o[2];
#pragma unroll
        for (int r_ = 0; r_ < 16; ++r_) { o[0][r_] = 0.f; o[1][r_] = 0.f; }
        bf16x8 qf[4];
#pragma unroll 1
        for (int kr = 0; kr < 8; kr += 2) {
            NA_WRITE(kA, vA);
            __syncthreads();
            if (kr == 0) {
#pragma unroll
                for (int kk = 0; kk < 4; ++kk) qf[kk] = rowfrag(Qt + (hl >> 1) * 16384 + qb * 8192 + (hl & 1) * 1024, 0, kk, fb);
            }
            if (kr + 2 < 8) NA_LOAD(kA, vA, kr + 2);
            {
            const LAS unsigned char* Kh = Kt + (hl >> 1) * 16384 + (hl & 1) * 1024; const LAS unsigned char* Vh = Vt + (hl >> 1) * 16384 + (hl & 1) * 1024;
            f32x16 p0, p1;
#pragma unroll
            for (int r_ = 0; r_ < 16; ++r_) { p0[r_] = 0.f; p1[r_] = 0.f; }
#pragma unroll
            for (int kk = 0; kk < 4; ++kk) { p0 = MFMA32(rowfrag(Kh, 0, kk, fb), qf[kk], p0); p1 = MFMA32(rowfrag(Kh, 1, kk, fb), qf[kk], p1); }
            const LAS float* rp = RP + (hq * 4 + hl) * 465 + (rs + (kr) - r + 7) * 31;
            int bq_ = 15 - qc; asm volatile("" : "+v"(bq_));
            int cs_ = cs; asm volatile("" : "+v"(cs_));
            float pmax = -1e30f;
#pragma unroll
            for (int r_ = 0; r_ < 16; ++r_) {
                const int ka = crow(r_, hi), kb = 32 + ka;
                const bool va = (unsigned)(ka - cs_) < 16u, vb = (unsigned)(kb - cs_) < 16u;
                const float ba = rp[min(max(ka + bq_, 0), 30)], bb = rp[min(max(kb + bq_, 0), 30)];
                p0[r_] = va ? p0[r_] * QS2 + ba * LOG2E : -1e30f; p1[r_] = vb ? p1[r_] * QS2 + bb * LOG2E : -1e30f;
                pmax = fmaxf(pmax, fmaxf(p0[r_], p1[r_]));
            }
            pmax = swap_max(pmax);
            const float mn = fmaxf(m_run, pmax), alpha = __builtin_amdgcn_exp2f(m_run - mn); m_run = mn;
            float ps = 0.f;
#pragma unroll
            for (int r_ = 0; r_ < 16; ++r_) { p0[r_] = __builtin_amdgcn_exp2f(p0[r_] - mn); p1[r_] = __builtin_amdgcn_exp2f(p1[r_] - mn); ps += p0[r_] + p1[r_]; }
            ps = swap_add(ps); l_run = l_run * alpha + ps;
            if (hi == 0) wsx[r32] = alpha;
#pragma unroll
            for (int r_ = 0; r_ < 16; ++r_) { const float al = wsx[crow(r_, hi)]; o[0][r_] *= al; o[1][r_] *= al; }
            bf16x8 pa[4];
            PK4(p0, 0, pa[0]); PK4(p0, 8, pa[1]); PK4(p1, 0, pa[2]); PK4(p1, 8, pa[3]);
#pragma unroll
            for (int d = 0; d < 2; ++d)
#pragma unroll
                for (int ks = 0; ks < 4; ++ks) o[d] = MFMA32(pa[ks], trfrag(Vh, d, ks, fb), o[d]);
            }
            __syncthreads();
            NA_WRITE(kB, vB);
            __syncthreads();
            if (kr + 3 < 8) NA_LOAD(kB, vB, kr + 3);
            {
            const LAS unsigned char* Kh = Kt + (hl >> 1) * 16384 + (hl & 1) * 1024; const LAS unsigned char* Vh = Vt + (hl >> 1) * 16384 + (hl & 1) * 1024;
            f32x16 p0, p1;
#pragma unroll
            for (int r_ = 0; r_ < 16; ++r_) { p0[r_] = 0.f; p1[r_] = 0.f; }
#pragma unroll
            for (int kk = 0; kk < 4; ++kk) { p0 = MFMA32(rowfrag(Kh, 0, kk, fb), qf[kk], p0); p1 = MFMA32(rowfrag(Kh, 1, kk, fb), qf[kk], p1); }
            const LAS float* rp = RP + (hq * 4 + hl) * 465 + (rs + (kr + 1) - r + 7) * 31;
            int bq_ = 15 - qc; asm volatile("" : "+v"(bq_));
            int cs_ = cs; asm volatile("" : "+v"(cs_));
            float pmax = -1e30f;
#pragma unroll
            for (int r_ = 0; r_ < 16; ++r_) {
                const int ka = crow(r_, hi), kb = 32 + ka;
                const bool va = (unsigned)(ka - cs_) < 16u, vb = (unsigned)(kb - cs_) < 16u;
                const float ba = rp[min(max(ka + bq_, 0), 30)], bb = rp[min(max(kb + bq_, 0), 30)];
                p0[r_] = va ? p0[r_] * QS2 + ba * LOG2E : -1e30f; p1[r_] = vb ? p1[r_] * QS2 + bb * LOG2E : -1e30f;
                pmax = fmaxf(pmax, fmaxf(p0[r_], p1[r_]));
            }
            pmax = swap_max(pmax);
            const float mn = fmaxf(m_run, pmax), alpha = __builtin_amdgcn_exp2f(m_run - mn); m_run = mn;
            float ps = 0.f;
#pragma unroll
            for (int r_ = 0; r_ < 16; ++r_) { p0[r_] = __builtin_amdgcn_exp2f(p0[r_] - mn); p1[r_] = __builtin_amdgcn_exp2f(p1[r_] - mn); ps += p0[r_] + p1[r_]; }
            ps = swap_add(ps); l_run = l_run * alpha + ps;
            if (hi == 0) wsx[r32] = alpha;
#pragma unroll
            for (int r_ = 0; r_ < 16; ++r_) { const float al = wsx[crow(r_, hi)]; o[0][r_] *= al; o[1][r_] *= al; }
            bf16x8 pa[4];
            PK4(p0, 0, pa[0]); PK4(p0, 8, pa[1]); PK4(p1, 0, pa[2]); PK4(p1, 8, pa[3]);
#pragma unroll
            for (int d = 0; d < 2; ++d)
#pragma unroll
                for (int ks = 0; ks < 4; ++ks) o[d] = MFMA32(pa[ks], trfrag(Vh, d, ks, fb), o[d]);
            }
            __syncthreads();
        }
        if (hi == 0) wsx[32 + r32] = l_run;
        const int head = hq * 4 + hl;
#pragma unroll
        for (int r_ = 0; r_ < 16; ++r_) { const int q = 32 * qb + crow(r_, hi); const float rl = 1.f / wsx[32 + crow(r_, hi)];
            bf16_t* op = MIXh + (size_t)(row0 + r * 64 + q) * DM + 1024 + head * 64;
            op[r32] = (bf16_t)f2bf(o[0][r_] * rl); op[32 + r32] = (bf16_t)f2bf(o[1][r_] * rl); }
#undef NA_LOAD
#undef NA_WRITE
    }
}

__device__ __forceinline__ void zero_mixed_cols(const Frame& F0, bf16_t* MIXh, int c0) {
    PHASE_FRAME(F0);
    const long gt = (long)F.vcu * (NWAVES * 64) + F.tid, NT = (long)F.G * NWAVES * 64;
    for (long it = gt; it < (long)MH * 64; it += NT) { const int row = (int)(it >> 6), ch = (int)(it & 63);
        *(u32x4*)(MIXh + (size_t)row * DM + c0 + ch * 8) = (u32x4){0u, 0u, 0u, 0u}; }
}

#ifndef EN_DIFF
#define EN_DIFF 1
#endif
#ifndef EN_MLSTM
#define EN_MLSTM 1
#endif
#ifndef EN_NA
#define EN_NA 1
#endif
#ifndef EN_S5
#define EN_S5 1
#endif
struct Args { const float* in[31]; float* out; unsigned char* ws; int ph_lo, ph_hi; };
constexpr size_t SZ_WGATE = (size_t)DM * DFF, SZ_WDOWN = (size_t)DFF * DM;

__global__ void __launch_bounds__(NWAVES * 64, 2) mk_fwd(Args args) {
    extern __shared__ __attribute__((aligned(16))) unsigned char lds_raw[];
    Frame F;
    F.lds = (LAS unsigned char*)lds_raw;
    F.MISC = (volatile LAS unsigned*)(F.lds + MISC_OFF);
    F.tid = threadIdx.x; F.lane = F.tid & 63; F.wave = __builtin_amdgcn_readfirstlane(F.tid >> 6);
    F.G = gridDim.x; { const int bx = blockIdx.x; F.vcu = (F.G % 8 == 0) ? (bx % 8) * (F.G / 8) + bx / 8 : bx; }
    unsigned char* ws = args.ws;
    unsigned* ctl = (unsigned*)(ws + WS_CTL);
    for (int u = F.tid; u < (LDS_BYTES - LDSCTL_OFF) / 4; u += NWAVES * 64) ((LAS unsigned*)(F.lds + LDSCTL_OFF))[u] = 0u;
    __syncthreads();
    XcdBarrier bar = xcd_barrier_post(ctl + CW_BAR, F.MISC + 8);
    const int lo = args.ph_lo, hi = args.ph_hi;
    int ph = 0;
#define IN_PH() (lo <= ph && ph < hi)
#define END_PH() do { if (lo <= ph && ph + 1 < hi) xcd_barrier(bar, F.wave); ++ph; } while (0)

    float* X = args.out;
    _Float16* XH = (_Float16*)((unsigned char*)args.out + (size_t)MTOT * DM * 2);
    bf16_t* XN = (bf16_t*)(ws + WS_XN);
    bf16_t* HB = (bf16_t*)(ws + WS_BIG);
    bf16_t* PROJ = (bf16_t*)(ws + MX_PROJ);
    bf16_t* UG = (bf16_t*)(ws + MX_UG);
    float* GATES = (float*)(ws + MX_GATES);
    float* ROPE = (float*)(ws + WS_ROPE);
    float* S5E = (float*)(ws + MX_E); bf16_t* S5Z = (bf16_t*)(ws + MX_Z);
    bf16_t* QKC = (bf16_t*)(ws + MX_QKC); bf16_t* CST = (bf16_t*)(ws + MX_CST); float* NST = (float*)(ws + MX_NST); float* MSC = (float*)(ws + MX_MSC);

{ constexpr int layer = 0;
        if (IN_PH()) {
{ constexpr int rep = 0;
            convert_ffn_weights(F, args.in[3] + layer * SZ_WGATE, args.in[4] + layer * SZ_WGATE, args.in[5] + layer * SZ_WDOWN, (bf16_t*)(ws + W_GU1), (bf16_t*)(ws + W_D1));
            convert_ffn_weights(F, args.in[27] + layer * SZ_WGATE, args.in[28] + layer * SZ_WGATE, args.in[29] + layer * SZ_WDOWN, (bf16_t*)(ws + W_GU2), (bf16_t*)(ws + W_D2));
            convert_mixer_weights(F, args.in[7] + (size_t)layer * DM * IN_W, args.in[25] + (size_t)layer * DM * DM, args.in[23] + (size_t)layer * GWID * GWID,
                                  (bf16_t*)(ws + W_IN), (bf16_t*)(ws + W_OUT), (bf16_t*)(ws + W_GLU));
}
            if (layer == 0) rope_table_phase(F, ROPE);
            __syncthreads();
{ constexpr int rep = 0;
            if (EN_S5) s5_build_phase(F, layer, args.in, (bf16_t*)(ws + W_S5MR), (bf16_t*)(ws + W_S5P), (float*)(ws + W_LBL));
}
        }
        END_PH();
{ constexpr int f = 0;
            if (IN_PH()) {
{ constexpr int rep = 0;
                const float* g = (f == 0 ? args.in[2] : args.in[26]) + layer * DM;
                if (layer == 0 && f == 0) rms_phase(F, args.in[0], args.in[1], nullptr, nullptr, nullptr, g, XN, nullptr);
                else if (f == 0) rms_phase(F, nullptr, nullptr, XH, XN, XN, g, XN, XH);
                else rms_phase(F, nullptr, nullptr, XH, (const bf16_t*)(ws + WS_SPARE), HB, g, XN, XH);
}
            }
            END_PH();
            if (IN_PH()) {
{ constexpr int rep = 0;
                pg8::Gemm g{XN, (const bf16_t*)(ws + (f == 0 ? W_GU1 : W_GU2)), DM, DM, DM};
                pg8::StaticOrder S; S.init(MTOT / 256, 2 * DFF / 256, F.G, (int)blockIdx.x, 32);
                pg8::EpiSwiglu E{HB, DFF};
                pg8::gemm_phase<pg8::EpiSwiglu, pg8::StaticOrder, true, true>(F.lds, g, S, E, F.wave);
}
            }
            END_PH();
            if (IN_PH()) {
{ constexpr int rep = 0;
                pg8::Gemm g{HB, (const bf16_t*)(ws + (f == 0 ? W_D1 : W_D2)), DFF, DFF, DFF};
                pg8::StaticOrder S; S.init(MTOT / 256, DM / 256, F.G, (int)blockIdx.x, 4, 0);
                pg8::EpiDelta E{XN, DM, 0.5f};
                pg8::gemm_phase<pg8::EpiDelta, pg8::StaticOrder, true, true>(F.lds, g, S, E, F.wave);
}
            }
            END_PH();
            if (f == 0) {
                if (IN_PH()) { if (layer == 0) rms_phase(F, args.in[0], args.in[1], nullptr, XN, XN, args.in[6] + layer * DM, XN, XH);
                    else rms_phase(F, nullptr, nullptr, XH, XN, XN, args.in[6] + layer * DM, XN, XH); }
                END_PH();
{ constexpr int half = 0;
                    bf16_t* MIXh = XN + (size_t)half * MH * DM;
                    if (IN_PH()) {
{ constexpr int rep = 0;
                        pg8::Gemm g{XN + (size_t)half * MH * DM, (const bf16_t*)(ws + W_IN), DM, DM, DM};
                        pg8::StaticOrder S; S.init(MH / 256, IN_WP / 256, F.G, (int)blockIdx.x, 32);
                        pg8::EpiInProj E{PROJ, UG, GATES, args.in[10] + layer * 16, ROPE, half};
                        pg8::gemm_phase<pg8::EpiInProj, pg8::StaticOrder, true, true>(F.lds, g, S, E, F.wave);
}
                    }
                    END_PH();
                    if (IN_PH()) {
{ constexpr int rep = 0;
                        if (EN_MLSTM) { mlstm_conv_phase(F, half, PROJ, QKC, args.in[8] + layer * 5 * 1024, args.in[9] + layer * 1024); mlstm_scalar_phase(F, GATES, MSC); }
}
                        if (!EN_MLSTM) zero_mixed_cols(F, MIXh, 0);
                        if (!EN_DIFF) zero_mixed_cols(F, MIXh, 512);
                        if (!EN_NA) zero_mixed_cols(F, MIXh, 1024);
                        if (!EN_S5) zero_mixed_cols(F, MIXh, 1536);
                        if (EN_S5) { __syncthreads();
                            pg8::Gemm g{UG, (const bf16_t*)(ws + W_S5P), 512, S5K, 512}; pg8::S5OrderA S{F.G, (int)blockIdx.x}; pg8::EpiS5E E{S5E};
                            pg8::gemm_phase<pg8::EpiS5E, pg8::S5OrderA, true, true>(F.lds, g, S, E, F.wave); }
                    }
                    END_PH();
                    if (IN_PH()) {
{ constexpr int rep = 0;
                        if (EN_S5) s5_scan_phase(F, half, S5E, (const float*)(ws + W_LBL), UG);
}
{ constexpr int rep = 0;
                        if (EN_NA) { na_phase(F, half, PROJ, args.in[14] + (size_t)layer * 8 * 465, MIXh); __syncthreads(); }
}
{ constexpr int rep = 0;
                        if (EN_MLSTM) mlstm_state_phase(F, PROJ, QKC, MSC, CST, NST);
}
                    }
                    END_PH();
                    if (IN_PH()) {
                        if (EN_MLSTM) mlstm_scan_phase(F, half, MSC, CST, NST);
{ constexpr int rep = 0;
                        if (EN_S5) { pg8::Gemm g{UG, (const bf16_t*)(ws + W_S5MR), S5K, S5K, S5K}; pg8::S5OrderB S{F.G, (int)blockIdx.x}; pg8::EpiS5Z E{S5Z};
                            pg8::gemm_phase<pg8::EpiS5Z, pg8::S5OrderB, true, true>(F.lds, g, S, E, F.wave); __syncthreads(); }
}
{ constexpr int rep = 0;
                        if (EN_DIFF) diffattn_phase(F, half, layer, PROJ, MIXh, args.in[12] + layer * 256, args.in[13] + layer * 128);
}
                    }
                    END_PH();
                    if (IN_PH()) {
{ constexpr int rep = 0;
                        if (EN_MLSTM) mlstm_out_phase(F, PROJ, QKC, MSC, CST, NST, args.in[11] + layer * GWID, MIXh);
}
                        if (EN_S5) { __syncthreads();
                            pg8::Gemm g{S5Z, (const bf16_t*)(ws + W_GLU), GWID, GWID, GWID}; pg8::StaticOrder S; S.init(MH / 256, GWID / 256, F.G, (int)blockIdx.x);
                            pg8::EpiGlu E{S5Z, args.in[24] + layer * GWID, MIXh};
                            pg8::gemm_phase<pg8::EpiGlu, pg8::StaticOrder, true, true>(F.lds, g, S, E, F.wave); }
                    }
                    END_PH();
                    if (IN_PH()) {
{ constexpr int rep = 0;
                        pg8::Gemm g{MIXh, (const bf16_t*)(ws + W_OUT), DM, DM, DM};
                        pg8::StaticOrder S; S.init(MH / 256, DM / 256, F.G, (int)blockIdx.x, 32);
                        pg8::EpiDelta E{half == 0 ? (bf16_t*)(ws + WS_SPARE) : HB + (size_t)MH * DM, DM, 1.0f};
                        pg8::gemm_phase<pg8::EpiDelta, pg8::StaticOrder, true, true>(F.lds, g, S, E, F.wave);
}
                    }
                    END_PH();
}
{ constexpr int half = 1;
                    bf16_t* MIXh = XN + (size_t)half * MH * DM;
                    if (IN_PH()) {
{ constexpr int rep = 0;
                        pg8::Gemm g{XN + (size_t)half * MH * DM, (const bf16_t*)(ws + W_IN), DM, DM, DM};
                        pg8::StaticOrder S; S.init(MH / 256, IN_WP / 256, F.G, (int)blockIdx.x, 32);
                        pg8::EpiInProj E{PROJ, UG, GATES, args.in[10] + layer * 16, ROPE, half};
                        pg8::gemm_phase<pg8::EpiInProj, pg8::StaticOrder, true, true>(F.lds, g, S, E, F.wave);
}
                    }
                    END_PH();
                    if (IN_PH()) {
{ constexpr int rep = 0;
                        if (EN_MLSTM) { mlstm_conv_phase(F, half, PROJ, QKC, args.in[8] + layer * 5 * 1024, args.in[9] + layer * 1024); mlstm_scalar_phase(F, GATES, MSC); }
}
                        if (!EN_MLSTM) zero_mixed_cols(F, MIXh, 0);
                        if (!EN_DIFF) zero_mixed_cols(F, MIXh, 512);
                        if (!EN_NA) zero_mixed_cols(F, MIXh, 1024);
                        if (!EN_S5) zero_mixed_cols(F, MIXh, 1536);
                        if (EN_S5) { __syncthreads();
                            pg8::Gemm g{UG, (const bf16_t*)(ws + W_S5P), 512, S5K, 512}; pg8::S5OrderA S{F.G, (int)blockIdx.x}; pg8::EpiS5E E{S5E};
                            pg8::gemm_phase<pg8::EpiS5E, pg8::S5OrderA, true, true>(F.lds, g, S, E, F.wave); }
                    }
                    END_PH();
                    if (IN_PH()) {
{ constexpr int rep = 0;
                        if (EN_S5) s5_scan_phase(F, half, S5E, (const float*)(ws + W_LBL), UG);
}
{ constexpr int rep = 0;
                        if (EN_NA) { na_phase(F, half, PROJ, args.in[14] + (size_t)layer * 8 * 465, MIXh); __syncthreads(); }
}
{ constexpr int rep = 0;
                        if (EN_MLSTM) mlstm_state_phase(F, PROJ, QKC, MSC, CST, NST);
}
                    }
                    END_PH();
                    if (IN_PH()) {
                        if (EN_MLSTM) mlstm_scan_phase(F, half, MSC, CST, NST);
{ constexpr int rep = 0;
                        if (EN_S5) { pg8::Gemm g{UG, (const bf16_t*)(ws + W_S5MR), S5K, S5K, S5K}; pg8::S5OrderB S{F.G, (int)blockIdx.x}; pg8::EpiS5Z E{S5Z};
                            pg8::gemm_phase<pg8::EpiS5Z, pg8::S5OrderB, true, true>(F.lds, g, S, E, F.wave); __syncthreads(); }
}
{ constexpr int rep = 0;
                        if (EN_DIFF) diffattn_phase(F, half, layer, PROJ, MIXh, args.in[12] + layer * 256, args.in[13] + layer * 128);
}
                    }
                    END_PH();
                    if (IN_PH()) {
{ constexpr int rep = 0;
                        if (EN_MLSTM) mlstm_out_phase(F, PROJ, QKC, MSC, CST, NST, args.in[11] + layer * GWID, MIXh);
}
                        if (EN_S5) { __syncthreads();
                            pg8::Gemm g{S5Z, (const bf16_t*)(ws + W_GLU), GWID, GWID, GWID}; pg8::StaticOrder S; S.init(MH / 256, GWID / 256, F.G, (int)blockIdx.x);
                            pg8::EpiGlu E{S5Z, args.in[24] + layer * GWID, MIXh};
                            pg8::gemm_phase<pg8::EpiGlu, pg8::StaticOrder, true, true>(F.lds, g, S, E, F.wave); }
                    }
                    END_PH();
                    if (IN_PH()) {
{ constexpr int rep = 0;
                        pg8::Gemm g{MIXh, (const bf16_t*)(ws + W_OUT), DM, DM, DM};
                        pg8::StaticOrder S; S.init(MH / 256, DM / 256, F.G, (int)blockIdx.x, 32);
                        pg8::EpiDelta E{half == 0 ? (bf16_t*)(ws + WS_SPARE) : HB + (size_t)MH * DM, DM, 1.0f};
                        pg8::gemm_phase<pg8::EpiDelta, pg8::StaticOrder, true, true>(F.lds, g, S, E, F.wave);
}
                    }
                    END_PH();
}
            }
}
{ constexpr int f = 1;
            if (IN_PH()) {
{ constexpr int rep = 0;
                const float* g = (f == 0 ? args.in[2] : args.in[26]) + layer * DM;
                if (layer == 0 && f == 0) rms_phase(F, args.in[0], args.in[1], nullptr, nullptr, nullptr, g, XN, nullptr);
                else if (f == 0) rms_phase(F, nullptr, nullptr, XH, XN, XN, g, XN, XH);
                else rms_phase(F, nullptr, nullptr, XH, (const bf16_t*)(ws + WS_SPARE), HB, g, XN, XH);
}
            }
            END_PH();
            if (IN_PH()) {
{ constexpr int rep = 0;
                pg8::Gemm g{XN, (const bf16_t*)(ws + (f == 0 ? W_GU1 : W_GU2)), DM, DM, DM};
                pg8::StaticOrder S; S.init(MTOT / 256, 2 * DFF / 256, F.G, (int)blockIdx.x, 32);
                pg8::EpiSwiglu E{HB, DFF};
                pg8::gemm_phase<pg8::EpiSwiglu, pg8::StaticOrder, true, true>(F.lds, g, S, E, F.wave);
}
            }
            END_PH();
            if (IN_PH()) {
{ constexpr int rep = 0;
                pg8::Gemm g{HB, (const bf16_t*)(ws + (f == 0 ? W_D1 : W_D2)), DFF, DFF, DFF};
                pg8::StaticOrder S; S.init(MTOT / 256, DM / 256, F.G, (int)blockIdx.x, 4, 0);
                pg8::EpiDelta E{XN, DM, 0.5f};
                pg8::gemm_phase<pg8::EpiDelta, pg8::StaticOrder, true, true>(F.lds, g, S, E, F.wave);
}
            }
            END_PH();
            if (f == 0) {
                if (IN_PH()) { if (layer == 0) rms_phase(F, args.in[0], args.in[1], nullptr, XN, XN, args.in[6] + layer * DM, XN, XH);
                    else rms_phase(F, nullptr, nullptr, XH, XN, XN, args.in[6] + layer * DM, XN, XH); }
                END_PH();
{ constexpr int half = 0;
                    bf16_t* MIXh = XN + (size_t)half * MH * DM;
                    if (IN_PH()) {
{ constexpr int rep = 0;
                        pg8::Gemm g{XN + (size_t)half * MH * DM, (const bf16_t*)(ws + W_IN), DM, DM, DM};
                        pg8::StaticOrder S; S.init(MH / 256, IN_WP / 256, F.G, (int)blockIdx.x, 32);
                        pg8::EpiInProj E{PROJ, UG, GATES, args.in[10] + layer * 16, ROPE, half};
                        pg8::gemm_phase<pg8::EpiInProj, pg8::StaticOrder, true, true>(F.lds, g, S, E, F.wave);
}
                    }
                    END_PH();
                    if (IN_PH()) {
{ constexpr int rep = 0;
                        if (EN_MLSTM) { mlstm_conv_phase(F, half, PROJ, QKC, args.in[8] + layer * 5 * 1024, args.in[9] + layer * 1024); mlstm_scalar_phase(F, GATES, MSC); }
}
                        if (!EN_MLSTM) zero_mixed_cols(F, MIXh, 0);
                        if (!EN_DIFF) zero_mixed_cols(F, MIXh, 512);
                        if (!EN_NA) zero_mixed_cols(F, MIXh, 1024);
                        if (!EN_S5) zero_mixed_cols(F, MIXh, 1536);
                        if (EN_S5) { __syncthreads();
                            pg8::Gemm g{UG, (const bf16_t*)(ws + W_S5P), 512, S5K, 512}; pg8::S5OrderA S{F.G, (int)blockIdx.x}; pg8::EpiS5E E{S5E};
                            pg8::gemm_phase<pg8::EpiS5E, pg8::S5OrderA, true, true>(F.lds, g, S, E, F.wave); }
                    }
                    END_PH();
                    if (IN_PH()) {
{ constexpr int rep = 0;
                        if (EN_S5) s5_scan_phase(F, half, S5E, (const float*)(ws + W_LBL), UG);
}
{ constexpr int rep = 0;
                        if (EN_NA) { na_phase(F, half, PROJ, args.in[14] + (size_t)layer * 8 * 465, MIXh); __syncthreads(); }
}
{ constexpr int rep = 0;
                        if (EN_MLSTM) mlstm_state_phase(F, PROJ, QKC, MSC, CST, NST);
}
                    }
                    END_PH();
                    if (IN_PH()) {
                        if (EN_MLSTM) mlstm_scan_phase(F, half, MSC, CST, NST);
{ constexpr int rep = 0;
                        if (EN_S5) { pg8::Gemm g{UG, (const bf16_t*)(ws + W_S5MR), S5K, S5K, S5K}; pg8::S5OrderB S{F.G, (int)blockIdx.x}; pg8::EpiS5Z E{S5Z};
                            pg8::gemm_phase<pg8::EpiS5Z, pg8::S5OrderB, true, true>(F.lds, g, S, E, F.wave); __syncthreads(); }
}
{ constexpr int rep = 0;
                        if (EN_DIFF) diffattn_phase(F, half, layer, PROJ, MIXh, args.in[12] + layer * 256, args.in[13] + layer * 128);
}
                    }
                    END_PH();
                    if (IN_PH()) {
{ constexpr int rep = 0;
                        if (EN_MLSTM) mlstm_out_phase(F, PROJ, QKC, MSC, CST, NST, args.in[11] + layer * GWID, MIXh);
}
                        if (EN_S5) { __syncthreads();
                            pg8::Gemm g{S5Z, (const bf16_t*)(ws + W_GLU), GWID, GWID, GWID}; pg8::StaticOrder S; S.init(MH / 256, GWID / 256, F.G, (int)blockIdx.x);
                            pg8::EpiGlu E{S5Z, args.in[24] + layer * GWID, MIXh};
                            pg8::gemm_phase<pg8::EpiGlu, pg8::StaticOrder, true, true>(F.lds, g, S, E, F.wave); }
                    }
                    END_PH();
                    if (IN_PH()) {
{ constexpr int rep = 0;
                        pg8::Gemm g{MIXh, (const bf16_t*)(ws + W_OUT), DM, DM, DM};
                        pg8::StaticOrder S; S.init(MH / 256, DM / 256, F.G, (int)blockIdx.x, 32);
                        pg8::EpiDelta E{half == 0 ? (bf16_t*)(ws + WS_SPARE) : HB + (size_t)MH * DM, DM, 1.0f};
                        pg8::gemm_phase<pg8::EpiDelta, pg8::StaticOrder, true, true>(F.lds, g, S, E, F.wave);
}
                    }
                    END_PH();
}
{ constexpr int half = 1;
                    bf16_t* MIXh = XN + (size_t)half * MH * DM;
                    if (IN_PH()) {
{ constexpr int rep = 0;
                        pg8::Gemm g{XN + (size_t)half * MH * DM, (const bf16_t*)(ws + W_IN), DM, DM, DM};
                        pg8::StaticOrder S; S.init(MH / 256, IN_WP / 256, F.G, (int)blockIdx.x, 32);
                        pg8::EpiInProj E{PROJ, UG, GATES, args.in[10] + layer * 16, ROPE, half};
                        pg8::gemm_phase<pg8::EpiInProj, pg8::StaticOrder, true, true>(F.lds, g, S, E, F.wave);
}
                    }
                    END_PH();
                    if (IN_PH()) {
{ constexpr int rep = 0;
                        if (EN_MLSTM) { mlstm_conv_phase(F, half, PROJ, QKC, args.in[8] + layer * 5 * 1024, args.in[9] + layer * 1024); mlstm_scalar_phase(F, GATES, MSC); }
}
                        if (!EN_MLSTM) zero_mixed_cols(F, MIXh, 0);
                        if (!EN_DIFF) zero_mixed_cols(F, MIXh, 512);
                        if (!EN_NA) zero_mixed_cols(F, MIXh, 1024);
                        if (!EN_S5) zero_mixed_cols(F, MIXh, 1536);
                        if (EN_S5) { __syncthreads();
                            pg8::Gemm g{UG, (const bf16_t*)(ws + W_S5P), 512, S5K, 512}; pg8::S5OrderA S{F.G, (int)blockIdx.x}; pg8::EpiS5E E{S5E};
                            pg8::gemm_phase<pg8::EpiS5E, pg8::S5OrderA, true, true>(F.lds, g, S, E, F.wave); }
                    }
                    END_PH();
                    if (IN_PH()) {
{ constexpr int rep = 0;
                        if (EN_S5) s5_scan_phase(F, half, S5E, (const float*)(ws + W_LBL), UG);
}
{ constexpr int rep = 0;
                        if (EN_NA) { na_phase(F, half, PROJ, args.in[14] + (size_t)layer * 8 * 465, MIXh); __syncthreads(); }
}
{ constexpr int rep = 0;
                        if (EN_MLSTM) mlstm_state_phase(F, PROJ, QKC, MSC, CST, NST);
}
                    }
                    END_PH();
                    if (IN_PH()) {
                        if (EN_MLSTM) mlstm_scan_phase(F, half, MSC, CST, NST);
{ constexpr int rep = 0;
                        if (EN_S5) { pg8::Gemm g{UG, (const bf16_t*)(ws + W_S5MR), S5K, S5K, S5K}; pg8::S5OrderB S{F.G, (int)blockIdx.x}; pg8::EpiS5Z E{S5Z};
                            pg8::gemm_phase<pg8::EpiS5Z, pg8::S5OrderB, true, true>(F.lds, g, S, E, F.wave); __syncthreads(); }
}
{ constexpr int rep = 0;
                        if (EN_DIFF) diffattn_phase(F, half, layer, PROJ, MIXh, args.in[12] + layer * 256, args.in[13] + layer * 128);
}
                    }
                    END_PH();
                    if (IN_PH()) {
{ constexpr int rep = 0;
                        if (EN_MLSTM) mlstm_out_phase(F, PROJ, QKC, MSC, CST, NST, args.in[11] + layer * GWID, MIXh);
}
                        if (EN_S5) { __syncthreads();
                            pg8::Gemm g{S5Z, (const bf16_t*)(ws + W_GLU), GWID, GWID, GWID}; pg8::StaticOrder S; S.init(MH / 256, GWID / 256, F.G, (int)blockIdx.x);
                            pg8::EpiGlu E{S5Z, args.in[24] + layer * GWID, MIXh};
                            pg8::gemm_phase<pg8::EpiGlu, pg8::StaticOrder, true, true>(F.lds, g, S, E, F.wave); }
                    }
                    END_PH();
                    if (IN_PH()) {
{ constexpr int rep = 0;
                        pg8::Gemm g{MIXh, (const bf16_t*)(ws + W_OUT), DM, DM, DM};
                        pg8::StaticOrder S; S.init(MH / 256, DM / 256, F.G, (int)blockIdx.x, 32);
                        pg8::EpiDelta E{half == 0 ? (bf16_t*)(ws + WS_SPARE) : HB + (size_t)MH * DM, DM, 1.0f};
                        pg8::gemm_phase<pg8::EpiDelta, pg8::StaticOrder, true, true>(F.lds, g, S, E, F.wave);
}
                    }
                    END_PH();
}
            }
}
}
{ constexpr int layer = 1;
        if (IN_PH()) {
{ constexpr int rep = 0;
            convert_ffn_weights(F, args.in[3] + layer * SZ_WGATE, args.in[4] + layer * SZ_WGATE, args.in[5] + layer * SZ_WDOWN, (bf16_t*)(ws + W_GU1), (bf16_t*)(ws + W_D1));
            convert_ffn_weights(F, args.in[27] + layer * SZ_WGATE, args.in[28] + layer * SZ_WGATE, args.in[29] + layer * SZ_WDOWN, (bf16_t*)(ws + W_GU2), (bf16_t*)(ws + W_D2));
            convert_mixer_weights(F, args.in[7] + (size_t)layer * DM * IN_W, args.in[25] + (size_t)layer * DM * DM, args.in[23] + (size_t)layer * GWID * GWID,
                                  (bf16_t*)(ws + W_IN), (bf16_t*)(ws + W_OUT), (bf16_t*)(ws + W_GLU));
}
            if (layer == 0) rope_table_phase(F, ROPE);
            __syncthreads();
{ constexpr int rep = 0;
            if (EN_S5) s5_build_phase(F, layer, args.in, (bf16_t*)(ws + W_S5MR), (bf16_t*)(ws + W_S5P), (float*)(ws + W_LBL));
}
        }
        END_PH();
{ constexpr int f = 0;
            if (IN_PH()) {
{ constexpr int rep = 0;
                const float* g = (f == 0 ? args.in[2] : args.in[26]) + layer * DM;
                if (layer == 0 && f == 0) rms_phase(F, args.in[0], args.in[1], nullptr, nullptr, nullptr, g, XN, nullptr);
                else if (f == 0) rms_phase(F, nullptr, nullptr, XH, XN, XN, g, XN, XH);
                else rms_phase(F, nullptr, nullptr, XH, (const bf16_t*)(ws + WS_SPARE), HB, g, XN, XH);
}
            }
            END_PH();
            if (IN_PH()) {
{ constexpr int rep = 0;
                pg8::Gemm g{XN, (const bf16_t*)(ws + (f == 0 ? W_GU1 : W_GU2)), DM, DM, DM};
                pg8::StaticOrder S; S.init(MTOT / 256, 2 * DFF / 256, F.G, (int)blockIdx.x, 32);
                pg8::EpiSwiglu E{HB, DFF};
                pg8::gemm_phase<pg8::EpiSwiglu, pg8::StaticOrder, true, true>(F.lds, g, S, E, F.wave);
}
            }
            END_PH();
            if (IN_PH()) {
{ constexpr int rep = 0;
                pg8::Gemm g{HB, (const bf16_t*)(ws + (f == 0 ? W_D1 : W_D2)), DFF, DFF, DFF};
                pg8::StaticOrder S; S.init(MTOT / 256, DM / 256, F.G, (int)blockIdx.x, 4, 0);
                pg8::EpiDelta E{XN, DM, 0.5f};
                pg8::gemm_phase<pg8::EpiDelta, pg8::StaticOrder, true, true>(F.lds, g, S, E, F.wave);
}
            }
            END_PH();
            if (f == 0) {
                if (IN_PH()) { if (layer == 0) rms_phase(F, args.in[0], args.in[1], nullptr, XN, XN, args.in[6] + layer * DM, XN, XH);
                    else rms_phase(F, nullptr, nullptr, XH, XN, XN, args.in[6] + layer * DM, XN, XH); }
                END_PH();
{ constexpr int half = 0;
                    bf16_t* MIXh = XN + (size_t)half * MH * DM;
                    if (IN_PH()) {
{ constexpr int rep = 0;
                        pg8::Gemm g{XN + (size_t)half * MH * DM, (const bf16_t*)(ws + W_IN), DM, DM, DM};
                        pg8::StaticOrder S; S.init(MH / 256, IN_WP / 256, F.G, (int)blockIdx.x, 32);
                        pg8::EpiInProj E{PROJ, UG, GATES, args.in[10] + layer * 16, ROPE, half};
                        pg8::gemm_phase<pg8::EpiInProj, pg8::StaticOrder, true, true>(F.lds, g, S, E, F.wave);
}
                    }
                    END_PH();
                    if (IN_PH()) {
{ constexpr int rep = 0;
                        if (EN_MLSTM) { mlstm_conv_phase(F, half, PROJ, QKC, args.in[8] + layer * 5 * 1024, args.in[9] + layer * 1024); mlstm_scalar_phase(F, GATES, MSC); }
}
                        if (!EN_MLSTM) zero_mixed_cols(F, MIXh, 0);
                        if (!EN_DIFF) zero_mixed_cols(F, MIXh, 512);
                        if (!EN_NA) zero_mixed_cols(F, MIXh, 1024);
                        if (!EN_S5) zero_mixed_cols(F, MIXh, 1536);
                        if (EN_S5) { __syncthreads();
                            pg8::Gemm g{UG, (const bf16_t*)(ws + W_S5P), 512, S5K, 512}; pg8::S5OrderA S{F.G, (int)blockIdx.x}; pg8::EpiS5E E{S5E};
                            pg8::gemm_phase<pg8::EpiS5E, pg8::S5OrderA, true, true>(F.lds, g, S, E, F.wave); }
                    }
                    END_PH();
                    if (IN_PH()) {
{ constexpr int rep = 0;
                        if (EN_S5) s5_scan_phase(F, half, S5E, (const float*)(ws + W_LBL), UG);
}
{ constexpr int rep = 0;
                        if (EN_NA) { na_phase(F, half, PROJ, args.in[14] + (size_t)layer * 8 * 465, MIXh); __syncthreads(); }
}
{ constexpr int rep = 0;
                        if (EN_MLSTM) mlstm_state_phase(F, PROJ, QKC, MSC, CST, NST);
}
                    }
                    END_PH();
                    if (IN_PH()) {
                        if (EN_MLSTM) mlstm_scan_phase(F, half, MSC, CST, NST);
{ constexpr int rep = 0;
                        if (EN_S5) { pg8::Gemm g{UG, (const bf16_t*)(ws + W_S5MR), S5K, S5K, S5K}; pg8::S5OrderB S{F.G, (int)blockIdx.x}; pg8::EpiS5Z E{S5Z};
                            pg8::gemm_phase<pg8::EpiS5Z, pg8::S5OrderB, true, true>(F.lds, g, S, E, F.wave); __syncthreads(); }
}
{ constexpr int rep = 0;
                        if (EN_DIFF) diffattn_phase(F, half, layer, PROJ, MIXh, args.in[12] + layer * 256, args.in[13] + layer * 128);
}
                    }
                    END_PH();
                    if (IN_PH()) {
{ constexpr int rep = 0;
                        if (EN_MLSTM) mlstm_out_phase(F, PROJ, QKC, MSC, CST, NST, args.in[11] + layer * GWID, MIXh);
}
                        if (EN_S5) { __syncthreads();
                            pg8::Gemm g{S5Z, (const bf16_t*)(ws + W_GLU), GWID, GWID, GWID}; pg8::StaticOrder S; S.init(MH / 256, GWID / 256, F.G, (int)blockIdx.x);
                            pg8::EpiGlu E{S5Z, args.in[24] + layer * GWID, MIXh};
                            pg8::gemm_phase<pg8::EpiGlu, pg8::StaticOrder, true, true>(F.lds, g, S, E, F.wave); }
                    }
                    END_PH();
                    if (IN_PH()) {
{ constexpr int rep = 0;
                        pg8::Gemm g{MIXh, (const bf16_t*)(ws + W_OUT), DM, DM, DM};
                        pg8::StaticOrder S; S.init(MH / 256, DM / 256, F.G, (int)blockIdx.x, 32);
                        pg8::EpiDelta E{half == 0 ? (bf16_t*)(ws + WS_SPARE) : HB + (size_t)MH * DM, DM, 1.0f};
                        pg8::gemm_phase<pg8::EpiDelta, pg8::StaticOrder, true, true>(F.lds, g, S, E, F.wave);
}
                    }
                    END_PH();
}
{ constexpr int half = 1;
                    bf16_t* MIXh = XN + (size_t)half * MH * DM;
                    if (IN_PH()) {
{ constexpr int rep = 0;
                        pg8::Gemm g{XN + (size_t)half * MH * DM, (const bf16_t*)(ws + W_IN), DM, DM, DM};
                        pg8::StaticOrder S; S.init(MH / 256, IN_WP / 256, F.G, (int)blockIdx.x, 32);
                        pg8::EpiInProj E{PROJ, UG, GATES, args.in[10] + layer * 16, ROPE, half};
                        pg8::gemm_phase<pg8::EpiInProj, pg8::StaticOrder, true, true>(F.lds, g, S, E, F.wave);
}
                    }
                    END_PH();
                    if (IN_PH()) {
{ constexpr int rep = 0;
                        if (EN_MLSTM) { mlstm_conv_phase(F, half, PROJ, QKC, args.in[8] + layer * 5 * 1024, args.in[9] + layer * 1024); mlstm_scalar_phase(F, GATES, MSC); }
}
                        if (!EN_MLSTM) zero_mixed_cols(F, MIXh, 0);
                        if (!EN_DIFF) zero_mixed_cols(F, MIXh, 512);
                        if (!EN_NA) zero_mixed_cols(F, MIXh, 1024);
                        if (!EN_S5) zero_mixed_cols(F, MIXh, 1536);
                        if (EN_S5) { __syncthreads();
                            pg8::Gemm g{UG, (const bf16_t*)(ws + W_S5P), 512, S5K, 512}; pg8::S5OrderA S{F.G, (int)blockIdx.x}; pg8::EpiS5E E{S5E};
                            pg8::gemm_phase<pg8::EpiS5E, pg8::S5OrderA, true, true>(F.lds, g, S, E, F.wave); }
                    }
                    END_PH();
                    if (IN_PH()) {
{ constexpr int rep = 0;
                        if (EN_S5) s5_scan_phase(F, half, S5E, (const float*)(ws + W_LBL), UG);
}
{ constexpr int rep = 0;
                        if (EN_NA) { na_phase(F, half, PROJ, args.in[14] + (size_t)layer * 8 * 465, MIXh); __syncthreads(); }
}
{ constexpr int rep = 0;
                        if (EN_MLSTM) mlstm_state_phase(F, PROJ, QKC, MSC, CST, NST);
}
                    }
                    END_PH();
                    if (IN_PH()) {
                        if (EN_MLSTM) mlstm_scan_phase(F, half, MSC, CST, NST);
{ constexpr int rep = 0;
                        if (EN_S5) { pg8::Gemm g{UG, (const bf16_t*)(ws + W_S5MR), S5K, S5K, S5K}; pg8::S5OrderB S{F.G, (int)blockIdx.x}; pg8::EpiS5Z E{S5Z};
                            pg8::gemm_phase<pg8::EpiS5Z, pg8::S5OrderB, true, true>(F.lds, g, S, E, F.wave); __syncthreads(); }
}
{ constexpr int rep = 0;
                        if (EN_DIFF) diffattn_phase(F, half, layer, PROJ, MIXh, args.in[12] + layer * 256, args.in[13] + layer * 128);
}
                    }
                    END_PH();
                    if (IN_PH()) {
{ constexpr int rep = 0;
                        if (EN_MLSTM) mlstm_out_phase(F, PROJ, QKC, MSC, CST, NST, args.in[11] + layer * GWID, MIXh);
}
                        if (EN_S5) { __syncthreads();
                            pg8::Gemm g{S5Z, (const bf16_t*)(ws + W_GLU), GWID, GWID, GWID}; pg8::StaticOrder S; S.init(MH / 256, GWID / 256, F.G, (int)blockIdx.x);
                            pg8::EpiGlu E{S5Z, args.in[24] + layer * GWID, MIXh};
                            pg8::gemm_phase<pg8::EpiGlu, pg8::StaticOrder, true, true>(F.lds, g, S, E, F.wave); }
                    }
                    END_PH();
                    if (IN_PH()) {
{ constexpr int rep = 0;
                        pg8::Gemm g{MIXh, (const bf16_t*)(ws + W_OUT), DM, DM, DM};
                        pg8::StaticOrder S; S.init(MH / 256, DM / 256, F.G, (int)blockIdx.x, 32);
                        pg8::EpiDelta E{half == 0 ? (bf16_t*)(ws + WS_SPARE) : HB + (size_t)MH * DM, DM, 1.0f};
                        pg8::gemm_phase<pg8::EpiDelta, pg8::StaticOrder, true, true>(F.lds, g, S, E, F.wave);
}
                    }
                    END_PH();
}
            }
}
{ constexpr int f = 1;
            if (IN_PH()) {
{ constexpr int rep = 0;
                const float* g = (f == 0 ? args.in[2] : args.in[26]) + layer * DM;
                if (layer == 0 && f == 0) rms_phase(F, args.in[0], args.in[1], nullptr, nullptr, nullptr, g, XN, nullptr);
                else if (f == 0) rms_phase(F, nullptr, nullptr, XH, XN, XN, g, XN, XH);
                else rms_phase(F, nullptr, nullptr, XH, (const bf16_t*)(ws + WS_SPARE), HB, g, XN, XH);
}
            }
            END_PH();
            if (IN_PH()) {
{ constexpr int rep = 0;
                pg8::Gemm g{XN, (const bf16_t*)(ws + (f == 0 ? W_GU1 : W_GU2)), DM, DM, DM};
                pg8::StaticOrder S; S.init(MTOT / 256, 2 * DFF / 256, F.G, (int)blockIdx.x, 32);
                pg8::EpiSwiglu E{HB, DFF};
                pg8::gemm_phase<pg8::EpiSwiglu, pg8::StaticOrder, true, true>(F.lds, g, S, E, F.wave);
}
            }
            END_PH();
            if (IN_PH()) {
{ constexpr int rep = 0;
                pg8::Gemm g{HB, (const bf16_t*)(ws + (f == 0 ? W_D1 : W_D2)), DFF, DFF, DFF};
                pg8::StaticOrder S; S.init(MTOT / 256, DM / 256, F.G, (int)blockIdx.x, 4, 0);
                pg8::EpiDelta E{XN, DM, 0.5f};
                pg8::gemm_phase<pg8::EpiDelta, pg8::StaticOrder, true, true>(F.lds, g, S, E, F.wave);
}
            }
            END_PH();
            if (f == 0) {
                if (IN_PH()) { if (layer == 0) rms_phase(F, args.in[0], args.in[1], nullptr, XN, XN, args.in[6] + layer * DM, XN, XH);
                    else rms_phase(F, nullptr, nullptr, XH, XN, XN, args.in[6] + layer * DM, XN, XH); }
                END_PH();
{ constexpr int half = 0;
                    bf16_t* MIXh = XN + (size_t)half * MH * DM;
                    if (IN_PH()) {
{ constexpr int rep = 0;
                        pg8::Gemm g{XN + (size_t)half * MH * DM, (const bf16_t*)(ws + W_IN), DM, DM, DM};
                        pg8::StaticOrder S; S.init(MH / 256, IN_WP / 256, F.G, (int)blockIdx.x, 32);
                        pg8::EpiInProj E{PROJ, UG, GATES, args.in[10] + layer * 16, ROPE, half};
                        pg8::gemm_phase<pg8::EpiInProj, pg8::StaticOrder, true, true>(F.lds, g, S, E, F.wave);
}
                    }
                    END_PH();
                    if (IN_PH()) {
{ constexpr int rep = 0;
                        if (EN_MLSTM) { mlstm_conv_phase(F, half, PROJ, QKC, args.in[8] + layer * 5 * 1024, args.in[9] + layer * 1024); mlstm_scalar_phase(F, GATES, MSC); }
}
                        if (!EN_MLSTM) zero_mixed_cols(F, MIXh, 0);
                        if (!EN_DIFF) zero_mixed_cols(F, MIXh, 512);
                        if (!EN_NA) zero_mixed_cols(F, MIXh, 1024);
                        if (!EN_S5) zero_mixed_cols(F, MIXh, 1536);
                        if (EN_S5) { __syncthreads();
                            pg8::Gemm g{UG, (const bf16_t*)(ws + W_S5P), 512, S5K, 512}; pg8::S5OrderA S{F.G, (int)blockIdx.x}; pg8::EpiS5E E{S5E};
                            pg8::gemm_phase<pg8::EpiS5E, pg8::S5OrderA, true, true>(F.lds, g, S, E, F.wave); }
                    }
                    END_PH();
                    if (IN_PH()) {
{ constexpr int rep = 0;
                        if (EN_S5) s5_scan_phase(F, half, S5E, (const float*)(ws + W_LBL), UG);
}
{ constexpr int rep = 0;
                        if (EN_NA) { na_phase(F, half, PROJ, args.in[14] + (size_t)layer * 8 * 465, MIXh); __syncthreads(); }
}
{ constexpr int rep = 0;
                        if (EN_MLSTM) mlstm_state_phase(F, PROJ, QKC, MSC, CST, NST);
}
                    }
                    END_PH();
                    if (IN_PH()) {
                        if (EN_MLSTM) mlstm_scan_phase(F, half, MSC, CST, NST);
{ constexpr int rep = 0;
                        if (EN_S5) { pg8::Gemm g{UG, (const bf16_t*)(ws + W_S5MR), S5K, S5K, S5K}; pg8::S5OrderB S{F.G, (int)blockIdx.x}; pg8::EpiS5Z E{S5Z};
                            pg8::gemm_phase<pg8::EpiS5Z, pg8::S5OrderB, true, true>(F.lds, g, S, E, F.wave); __syncthreads(); }
}
{ constexpr int rep = 0;
                        if (EN_DIFF) diffattn_phase(F, half, layer, PROJ, MIXh, args.in[12] + layer * 256, args.in[13] + layer * 128);
}
                    }
                    END_PH();
                    if (IN_PH()) {
{ constexpr int rep = 0;
                        if (EN_MLSTM) mlstm_out_phase(F, PROJ, QKC, MSC, CST, NST, args.in[11] + layer * GWID, MIXh);
}
                        if (EN_S5) { __syncthreads();
                            pg8::Gemm g{S5Z, (const bf16_t*)(ws + W_GLU), GWID, GWID, GWID}; pg8::StaticOrder S; S.init(MH / 256, GWID / 256, F.G, (int)blockIdx.x);
                            pg8::EpiGlu E{S5Z, args.in[24] + layer * GWID, MIXh};
                            pg8::gemm_phase<pg8::EpiGlu, pg8::StaticOrder, true, true>(F.lds, g, S, E, F.wave); }
                    }
                    END_PH();
                    if (IN_PH()) {
{ constexpr int rep = 0;
                        pg8::Gemm g{MIXh, (const bf16_t*)(ws + W_OUT), DM, DM, DM};
                        pg8::StaticOrder S; S.init(MH / 256, DM / 256, F.G, (int)blockIdx.x, 32);
                        pg8::EpiDelta E{half == 0 ? (bf16_t*)(ws + WS_SPARE) : HB + (size_t)MH * DM, DM, 1.0f};
                        pg8::gemm_phase<pg8::EpiDelta, pg8::StaticOrder, true, true>(F.lds, g, S, E, F.wave);
}
                    }
                    END_PH();
}
{ constexpr int half = 1;
                    bf16_t* MIXh = XN + (size_t)half * MH * DM;
                    if (IN_PH()) {
{ constexpr int rep = 0;
                        pg8::Gemm g{XN + (size_t)half * MH * DM, (const bf16_t*)(ws + W_IN), DM, DM, DM};
                        pg8::StaticOrder S; S.init(MH / 256, IN_WP / 256, F.G, (int)blockIdx.x, 32);
                        pg8::EpiInProj E{PROJ, UG, GATES, args.in[10] + layer * 16, ROPE, half};
                        pg8::gemm_phase<pg8::EpiInProj, pg8::StaticOrder, true, true>(F.lds, g, S, E, F.wave);
}
                    }
                    END_PH();
                    if (IN_PH()) {
{ constexpr int rep = 0;
                        if (EN_MLSTM) { mlstm_conv_phase(F, half, PROJ, QKC, args.in[8] + layer * 5 * 1024, args.in[9] + layer * 1024); mlstm_scalar_phase(F, GATES, MSC); }
}
                        if (!EN_MLSTM) zero_mixed_cols(F, MIXh, 0);
                        if (!EN_DIFF) zero_mixed_cols(F, MIXh, 512);
                        if (!EN_NA) zero_mixed_cols(F, MIXh, 1024);
                        if (!EN_S5) zero_mixed_cols(F, MIXh, 1536);
                        if (EN_S5) { __syncthreads();
                            pg8::Gemm g{UG, (const bf16_t*)(ws + W_S5P), 512, S5K, 512}; pg8::S5OrderA S{F.G, (int)blockIdx.x}; pg8::EpiS5E E{S5E};
                            pg8::gemm_phase<pg8::EpiS5E, pg8::S5OrderA, true, true>(F.lds, g, S, E, F.wave); }
                    }
                    END_PH();
                    if (IN_PH()) {
{ constexpr int rep = 0;
                        if (EN_S5) s5_scan_phase(F, half, S5E, (const float*)(ws + W_LBL), UG);
}
{ constexpr int rep = 0;
                        if (EN_NA) { na_phase(F, half, PROJ, args.in[14] + (size_t)layer * 8 * 465, MIXh); __syncthreads(); }
}
{ constexpr int rep = 0;
                        if (EN_MLSTM) mlstm_state_phase(F, PROJ, QKC, MSC, CST, NST);
}
                    }
                    END_PH();
                    if (IN_PH()) {
                        if (EN_MLSTM) mlstm_scan_phase(F, half, MSC, CST, NST);
{ constexpr int rep = 0;
                        if (EN_S5) { pg8::Gemm g{UG, (const bf16_t*)(ws + W_S5MR), S5K, S5K, S5K}; pg8::S5OrderB S{F.G, (int)blockIdx.x}; pg8::EpiS5Z E{S5Z};
                            pg8::gemm_phase<pg8::EpiS5Z, pg8::S5OrderB, true, true>(F.lds, g, S, E, F.wave); __syncthreads(); }
}
{ constexpr int rep = 0;
                        if (EN_DIFF) diffattn_phase(F, half, layer, PROJ, MIXh, args.in[12] + layer * 256, args.in[13] + layer * 128);
}
                    }
                    END_PH();
                    if (IN_PH()) {
{ constexpr int rep = 0;
                        if (EN_MLSTM) mlstm_out_phase(F, PROJ, QKC, MSC, CST, NST, args.in[11] + layer * GWID, MIXh);
}
                        if (EN_S5) { __syncthreads();
                            pg8::Gemm g{S5Z, (const bf16_t*)(ws + W_GLU), GWID, GWID, GWID}; pg8::StaticOrder S; S.init(MH / 256, GWID / 256, F.G, (int)blockIdx.x);
                            pg8::EpiGlu E{S5Z, args.in[24] + layer * GWID, MIXh};
                            pg8::gemm_phase<pg8::EpiGlu, pg8::StaticOrder, true, true>(F.lds, g, S, E, F.wave); }
                    }
                    END_PH();
                    if (IN_PH()) {
{ constexpr int rep = 0;
                        pg8::Gemm g{MIXh, (const bf16_t*)(ws + W_OUT), DM, DM, DM};
                        pg8::StaticOrder S; S.init(MH / 256, DM / 256, F.G, (int)blockIdx.x, 32);
                        pg8::EpiDelta E{half == 0 ? (bf16_t*)(ws + WS_SPARE) : HB + (size_t)MH * DM, DM, 1.0f};
                        pg8::gemm_phase<pg8::EpiDelta, pg8::StaticOrder, true, true>(F.lds, g, S, E, F.wave);
}
                    }
                    END_PH();
}
            }
}
}
    if (IN_PH()) {
        constexpr int FT = 3072, A_END = MH - FT;
        _Float16* XT = (_Float16*)(ws + WS_SPARE);
        { const long gt = (long)F.vcu * (NWAVES * 64) + opaque_tid(F.wave), NT = (long)F.G * NWAVES * 64;
          for (long i = gt; i < (long)FT * DM / 8; i += NT) *(u32x4*)(XT + i * 8) = *(const u32x4*)(XH + (size_t)(MTOT - FT) * DM + i * 8); }
        final_norm_rows(F, X, XH, XN, args.in[30], 0, MH, 0);
        for (int a0 = 0; a0 < A_END; ) {
            xcd_barrier(bar, F.wave);
            const int a1 = (a0 + MH) / 2;
            final_norm_rows(F, X, XH, XN, args.in[30], MH + a0, MH + a1, 0);
            a0 = a1;
        }
        xcd_barrier(bar, F.wave);
        final_norm_rows(F, X, XT, XN, args.in[30], MTOT - FT, MTOT, MTOT - FT);
        if (xb_ld(ctl + CW_BAR + XB_TMO) != 0u) {
            const int gw = F.vcu * NWAVES + F.wave, NGW = F.G * NWAVES, ln = opaque_tid(F.wave) & 63; const float q = __builtin_nanf("");
            for (int m = gw; m < MTOT; m += NGW) X[(size_t)m * DM + ln] = q;
        }
    }
    ++ph;
#undef IN_PH
#undef END_PH
}

extern "C" void kernel_launch(void* const* d_in, const int* in_sizes, int n_in, void* d_out, int out_size, void* d_ws, size_t ws_size, hipStream_t stream) {
    static int grid = 0;
    if (grid == 0) {
        if (n_in != 31 || out_size != MTOT * DM || ws_size < WS_END) { fprintf(stderr, "kernel_launch: shape mismatch: n_in %d out %d ws %zu (need %zu)\n", n_in, out_size, ws_size, (size_t)WS_END); grid = -1; return; }
        int dev = 0, cus = 0, per_cu = 0;
        if (hipGetDevice(&dev) != hipSuccess || hipDeviceGetAttribute(&cus, hipDeviceAttributeMultiprocessorCount, dev) != hipSuccess) { grid = -1; return; }
        if (hipFuncSetAttribute((const void*)mk_fwd, hipFuncAttributeMaxDynamicSharedMemorySize, LDS_BYTES) != hipSuccess) { fprintf(stderr, "kernel_launch: hipFuncSetAttribute failed\n"); grid = -1; return; }
        if (hipOccupancyMaxActiveBlocksPerMultiprocessor(&per_cu, (const void*)mk_fwd, NWAVES * 64, LDS_BYTES) != hipSuccess || per_cu < 1) { fprintf(stderr, "kernel_launch: occupancy query says %d\n", per_cu); (void)hipGetLastError(); grid = -1; return; }
        grid = cus;
    }
    if (grid < 0) return;
    (void)hipMemsetAsync((char*)d_ws + WS_CTL, 0, CTL_ZERO_BYTES, stream);
    Args a{};
    for (int i = 0; i < 31; ++i) a.in[i] = (const float*)d_in[i];
    a.out = (float*)d_out; a.ws = (unsigned char*)d_ws; a.ph_lo = 0; a.ph_hi = 1 << 30;
    hipLaunchKernelGGL(mk_fwd, dim3(grid), dim3(NWAVES * 64), LDS_BYTES, stream, a);
    const hipError_t le = hipPeekAtLastError();
    if (le != hipSuccess) fprintf(stderr, "kernel_launch: launch failed: %s\n", hipGetErrorName(le));
}
```

```cpp
#include <hip/hip_runtime.h>
#include <cstdio>
#include <cstdint>

#define GAS __attribute__((address_space(1)))
#define LAS __attribute__((address_space(3)))
typedef unsigned short bf16_t;
typedef short bf16x8 __attribute__((ext_vector_type(8)));
typedef float f32x4 __attribute__((ext_vector_type(4)));
typedef float f32x2 __attribute__((ext_vector_type(2)));
typedef float f32x16 __attribute__((ext_vector_type(16)));
typedef unsigned u32x4 __attribute__((ext_vector_type(4)));
typedef unsigned u32x2 __attribute__((ext_vector_type(2)));

constexpr int DM = 2048, DFF = 5632, DEPTH = 2, GWID = 512;
constexpr int T_P = 8192, B_P = 2, T_S = 4096, B_S = 8;
constexpr int M_P = B_P * T_P, M_S = B_S * T_S, MTOT = M_P + M_S;
constexpr float NORM_EPS = 1e-6f;
constexpr int NWAVES = 8;

constexpr size_t MiB = 1u << 20;
constexpr size_t WS_CTL = 0, CTL_ZERO_BYTES = 1 * MiB;
constexpr size_t WS_ROPE = 1 * MiB;
constexpr size_t WS_W = 4 * MiB;
constexpr size_t W_GU1 = WS_W, W_D1 = W_GU1 + 44 * MiB, W_GU2 = W_D1 + 22 * MiB, W_D2 = W_GU2 + 44 * MiB;
constexpr size_t W_IN = W_D2 + 22 * MiB, W_OUT = W_IN + 23 * MiB, W_GLU = W_OUT + 8 * MiB, W_S5MR = W_GLU + 1 * MiB, W_S5P = W_S5MR + 24 * MiB, W_END = W_S5P + 8 * MiB;
constexpr size_t WS_XN = 200 * MiB;
constexpr size_t WS_BIG = 392 * MiB;
constexpr size_t WS_SPARE = 920 * MiB;
constexpr size_t WS_END = 1016 * MiB;
static_assert(W_END <= WS_XN, "weights fit");
constexpr int CW_BAR = 4096;

constexpr int RING_BYTES = 131072;
constexpr int LDSCTL_OFF = RING_BYTES, MISC_OFF = LDSCTL_OFF + 320;
constexpr int LDS_BYTES = 147456;

#define RLX_AGENT __ATOMIC_RELAXED, __HIP_MEMORY_SCOPE_AGENT
#define LDS_WAIT() asm volatile("s_waitcnt lgkmcnt(0)" ::: "memory")
#define VM_WAIT() asm volatile("s_waitcnt vmcnt(0)" ::: "memory")
__device__ __forceinline__ unsigned f2bf(float f) { unsigned u = __builtin_bit_cast(unsigned, f); return (u + 0x7fffu + ((u >> 16) & 1u)) >> 16; }
__device__ __forceinline__ unsigned pk2(float lo, float hi) { return f2bf(lo) | (f2bf(hi) << 16); }
__device__ __forceinline__ float bf2f(unsigned short b) { return __builtin_bit_cast(float, (unsigned)b << 16); }
__device__ __forceinline__ unsigned cvt_pk_bf16(float lo, float hi) { unsigned r; asm volatile("v_cvt_pk_bf16_f32 %0, %1, %2" : "=v"(r) : "v"(lo), "v"(hi)); return r; }
__device__ __forceinline__ float wave_sum(float v) {
#pragma unroll
    for (int o = 1; o < 64; o <<= 1) v += __shfl_xor(v, o);
    return v;
}
__device__ __forceinline__ int opaque_tid(int wave) { int l_; asm volatile("v_mbcnt_lo_u32_b32 %0, -1, 0\n\tv_mbcnt_hi_u32_b32 %0, -1, %0" : "=v"(l_)); return wave * 64 + l_; }
__device__ __forceinline__ float fast_silu(float g) { return g * __builtin_amdgcn_rcpf(1.f + __expf(-g)); }

namespace pg8 {
constexpr int BM = 256, BK = 64, HALF = 128, HTB = HALF * BK * 2, STAGE_BYTES = 8 * HTB, NXCD = 8, WGM = 8;
__host__ __device__ __forceinline__ int lds_byte(int r, int c) { const int st = (r >> 4) * 2 + (c >> 5), rr = r & 15, cc = c & 31, ob = rr * 64 + cc * 2; return st * 1024 + (ob ^ (((ob >> 9) & 1) << 5)); }
__host__ __device__ __forceinline__ void stage_rc(int b, int& R, int& C) { const int st = b / 1024, sb = b % 1024, swz = sb ^ (((sb >> 9) & 1) << 5); R = (st >> 1) * 16 + swz / 64; C = (st & 1) * 32 + (swz % 64) / 2; }
__host__ __device__ __forceinline__ int perm32(int rho) { const int n = rho >> 4, i = rho & 15; return 8 * (i >> 2) + 4 * n + (i & 3); }

struct Unit { int pm, pn; };
struct Gemm { const bf16_t* A; const bf16_t* Bt; int K, lda, ldb; };

struct StaticOrder {
    int nM, nN, nwg, G, c, wgm, rev;
    __host__ __device__ void init(int nM_, int nN_, int G_, int c_, int wgm_ = WGM, int rev_ = 0) { nM = nM_; nN = nN_; nwg = nM * nN; G = G_; c = c_; wgm = wgm_; rev = rev_; }
    __host__ __device__ bool next(int i, Unit& u) const {
        const long L = (long)i * G + c; if (L >= nwg) return false;
        int wgid = rev ? nwg - 1 - (int)L : (int)L;
        const int nig = wgm * nN, gid = wgid / nig, fm = gid * wgm, gsz = (nM - fm) < wgm ? (nM - fm) : wgm;
        u.pm = fm + ((wgid % nig) % gsz); u.pn = (wgid % nig) / gsz; return true;
    }
    __device__ __forceinline__ void a_ready(const Unit&) const {}
    __device__ __forceinline__ void done(const Unit&) const {}
};

template <class Epi, class Sched, bool ALIGN_EPI = false, bool SP2 = false>
__device__ __forceinline__ void gemm_phase(LAS unsigned char* lds, const Gemm g, const Sched& S, const Epi& E, const int wave0) {
    const int tid = opaque_tid(wave0), wid = wave0, lane = tid & 63, wr = wid >> 2, wc = wid & 3, fr = lane & 15, fq = lane >> 4;
    const int K = g.K, nt = K / BK;
    unsigned voffA[2], voffB[2];
#pragma unroll
    for (int i = 0; i < 2; ++i) { int R, C; stage_rc(tid * 16 + i * 8192, R, C); const int Rb = Epi::PERM ? ((R & ~31) + perm32(R & 31)) : R;
        voffA[i] = (unsigned)(R * g.lda + C) * 2u; voffB[i] = (unsigned)(Rb * g.ldb + C) * 2u; }
    const size_t kstep = (size_t)(BK * 2);
    const size_t hstepA = (size_t)HALF * g.lda * 2, hstepB = (size_t)HALF * g.ldb * 2;
    const size_t tstepA = 2 * hstepA, tstepB = 2 * hstepB;
    const unsigned ldsw = (unsigned)wid * 1024u;
    const int aoff = lds_byte(wr * 64 + fr, fq * 8), boff = lds_byte(wc * 32 + fr, fq * 8);
#define PG8_SA(b, h) (((b) * 2 + (h)) * HTB)
#define PG8_SB(b, h) ((4 + (b) * 2 + (h)) * HTB)
#define PG8_STAGE(bufoff, gbase, voff) do { _Pragma("unroll") for (int _i = 0; _i < 2; ++_i) \
        __builtin_amdgcn_global_load_lds((const unsigned*)((const char*)(gbase) + (voff)[_i]), (LAS unsigned*)(lds + (bufoff) + ldsw + _i * 8192), 16, 0, 0); } while (0)
#define PG8_LDA(dst, b, h) do { _Pragma("unroll") for (int m = 0; m < 4; ++m) _Pragma("unroll") for (int k = 0; k < 2; ++k) dst[m][k] = *(const LAS bf16x8*)(lds + PG8_SA(b, h) + aoff + m * 2048 + k * 1024); } while (0)
#define PG8_LDB(dst, b, h) do { _Pragma("unroll") for (int n = 0; n < 2; ++n) _Pragma("unroll") for (int k = 0; k < 2; ++k) dst[n][k] = *(const LAS bf16x8*)(lds + PG8_SB(b, h) + boff + n * 2048 + k * 1024); } while (0)
#define PG8_MMA(ai, bj, At, Bt) do { __builtin_amdgcn_s_setprio(1); _Pragma("unroll") for (int m = 0; m < 4; ++m) _Pragma("unroll") for (int n = 0; n < 2; ++n) _Pragma("unroll") for (int k = 0; k < 2; ++k) \
        acc[ai][bj][m][n] = __builtin_amdgcn_mfma_f32_16x16x32_bf16(Bt[n][k], At[m][k], acc[ai][bj][m][n], 0, 0, 0); __builtin_amdgcn_s_setprio(0); } while (0)
#define PG8_WAIT_V(n) asm volatile("s_waitcnt vmcnt(" #n ")" ::: "memory")
#define PG8_WAIT_L(n) asm volatile("s_waitcnt lgkmcnt(" #n ")" ::: "memory")
#define PG8_BAR __builtin_amdgcn_s_barrier()
#define PG8_SCHED __builtin_amdgcn_sched_barrier(0)
    Unit cur, nxt; int ui = 0;
    if (!S.next(0, cur)) return;
    f32x4 acc[2][2][4][2];
#pragma unroll
    for (int a = 0; a < 2; ++a)
#pragma unroll
        for (int b = 0; b < 2; ++b)
#pragma unroll
            for (int m = 0; m < 4; ++m)
#pragma unroll
                for (int n = 0; n < 2; ++n) acc[a][b][m][n] = (f32x4){0.f, 0.f, 0.f, 0.f};
    bf16x8 At[4][2], B0[2][2], B1[2][2];
    const char* cA = (const char*)g.A + (size_t)cur.pm * tstepA; const char* cB = (const char*)g.Bt + (size_t)cur.pn * tstepB;
    S.a_ready(cur);
    if constexpr (SP2) {
        PG8_STAGE(PG8_SB(0, 0), cB, voffB); PG8_STAGE(PG8_SB(0, 1), cB + hstepB, voffB); PG8_STAGE(PG8_SA(0, 0), cA, voffA); PG8_STAGE(PG8_SA(0, 1), cA + hstepA, voffA);
        if (wr == 1) PG8_BAR;
        PG8_WAIT_V(2); PG8_BAR;
        PG8_STAGE(PG8_SB(1, 0), cB + kstep, voffB); PG8_STAGE(PG8_SA(1, 0), cA + kstep, voffA); PG8_STAGE(PG8_SB(1, 1), cB + hstepB + kstep, voffB);
        PG8_WAIT_V(6); PG8_BAR;
    } else {
        PG8_STAGE(PG8_SB(0, 0), cB, voffB); PG8_STAGE(PG8_SA(0, 0), cA, voffA); PG8_STAGE(PG8_SB(0, 1), cB + hstepB, voffB); PG8_STAGE(PG8_SA(0, 1), cA + hstepA, voffA);
        if (wr == 1) PG8_BAR;
        PG8_WAIT_V(4); PG8_BAR;
        PG8_STAGE(PG8_SB(1, 0), cB + kstep, voffB); PG8_STAGE(PG8_SA(1, 0), cA + kstep, voffA); PG8_STAGE(PG8_SB(1, 1), cB + hstepB + kstep, voffB);
        PG8_WAIT_V(6); PG8_BAR;
    }
    for (;;) {
        const bool has_next = S.next(ui + 1, nxt);
        const char* nA = has_next ? (const char*)g.A + (size_t)nxt.pm * tstepA : cA; const char* nB = has_next ? (const char*)g.Bt + (size_t)nxt.pn * tstepB : cB;
        for (int t = 0; t < nt; t += 2) {
            const bool last = (t == nt - 2);
            const char* a1 = cA + (size_t)(t + 1) * kstep;
            const char* a2 = last ? nA : cA + (size_t)(t + 2) * kstep; const char* b2 = last ? nB : cB + (size_t)(t + 2) * kstep;
            const char* a3 = a2 + kstep; const char* b3 = b2 + kstep;
            if (last && has_next) S.a_ready(nxt);
            if constexpr (SP2) {
            PG8_LDB(B0, 0, 0); PG8_LDB(B1, 0, 1); PG8_SCHED; PG8_LDA(At, 0, 0); PG8_STAGE(PG8_SA(1, 1), a1 + hstepA, voffA);
            PG8_WAIT_V(8); PG8_WAIT_L(0); PG8_BAR; PG8_MMA(0, 0, At, B0); PG8_MMA(0, 1, At, B1); PG8_BAR; PG8_SCHED;
            PG8_LDA(At, 0, 1); PG8_STAGE(PG8_SB(0, 0), b2, voffB); PG8_STAGE(PG8_SB(0, 1), b2 + hstepB, voffB); PG8_STAGE(PG8_SA(0, 0), a2, voffA);
            PG8_WAIT_V(8); PG8_WAIT_L(0); PG8_BAR; PG8_MMA(1, 0, At, B0); PG8_MMA(1, 1, At, B1); PG8_BAR; PG8_SCHED;
            PG8_LDB(B0, 1, 0); PG8_LDB(B1, 1, 1); PG8_SCHED; PG8_LDA(At, 1, 0); PG8_STAGE(PG8_SA(0, 1), a2 + hstepA, voffA);
            PG8_WAIT_V(8); PG8_WAIT_L(0); PG8_BAR; PG8_MMA(0, 0, At, B0); PG8_MMA(0, 1, At, B1); PG8_BAR; PG8_SCHED;
            PG8_LDA(At, 1, 1); PG8_STAGE(PG8_SB(1, 0), b3, voffB); PG8_STAGE(PG8_SB(1, 1), b3 + hstepB, voffB); PG8_STAGE(PG8_SA(1, 0), a3, voffA);
            PG8_WAIT_V(8); PG8_WAIT_L(0); PG8_BAR; PG8_MMA(1, 0, At, B0); PG8_MMA(1, 1, At, B1); PG8_BAR; PG8_SCHED;
            } else {
            PG8_LDB(B0, 0, 0); PG8_SCHED; PG8_LDA(At, 0, 0); PG8_STAGE(PG8_SA(1, 1), a1 + hstepA, voffA);
            PG8_WAIT_L(8); PG8_BAR; PG8_WAIT_L(0); PG8_MMA(0, 0, At, B0); PG8_BAR; PG8_SCHED;
            PG8_LDB(B1, 0, 1); PG8_STAGE(PG8_SB(0, 0), b2, voffB);
            PG8_BAR; PG8_WAIT_L(0); PG8_MMA(0, 1, At, B1); PG8_BAR;
            PG8_LDA(At, 0, 1); PG8_STAGE(PG8_SA(0, 0), a2, voffA);
            PG8_BAR; PG8_WAIT_L(0); PG8_MMA(1, 0, At, B0); PG8_BAR; PG8_SCHED;
            PG8_STAGE(PG8_SB(0, 1), b2 + hstepB, voffB);
            PG8_WAIT_V(6); PG8_BAR; PG8_MMA(1, 1, At, B1); PG8_BAR;
            PG8_LDB(B0, 1, 0); PG8_SCHED; PG8_LDA(At, 1, 0); PG8_STAGE(PG8_SA(0, 1), a2 + hstepA, voffA);
            PG8_WAIT_L(8); PG8_BAR; PG8_WAIT_L(0); PG8_MMA(0, 0, At, B0); PG8_BAR; PG8_SCHED;
            PG8_LDB(B1, 1, 1); PG8_STAGE(PG8_SB(1, 0), b3, voffB);
            PG8_BAR; PG8_WAIT_L(0); PG8_MMA(0, 1, At, B1); PG8_BAR;
            PG8_LDA(At, 1, 1); PG8_STAGE(PG8_SA(1, 0), a3, voffA);
            PG8_BAR; PG8_WAIT_L(0); PG8_MMA(1, 0, At, B0); PG8_BAR; PG8_SCHED;
            PG8_STAGE(PG8_SB(1, 1), b3 + hstepB, voffB);
            PG8_WAIT_V(6); PG8_BAR; PG8_MMA(1, 1, At, B1); PG8_BAR;
            }
        }
        if constexpr (ALIGN_EPI) { if (wr == 0) PG8_BAR; }
        E(acc, cur, wr, wc, fr, fq); S.done(cur);
        if (!has_next) break;
#pragma unroll
        for (int a = 0; a < 2; ++a)
#pragma unroll
            for (int b = 0; b < 2; ++b)
#pragma unroll
                for (int m = 0; m < 4; ++m)
#pragma unroll
                    for (int n = 0; n < 2; ++n) acc[a][b][m][n] = (f32x4){0.f, 0.f, 0.f, 0.f};
        cur = nxt; cA = nA; cB = nB; ++ui;
        if constexpr (ALIGN_EPI) { if (wr == 1) PG8_BAR; }
    }
    PG8_WAIT_V(0);
    if constexpr (!ALIGN_EPI) { if (wr == 0) PG8_BAR; }
    PG8_BAR;
#undef PG8_SA
#undef PG8_SB
#undef PG8_STAGE
#undef PG8_LDA
#undef PG8_LDB
#undef PG8_MMA
#undef PG8_WAIT_V
#undef PG8_WAIT_L
#undef PG8_BAR
#undef PG8_SCHED
}

struct EpiSwiglu {
    static constexpr bool PERM = true;
    bf16_t* H; int ldh;
    __device__ __forceinline__ void operator()(const f32x4 (&acc)[2][2][4][2], const Unit& u, int wr, int wc, int fr, int fq) const {
        const int row0 = u.pm * BM + wr * 64 + fr, col0 = u.pn * HALF + wc * 32 + 8 * fq;
#pragma unroll
        for (int ai = 0; ai < 2; ++ai)
#pragma unroll
            for (int m = 0; m < 4; ++m) {
                bf16_t* rowp = H + (size_t)(row0 + ai * HALF + m * 16) * ldh + col0;
                const f32x4 g0 = acc[ai][0][m][0], g1 = acc[ai][0][m][1], u0 = acc[ai][1][m][0], u1 = acc[ai][1][m][1];
                u32x4 w;
                w.x = cvt_pk_bf16(fast_silu(g0[0]) * u0[0], fast_silu(g0[1]) * u0[1]); w.y = cvt_pk_bf16(fast_silu(g0[2]) * u0[2], fast_silu(g0[3]) * u0[3]);
                w.z = cvt_pk_bf16(fast_silu(g1[0]) * u1[0], fast_silu(g1[1]) * u1[1]); w.w = cvt_pk_bf16(fast_silu(g1[2]) * u1[2], fast_silu(g1[3]) * u1[3]);
                *(u32x4*)rowp = w;
            }
    }
};
struct EpiDelta {
    static constexpr bool PERM = true;
    bf16_t* D; int ldd; float s;
    __device__ __forceinline__ void operator()(const f32x4 (&acc)[2][2][4][2], const Unit& u, int wr, int wc, int fr, int fq) const {
        const int row0 = u.pm * BM + wr * 64 + fr, col0 = u.pn * BM + wc * 32 + 8 * fq;
#pragma unroll
        for (int ai = 0; ai < 2; ++ai)
#pragma unroll
            for (int m = 0; m < 4; ++m) { bf16_t* rowp = D + (size_t)(row0 + ai * HALF + m * 16) * ldd + col0;
#pragma unroll
                for (int bj = 0; bj < 2; ++bj) { const f32x4 v0 = acc[ai][bj][m][0] * s, v1 = acc[ai][bj][m][1] * s;
                    u32x4 w; w.x = cvt_pk_bf16(v0[0], v0[1]); w.y = cvt_pk_bf16(v0[2], v0[3]); w.z = cvt_pk_bf16(v1[0], v1[1]); w.w = cvt_pk_bf16(v1[2], v1[3]);
                    *(u32x4*)(rowp + bj * HALF) = w; } }
    }
};
struct EpiResid {
    static constexpr bool PERM = true;
    float* X; int ldx; float s;
    __device__ __forceinline__ void operator()(const f32x4 (&acc)[2][2][4][2], const Unit& u, int wr, int wc, int fr, int fq) const {
        const int row0 = u.pm * BM + wr * 64 + fr, col0 = u.pn * BM + wc * 32 + 8 * fq;
#pragma unroll
        for (int ai = 0; ai < 2; ++ai)
#pragma unroll
            for (int m = 0; m < 4; ++m) {
                float* rowp = X + (size_t)(row0 + ai * HALF + m * 16) * ldx + col0;
#pragma unroll
                for (int bj = 0; bj < 2; ++bj) {
                    f32x4 a = *(const f32x4*)(rowp + bj * HALF), b = *(const f32x4*)(rowp + bj * HALF + 4);
                    a = a + acc[ai][bj][m][0] * s; b = b + acc[ai][bj][m][1] * s;
                    *(f32x4*)(rowp + bj * HALF) = a; *(f32x4*)(rowp + bj * HALF + 4) = b;
                }
            }
    }
};
}

#define XB_TMO      128
#define XB_XCNT(j)  (256  + 64 * (j))
#define XB_XSUB(j)  (1280 + 64 * (j))
#define XB_XGEN(j)  (2304 + 64 * (j))
#define XB_TOP      3328
#define XB_TOPGEN   3392
#define XCD_BAR_WORDS 3456
#define XB_SPIN_CAP (1u << 18)
__device__ __forceinline__ unsigned xb_ld(unsigned* p)              { return __hip_atomic_load(p, __ATOMIC_RELAXED, __HIP_MEMORY_SCOPE_AGENT); }
__device__ __forceinline__ unsigned xb_add(unsigned* p, unsigned v) { return __hip_atomic_fetch_add(p, v, __ATOMIC_RELAXED, __HIP_MEMORY_SCOPE_AGENT); }
__device__ __forceinline__ unsigned xb_xcc_id() { return (unsigned)__builtin_amdgcn_s_getreg((3 << 11) | 20) & 0xFu; }
#define XB_SPIN(cond, bar) do { unsigned _sp = 0; while (cond) { __builtin_amdgcn_s_sleep(1); \
    if ((++_sp & 255u) == 0u) { if (xb_ld(&(bar)[XB_TMO])) break; if (_sp > XB_SPIN_CAP) { atomicAdd(&(bar)[XB_TMO], 1u); break; } } } } while (0)
struct XcdBarrier { unsigned* bar; unsigned x; volatile LAS unsigned* st; };
__device__ __forceinline__ XcdBarrier xcd_barrier_post(unsigned* bar, volatile LAS unsigned* st) {
    XcdBarrier b; b.bar = bar; b.x = xb_xcc_id(); b.st = st;
    if (threadIdx.x == 0) (void)xb_add(&bar[XB_XCNT(b.x)], 1u);
    return b;
}
__device__ __forceinline__ void xcd_barrier_complete(unsigned* bar, unsigned x, unsigned& nloc, unsigned& nx) {
    const unsigned G = gridDim.x * gridDim.y * gridDim.z;
    unsigned sum, cnt, mine, sp = 0u;
    for (;;) {
        sum = 0u; cnt = 0u; mine = 0u;
#pragma unroll
        for (unsigned j = 0; j < 16; ++j) { const unsigned c = xb_ld(&bar[XB_XCNT(j)]); sum += c; cnt += (c > 0u) ? 1u : 0u; mine = (j == x) ? c : mine; }
        if (sum == G) break;
        __builtin_amdgcn_s_sleep(1);
        if ((++sp & 255u) == 0u) { if (xb_ld(&bar[XB_TMO])) break; if (sp > XB_SPIN_CAP) { atomicAdd(&bar[XB_TMO], 1u); break; } }
    }
    nloc = mine > 0u ? mine : 1u; nx = cnt > 0u ? cnt : 1u;
}
__device__ __forceinline__ void xcd_barrier(const XcdBarrier& b, const int wave) {
    asm volatile("s_waitcnt vmcnt(0)" ::: "memory");
    __syncthreads();
    if (opaque_tid(wave) == 0) {
        unsigned* bar = b.bar;
        __builtin_amdgcn_s_waitcnt(0);
        unsigned nloc = b.st[0], nx = b.st[1];
        if (nloc == 0u) { xcd_barrier_complete(bar, b.x, nloc, nx); b.st[0] = nloc; b.st[1] = nx; }
        const unsigned old = xb_add(&bar[XB_XSUB(b.x)], 1u);
        const unsigned gen = old / nloc;
        if (old + 1u == (gen + 1u) * nloc) {
            __builtin_amdgcn_fence(__ATOMIC_RELEASE, "agent");
            asm volatile("s_waitcnt vmcnt(0)" ::: "memory");
            const unsigned og = xb_add(&bar[XB_TOP], 1u);
            const unsigned tg = og / nx;
            if (og + 1u == (tg + 1u) * nx) xb_add(&bar[XB_TOPGEN], 1u);
            else XB_SPIN(xb_ld(&bar[XB_TOPGEN]) == tg, bar);
            __builtin_amdgcn_fence(__ATOMIC_ACQUIRE, "agent");
            xb_add(&bar[XB_XGEN(b.x)], 1u);
            asm volatile("s_waitcnt vmcnt(0)" ::: "memory");
        } else {
            XB_SPIN(xb_ld(&bar[XB_XGEN(b.x)]) == gen, bar);
            __builtin_amdgcn_fence(__ATOMIC_ACQUIRE, "agent");
            asm volatile("s_waitcnt vmcnt(0)" ::: "memory");
        }
    }
    __syncthreads();
}

struct Frame {
    LAS unsigned char* lds;
    volatile LAS unsigned* MISC;
    int tid, lane, wave, vcu, G;
};
#define PHASE_FRAME(F0) Frame F = (F0); { const int t_ = opaque_tid(F.wave); F.tid = t_; F.lane = t_ & 63; }

__device__ __forceinline__ void tr_item(const float* W, int ldw, bf16_t* WT, int ldt, int k0, int s0, int d0, int nvalid, LAS float* scr, int lane, bool perm = false) {
    if (!perm && nvalid == 32) {
        const int r8 = lane >> 3, n4 = (lane & 7) * 4;
        f32x4 v[8];
#pragma unroll
        for (int i = 0; i < 8; ++i) v[i] = *(const f32x4*)(W + (size_t)(k0 + 8 * i + r8) * ldw + s0 + n4);
#pragma unroll
        for (int i = 0; i < 8; ++i) { LAS float* p = scr + (8 * i + r8) * 33 + n4; p[0] = v[i].x; p[1] = v[i].y; p[2] = v[i].z; p[3] = v[i].w; }
    } else {
        const int c32 = lane & 31, sc = perm ? s0 + (c32 >> 1) + 32 * (c32 & 1) : s0 + c32;
#pragma unroll 8
        for (int i = 0; i < 32; ++i) { const int kk = 2 * i + (lane >> 5); scr[kk * 33 + c32] = (c32 < nvalid) ? W[(size_t)(k0 + kk) * ldw + sc] : 0.f; }
    }
    LDS_WAIT(); asm volatile("" ::: "memory");
    const int c = lane & 7;
#pragma unroll
    for (int j = 0; j < 4; ++j) { const int n = (lane >> 3) + 8 * j; const LAS float* s = scr + (8 * c) * 33 + n;
        u32x4 o; o.x = pk2(s[0 * 33], s[1 * 33]); o.y = pk2(s[2 * 33], s[3 * 33]); o.z = pk2(s[4 * 33], s[5 * 33]); o.w = pk2(s[6 * 33], s[7 * 33]);
        *(u32x4*)(WT + (size_t)(d0 + n) * ldt + k0 + 8 * c) = o; }
    LDS_WAIT(); asm volatile("" ::: "memory");
}

typedef _Float16 f16x4 __attribute__((ext_vector_type(4)));
__device__ __forceinline__ void rms_phase(const Frame& F0, const float* srcP, const float* srcS, const _Float16* srcH, const bf16_t* deltaLo, const bf16_t* deltaHi, const float* g, bf16_t* dst, _Float16* xout) {
    PHASE_FRAME(F0);
    const int gw = F.vcu * NWAVES + F.wave, NGW = F.G * NWAVES;
    f32x4 gv[8];
#pragma unroll
    for (int j = 0; j < 8; ++j) gv[j] = *(const f32x4*)(g + 4 * F.lane + 256 * j);
    for (int m = gw; m < MTOT; m += NGW) {
        f32x4 v[8]; float s = 0.f;
        if (srcH) {
#pragma unroll
            for (int j = 0; j < 8; ++j) { const f16x4 h = *(const f16x4*)(srcH + (size_t)m * DM + 4 * F.lane + 256 * j); v[j] = (f32x4){(float)h.x, (float)h.y, (float)h.z, (float)h.w}; }
        } else {
            const float* xrow = (m < M_P) ? srcP + (size_t)m * DM : srcS + (size_t)(m - M_P) * DM;
#pragma unroll
            for (int j = 0; j < 8; ++j) v[j] = *(const f32x4*)(xrow + 4 * F.lane + 256 * j);
        }
        if (deltaLo) {
            const bf16_t* delta = m < MTOT / 2 ? deltaLo : deltaHi;
#pragma unroll
            for (int j = 0; j < 8; ++j) { const u32x2 d = *(const u32x2*)(delta + (size_t)m * DM + 4 * F.lane + 256 * j);
                v[j].x += __builtin_bit_cast(float, d.x << 16); v[j].y += __builtin_bit_cast(float, d.x & 0xffff0000u); v[j].z += __builtin_bit_cast(float, d.y << 16); v[j].w += __builtin_bit_cast(float, d.y & 0xffff0000u); }
        }
#pragma unroll
        for (int j = 0; j < 8; ++j) s += (v[j].x * v[j].x + v[j].y * v[j].y) + (v[j].z * v[j].z + v[j].w * v[j].w);
        const float r = 1.f / sqrtf(wave_sum(s) * (1.f / DM) + NORM_EPS);
        bf16_t* orow = dst + (size_t)m * DM;
#pragma unroll
        for (int j = 0; j < 8; ++j) {
            if (xout) *(f16x4*)(xout + (size_t)m * DM + 4 * F.lane + 256 * j) = (f16x4){(_Float16)v[j].x, (_Float16)v[j].y, (_Float16)v[j].z, (_Float16)v[j].w};
            const f32x4 y = v[j] * r * gv[j];
            u32x2 o; o.x = pk2(y.x, y.y); o.y = pk2(y.z, y.w);
            *(u32x2*)(orow + 4 * F.lane + 256 * j) = o;
        }
    }
}
__device__ __forceinline__ void final_norm_rows(const Frame& F0, float* OUT, const _Float16* XH, const bf16_t* delta, const float* g, int m0, int m1, int src_base) {
    PHASE_FRAME(F0);
    const int gw = F.vcu * NWAVES + F.wave, NGW = F.G * NWAVES;
    for (int m = m0 + gw; m < m1; m += NGW) {
        f32x4 v[8]; float s = 0.f;
#pragma unroll
        for (int j = 0; j < 8; ++j) { const f16x4 h = *(const f16x4*)(XH + (size_t)(m - src_base) * DM + 4 * F.lane + 256 * j); const u32x2 d = *(const u32x2*)(delta + (size_t)m * DM + 4 * F.lane + 256 * j);
            v[j].x = (float)h.x + __builtin_bit_cast(float, d.x << 16); v[j].y = (float)h.y + __builtin_bit_cast(float, d.x & 0xffff0000u);
            v[j].z = (float)h.z + __builtin_bit_cast(float, d.y << 16); v[j].w = (float)h.w + __builtin_bit_cast(float, d.y & 0xffff0000u);
            s += (v[j].x * v[j].x + v[j].y * v[j].y) + (v[j].z * v[j].z + v[j].w * v[j].w); }
        const float r = 1.f / sqrtf(wave_sum(s) * (1.f / DM) + NORM_EPS);
#pragma unroll
        for (int j = 0; j < 8; ++j) *(f32x4*)(OUT + (size_t)m * DM + 4 * F.lane + 256 * j) = v[j] * r * (*(const f32x4*)(g + 4 * F.lane + 256 * j));
    }
}

__device__ __forceinline__ void convert_ffn_weights(const Frame& F0, const float* wg, const float* wu, const float* wd, bf16_t* GU, bf16_t* D) {
    PHASE_FRAME(F0);
    LAS float* scr = (LAS float*)(F.lds + F.wave * 16384);
    const int gw = F.vcu * NWAVES + F.wave, NGW = F.G * NWAVES;
    constexpr int NB_FF = DFF / 32, KB_DM = DM / 64, I_G = KB_DM * NB_FF;
    constexpr int NB_DM = DM / 32, KB_FF = DFF / 64, I_D = KB_FF * NB_DM;
    for (int it = gw; it < 2 * I_G + I_D; it += NGW) {
        if (it < 2 * I_G) {
            const int up = it >= I_G, r = it - up * I_G, kb = r / NB_FF, nb = r % NB_FF, n0 = nb * 32;
            const int d0 = 256 * (n0 >> 7) + (n0 & 127) + up * 128;
            tr_item(up ? wu : wg, DFF, GU, DM, kb * 64, n0, d0, 32, scr, F.lane);
        } else {
            const int r = it - 2 * I_G, kb = r / NB_DM, nb = r % NB_DM;
            tr_item(wd, DM, D, DFF, kb * 64, nb * 32, nb * 32, 32, scr, F.lane);
        }
    }
}

constexpr int MH = MTOT / 2;
constexpr int IN_W = 5648, IN_WP = 5888, PRJ_LD = 5120;
constexpr int PC_MQ = 0, PC_MK = 512, PC_MV = 1024, PC_MO = 1536, PC_DQ = 2048, PC_DK = 2560, PC_DV = 3072, PC_NQ = 3584, PC_NK = 4096, PC_NV = 4608;
constexpr int S5L = 32, S5NCH = MH / S5L, S5K = 16 * S5L + 256;
constexpr size_t MX_PROJ = WS_BIG, MX_UG = MX_PROJ + 240 * MiB, MX_QKC = MX_UG + 36 * MiB, MX_CST = MX_QKC + 48 * MiB, MX_E = MX_CST + 96 * MiB, MX_Z = MX_E + 24 * MiB;
constexpr size_t MX_GATES = MX_Z + 24 * MiB, MX_NST = MX_GATES + 2 * MiB, MX_MSC = MX_NST + 2 * MiB, MX_END = MX_MSC + 4 * MiB;
static_assert(MX_END <= WS_END, "mixer buffers fit in BIG");
constexpr float QSCALE = 0.125f * 1.4426950408889634f;

__device__ __forceinline__ int tpos(int half, int row) { return (half == 0 && row < 16384) ? (row & 8191) : (row & 4095); }

typedef short v4i16_t __attribute__((ext_vector_type(4)));
__device__ __forceinline__ unsigned off_a(unsigned row, unsigned ch) { return 2048u * (row >> 3) + 512u * (ch >> 2) + 64u * (row & 7) + 16u * ((ch & 3) ^ ((row >> 2) & 3)); }
struct FragBase { unsigned r0, r1, t0, t1; };
__device__ __forceinline__ FragBase make_fragbase(int lane) {
    const unsigned r32 = lane & 31, h = lane >> 5, blk = (lane >> 4) & 1, q = (lane & 15) >> 2, p = lane & 3;
    FragBase fb;
    fb.r0 = 2048u * (r32 >> 3) + 64u * (r32 & 7) + 16u * (((0u + h) & 3) ^ ((r32 >> 2) & 3));
    fb.r1 = 2048u * (r32 >> 3) + 64u * (r32 & 7) + 16u * (((2u + h) & 3) ^ ((r32 >> 2) & 3));
    fb.t0 = 2048u * h + 64u * q + 16u * ((2u * blk + (p >> 1)) ^ ((2u * h) & 3)) + 8u * (p & 1);
    fb.t1 = 2048u * h + 256u + 64u * q + 16u * ((2u * blk + (p >> 1)) ^ ((2u * h + 1u) & 3)) + 8u * (p & 1);
    return fb;
}
__device__ __forceinline__ bf16x8 rowfrag(const LAS unsigned char* tile, int rb, int s, const FragBase& fb) {
    return *(const LAS bf16x8*)(tile + rb * 8192 + (s >> 1) * 512 + ((s & 1) ? fb.r1 : fb.r0));
}
__device__ __forceinline__ bf16x8 trfrag(const LAS unsigned char* tile, int c, int ks, const FragBase& fb) {
    const v4i16_t lo = __builtin_amdgcn_ds_read_tr16_b64_v4i16((LAS v4i16_t*)(tile + ks * 4096 + c * 512 + fb.t0));
    const v4i16_t hi = __builtin_amdgcn_ds_read_tr16_b64_v4i16((LAS v4i16_t*)(tile + ks * 4096 + c * 512 + fb.t1));
    return (bf16x8){lo[0], lo[1], lo[2], lo[3], hi[0], hi[1], hi[2], hi[3]};
}
__device__ __forceinline__ float max3f(float a, float b, float c) { float r; asm("v_max3_f32 %0, %1, %2, %3" : "=v"(r) : "v"(a), "v"(b), "v"(c)); return r; }
#define SBAR() __builtin_amdgcn_sched_barrier(0)
__device__ __forceinline__ int crow(int r, int hi) { return (r & 3) + 8 * (r >> 2) + 4 * hi; }
#define MFMA32(a, b, c) __builtin_amdgcn_mfma_f32_32x32x16_bf16((a), (b), (c), 0, 0, 0)
__device__ __forceinline__ float swap_max(float v) { auto rr = __builtin_amdgcn_permlane32_swap(__float_as_uint(v), __float_as_uint(v), false, false); return fmaxf(__uint_as_float(rr[0]), __uint_as_float(rr[1])); }
__device__ __forceinline__ float swap_add(float v) { auto rr = __builtin_amdgcn_permlane32_swap(__float_as_uint(v), __float_as_uint(v), false, false); return __uint_as_float(rr[0]) + __uint_as_float(rr[1]); }
#define PK4(P, BASE, OUT) do { unsigned a0_ = cvt_pk_bf16(P[BASE + 0], P[BASE + 1]), a1_ = cvt_pk_bf16(P[BASE + 2], P[BASE + 3]); \
    unsigned b0_ = cvt_pk_bf16(P[BASE + 4], P[BASE + 5]), b1_ = cvt_pk_bf16(P[BASE + 6], P[BASE + 7]); \
    auto r0_ = __builtin_amdgcn_permlane32_swap(a0_, b0_, false, false); auto r1_ = __builtin_amdgcn_permlane32_swap(a1_, b1_, false, false); \
    u32x4 w_ = {r0_[0], r1_[0], r0_[1], r1_[1]}; OUT = __builtin_bit_cast(bf16x8, w_); } while (0)

namespace pg8 {
struct EpiInProj {
    static constexpr bool PERM = true;
    bf16_t* P; bf16_t* UG; float* GT; const float* gbias; const float* rope; int half;
    __device__ __forceinline__ void operator()(const f32x4 (&acc)[2][2][4][2], const Unit& u, int wr, int wc, int fr, int fq) const {
        const int row0 = u.pm * BM + wr * 64 + fr;
        if (u.pn >= 8 && u.pn < 12) {
            const float sc = u.pn < 10 ? QSCALE : 1.f;
#pragma unroll
            for (int ai = 0; ai < 2; ++ai)
#pragma unroll
                for (int m = 0; m < 4; ++m) { const int row = row0 + ai * HALF + m * 16; bf16_t* rowp = P + (size_t)row * PRJ_LD + u.pn * BM + wc * 32 + 8 * fq;
                    const float* tb = rope + ((size_t)tpos(half, row) * 32 + (((wc * 32 + 8 * fq) & 63) >> 1)) * 2;
                    const f32x4 cs0 = *(const f32x4*)tb, cs1 = *(const f32x4*)(tb + 4);
#pragma unroll
                    for (int bj = 0; bj < 2; ++bj) { const f32x4 v0 = acc[ai][bj][m][0], v1 = acc[ai][bj][m][1];
                        u32x4 w;
                        w.x = cvt_pk_bf16((v0[0] * cs0[0] - v0[1] * cs0[1]) * sc, (v0[1] * cs0[0] + v0[0] * cs0[1]) * sc);
                        w.y = cvt_pk_bf16((v0[2] * cs0[2] - v0[3] * cs0[3]) * sc, (v0[3] * cs0[2] + v0[2] * cs0[3]) * sc);
                        w.z = cvt_pk_bf16((v1[0] * cs1[0] - v1[1] * cs1[1]) * sc, (v1[1] * cs1[0] + v1[0] * cs1[1]) * sc);
                        w.w = cvt_pk_bf16((v1[2] * cs1[2] - v1[3] * cs1[3]) * sc, (v1[3] * cs1[2] + v1[2] * cs1[3]) * sc);
                        *(u32x4*)(rowp + bj * HALF) = w; } }
        } else if (u.pn < 20) {
            const int col0 = u.pn * BM + wc * 32 + 8 * fq;
#pragma unroll
            for (int ai = 0; ai < 2; ++ai)
#pragma unroll
                for (int m = 0; m < 4; ++m) { bf16_t* rowp = P + (size_t)(row0 + ai * HALF + m * 16) * PRJ_LD + col0;
#pragma unroll
                    for (int bj = 0; bj < 2; ++bj) { const f32x4 v0 = acc[ai][bj][m][0], v1 = acc[ai][bj][m][1];
                        u32x4 w; w.x = cvt_pk_bf16(v0[0], v0[1]); w.y = cvt_pk_bf16(v0[2], v0[3]); w.z = cvt_pk_bf16(v1[0], v1[1]); w.w = cvt_pk_bf16(v1[2], v1[3]);
                        *(u32x4*)(rowp + bj * HALF) = w; } }
        } else if (u.pn < 22) {
#pragma unroll
            for (int ai = 0; ai < 2; ++ai)
#pragma unroll
                for (int m = 0; m < 4; ++m) { const int row = row0 + ai * HALF + m * 16, chunk = row / S5L, i = row % S5L;
#pragma unroll
                    for (int bj = 0; bj < 2; ++bj) { const int col = (u.pn - 20) * BM + bj * HALF + wc * 32 + 8 * fq, g = col >> 4, c0 = col & 15;
                        const f32x4 v0 = acc[ai][bj][m][0], v1 = acc[ai][bj][m][1];
                        u32x4 w; w.x = cvt_pk_bf16(v0[0], v0[1]); w.y = cvt_pk_bf16(v0[2], v0[3]); w.z = cvt_pk_bf16(v1[0], v1[1]); w.w = cvt_pk_bf16(v1[2], v1[3]);
                        *(u32x4*)(UG + ((size_t)g * S5NCH + chunk) * S5K + i * 16 + c0) = w; } }
        } else {
            if (wc == 0 && fq < 2) {
                const f32x4 b0 = *(const f32x4*)(gbias + 8 * fq), b1 = *(const f32x4*)(gbias + 8 * fq + 4);
#pragma unroll
                for (int ai = 0; ai < 2; ++ai)
#pragma unroll
                    for (int m = 0; m < 4; ++m) { float* gp = GT + (size_t)(row0 + ai * HALF + m * 16) * 16 + 8 * fq;
                        *(f32x4*)gp = acc[ai][0][m][0] + b0; *(f32x4*)(gp + 4) = acc[ai][0][m][1] + b1; }
            }
        }
    }
};
}

__device__ __forceinline__ void convert_mixer_weights(const Frame& F0, const float* win, const float* wout, const float* glu, bf16_t* WIN, bf16_t* WOUT, bf16_t* GLU) {
    PHASE_FRAME(F0);
    LAS float* scr = (LAS float*)(F.lds + F.wave * 16384);
    const int gw = F.vcu * NWAVES + F.wave, NGW = F.G * NWAVES;
    constexpr int I_IN = (DM / 64) * (IN_WP / 32), I_OUT = (DM / 64) * (DM / 32), I_GLU = (GWID / 64) * (GWID / 32);
    for (int it = gw; it < I_IN + I_OUT + I_GLU; it += NGW) {
        if (it < I_IN) {
            const int kb = it / (IN_WP / 32), db = it % (IN_WP / 32), d0 = db * 32;
            int s0, nv; bool perm = false;
            if (d0 < 2048) { s0 = d0; nv = 32; } else if (d0 < 3072) { s0 = (d0 & ~63) + 16 + ((d0 >> 5) & 1) * 16; nv = 32; perm = true; }
            else if (d0 < 5632) { s0 = d0 + 16; nv = 32; } else if (d0 == 5632) { s0 = 2048; nv = 16; } else { s0 = 0; nv = 0; }
            tr_item(win, IN_W, WIN, DM, kb * 64, s0, d0, nv, scr, F.lane, perm);
        } else if (it < I_IN + I_OUT) {
            const int r = it - I_IN, kb = r / (DM / 32), nb = r % (DM / 32);
            tr_item(wout, DM, WOUT, DM, kb * 64, nb * 32, nb * 32, 32, scr, F.lane);
        } else {
            const int r = it - I_IN - I_OUT, kb = r / (GWID / 32), nb = r % (GWID / 32);
            tr_item(glu, GWID, GLU, GWID, kb * 64, nb * 32, nb * 32, 32, scr, F.lane);
        }
    }
}

__device__ __forceinline__ void rope_table_phase(const Frame& F0, float* tab) {
    PHASE_FRAME(F0);
    const int gt = F.vcu * (NWAVES * 64) + F.tid, NT = F.G * NWAVES * 64;
    for (int idx = gt; idx < 8192 * 32; idx += NT) {
        const int t = idx >> 5, i = idx & 31;
        const float inv = powf(10000.f, -(float)(2 * i) / 64.f);
        float s, c; sincosf((float)t * inv, &s, &c);
        tab[2 * idx] = c; tab[2 * idx + 1] = s;
    }
}
__device__ __forceinline__ void rope_apply_phase(const Frame& F0, int half, bf16_t* PR, const float* tab) {
    PHASE_FRAME(F0);
    const long gt = (long)F.vcu * (NWAVES * 64) + F.tid, NT = (long)F.G * NWAVES * 64;
    for (long it = gt; it < (long)MH * 64; it += NT) {
        const int row = (int)(it >> 6), x = (int)(it & 63), vec = x >> 2, ig = x & 3;
        bf16_t* p = PR + (size_t)row * PRJ_LD + PC_DQ + vec * 64 + ig * 8;
        const u32x4 a = *(const u32x4*)p, b = *(const u32x4*)(p + 32);
        const float* tb = tab + ((size_t)tpos(half, row) * 32 + ig * 8) * 2;
        const float sc = vec < 8 ? QSCALE : 1.f;
        u32x4 oa, ob;
#pragma unroll
        for (int e = 0; e < 4; ++e) {
            const f32x4 cs = *(const f32x4*)(tb + 4 * e);
            const float x1a = __builtin_bit_cast(float, a[e] << 16), x1b = __builtin_bit_cast(float, a[e] & 0xffff0000u);
            const float x2a = __builtin_bit_cast(float, b[e] << 16), x2b = __builtin_bit_cast(float, b[e] & 0xffff0000u);
            oa[e] = pk2((x1a * cs[0] - x2a * cs[1]) * sc, (x1b * cs[2] - x2b * cs[3]) * sc);
            ob[e] = pk2((x2a * cs[0] + x1a * cs[1]) * sc, (x2b * cs[2] + x1b * cs[3]) * sc);
        }
        *(u32x4*)p = oa; *(u32x4*)(p + 32) = ob;
    }
}

__device__ __forceinline__ void diffattn_phase(const Frame& F, int half, int layer, const bf16_t* PR, bf16_t* MIXh, const float* lamp, const float* normg) {
    const int tid = opaque_tid(F.wave), lane = tid & 63, wave = F.wave;
    const int map = wave >> 2, qw = wave & 3, r32 = lane & 31, hi = lane >> 5;
    const FragBase fb = make_fragbase(lane);
    LAS unsigned char* lds = F.lds;
    float d01 = 0.f, d23 = 0.f;
    for (int i = 0; i < 64; ++i) { d01 += lamp[i] * lamp[64 + i]; d23 += lamp[128 + i] * lamp[192 + i]; }
    const float lam_init = 0.8f - 0.6f * expf(-0.3f * (float)layer);
    const float lam = expf(d01) - expf(d23) + lam_init, oscale = 1.f - lam_init;
    LAS unsigned char* KB = lds; LAS unsigned char* VB = lds + 32768;
    LAS float* wsf = (LAS float*)(lds + 69632 + wave * 256);
    LAS float* OS = (LAS float*)lds;
    const int srow = tid >> 4, sch = tid & 15;
    const unsigned so0 = off_a(srow, sch), so1 = off_a(srow + 32, sch);
    for (int ui = 0; ; ++ui) {
        int row0, T, head, qb;
        if (gridDim.x == 256) {
            if (ui >= 3) break;
            const int x = blockIdx.x & 7, r = blockIdx.x >> 3;
            if (half == 0) { if (ui < 2) { row0 = (x >> 2) * 8192; T = 8192; head = x & 3; qb = r + 32 * ui; } else { row0 = 16384 + (x >> 2) * 4096; T = 4096; head = x & 3; qb = r; } }
            else { const int p = x + 8 * ui; row0 = (p >> 2) * 4096; T = 4096; head = p & 3; qb = r; }
        } else {
            const int u = blockIdx.x + ui * gridDim.x; if (u >= 768) break;
            if (half == 0) { if (u < 512) { row0 = (u >> 8) * 8192; T = 8192; head = (u >> 6) & 3; qb = u & 63; } else { const int v = u - 512; row0 = 16384 + (v >> 7) * 4096; T = 4096; head = (v >> 5) & 3; qb = v & 31; } }
            else { row0 = (u >> 7) * 4096; T = 4096; head = (u >> 5) & 3; qb = u & 31; }
        }
        const int NT = T / 64;
        const bf16_t* Kg = PR + (size_t)row0 * PRJ_LD + PC_DK + head * 128;
        const bf16_t* Vg = PR + (size_t)row0 * PRJ_LD + PC_DV + head * 128;
        const int qrow = row0 + qb * 128 + qw * 32 + r32;
        bf16x8 qf[4];
#pragma unroll
        for (int kk = 0; kk < 4; ++kk) qf[kk] = *(const bf16x8*)(PR + (size_t)qrow * PRJ_LD + PC_DQ + head * 128 + map * 64 + kk * 16 + hi * 8);
        u32x4 sk0, sk1, sv0, sv1, tk0, tk1, tv0, tv1;
#define DA_LOAD(j) do { const size_t ro_ = (size_t)((j) * 64 + srow) * PRJ_LD + sch * 8; sk0 = *(const u32x4*)(Kg + ro_); sk1 = *(const u32x4*)(Kg + ro_ + 32 * PRJ_LD); \
        sv0 = *(const u32x4*)(Vg + ro_); sv1 = *(const u32x4*)(Vg + ro_ + 32 * PRJ_LD); } while (0)
#define DA_LOAD2(j) do { const size_t ro_ = (size_t)((j) * 64 + srow) * PRJ_LD + sch * 8; tk0 = *(const u32x4*)(Kg + ro_); tk1 = *(const u32x4*)(Kg + ro_ + 32 * PRJ_LD); \
        tv0 = *(const u32x4*)(Vg + ro_); tv1 = *(const u32x4*)(Vg + ro_ + 32 * PRJ_LD); } while (0)
#define DA_WRITE(b) do { *(LAS u32x4*)(KB + (b) * 16384 + so0) = sk0; *(LAS u32x4*)(KB + (b) * 16384 + so1) = sk1; \
        *(LAS u32x4*)(VB + (b) * 16384 + so0) = sv0; *(LAS u32x4*)(VB + (b) * 16384 + so1) = sv1; } while (0)
#define DA_WRITE2(b) do { *(LAS u32x4*)(KB + (b) * 16384 + so0) = tk0; *(LAS u32x4*)(KB + (b) * 16384 + so1) = tk1; \
        *(LAS u32x4*)(VB + (b) * 16384 + so0) = tv0; *(LAS u32x4*)(VB + (b) * 16384 + so1) = tv1; } while (0)
        DA_LOAD(0); DA_WRITE(0); DA_LOAD2(1); __syncthreads();
        constexpr float DTHR = 10.f;
        float m_run = 0.f;
        f32x16 o[4], lacc, negm;
#pragma unroll
        for (int r = 0; r < 16; ++r) { lacc[r] = 0.f; negm[r] = 0.f; }
#pragma unroll
        for (int d = 0; d < 4; ++d)
#pragma unroll
            for (int r = 0; r < 16; ++r) o[d][r] = 0.f;
        const bf16x8 ones = {0x3F80, 0x3F80, 0x3F80, 0x3F80, 0x3F80, 0x3F80, 0x3F80, 0x3F80};
        for (int j = 0; j < NT; j += 2) {
          { const int b = 0;
            if (j + 2 < NT) DA_LOAD(j + 2);
            const LAS unsigned char* Kt = KB + b * 16384; const LAS unsigned char* Vt = VB + b * 16384;
            f32x16 p0, p1;
            {
                bf16x8 ka[4], kb[4];
#pragma unroll
                for (int kk = 0; kk < 4; ++kk) { ka[kk] = rowfrag(Kt + map * 1024, 0, kk, fb); kb[kk] = rowfrag(Kt + map * 1024, 1, kk, fb); }
                SBAR();
                p0 = MFMA32(ka[0], qf[0], negm); p1 = MFMA32(kb[0], qf[0], negm);
#pragma unroll
                for (int kk = 1; kk < 4; ++kk) { p0 = MFMA32(ka[kk], qf[kk], p0); p1 = MFMA32(kb[kk], qf[kk], p1); }
            }
            bf16x8 vA[4], vB[4];
#pragma unroll
            for (int d = 0; d < 4; ++d) vA[d] = trfrag(Vt, d, 0, fb);
            float pmax = max3f(p0[0], p1[0], p0[1]);
            pmax = max3f(pmax, p1[1], p0[2]);
#pragma unroll
            for (int r = 2; r < 15; ++r) pmax = max3f(pmax, p1[r], p0[r + 1]);
            pmax = fmaxf(pmax, p1[15]);
            pmax = swap_max(pmax);
            if (__builtin_expect(!__all(pmax <= DTHR) || j == 0, 0)) {
                const float dlt = j == 0 ? pmax : fmaxf(pmax, 0.f), alpha = j == 0 ? 1.f : __builtin_amdgcn_exp2f(-dlt);
                m_run += dlt;
#pragma unroll
                for (int r = 0; r < 16; ++r) { p0[r] -= dlt; p1[r] -= dlt; negm[r] = -m_run; }
                if (hi == 0) wsf[r32] = alpha;
#pragma unroll
                for (int r = 0; r < 16; ++r) { const float al = wsf[crow(r, hi)]; lacc[r] *= al;
#pragma unroll
                    for (int d = 0; d < 4; ++d) o[d][r] *= al; }
            }
#pragma unroll
            for (int r = 0; r < 16; ++r) { p0[r] = __builtin_amdgcn_exp2f(p0[r]); p1[r] = __builtin_amdgcn_exp2f(p1[r]); }
            bf16x8 pa[4];
            PK4(p0, 0, pa[0]); PK4(p0, 8, pa[1]); PK4(p1, 0, pa[2]); PK4(p1, 8, pa[3]);
#define DA_PV_STEP(KS, VC, VN) do { if ((KS) < 3) { _Pragma("unroll") for (int d = 0; d < 4; ++d) VN[d] = trfrag(Vt, d, (KS) + 1, fb); } SBAR(); \
                lacc = MFMA32(pa[KS], ones, lacc); _Pragma("unroll") for (int d = 0; d < 4; ++d) o[d] = MFMA32(pa[KS], VC[d], o[d]); SBAR(); } while (0)
            DA_PV_STEP(0, vA, vB); DA_PV_STEP(1, vB, vA); DA_PV_STEP(2, vA, vB); DA_PV_STEP(3, vB, vA);
#undef DA_PV_STEP
            DA_WRITE2(1);
            __syncthreads();
          }
          { const int b = 1;
            if (j + 3 < NT) DA_LOAD2(j + 3);
            const LAS unsigned char* Kt = KB + b * 16384; const LAS unsigned char* Vt = VB + b * 16384;
            f32x16 p0, p1;
            {
                bf16x8 ka[4], kb[4];
#pragma unroll
                for (int kk = 0; kk < 4; ++kk) { ka[kk] = rowfrag(Kt + map * 1024, 0, kk, fb); kb[kk] = rowfrag(Kt + map * 1024, 1, kk, fb); }
                SBAR();
                p0 = MFMA32(ka[0], qf[0], negm); p1 = MFMA32(kb[0], qf[0], negm);
#pragma unroll
                for (int kk = 1; kk < 4; ++kk) { p0 = MFMA32(ka[kk], qf[kk], p0); p1 = MFMA32(kb[kk], qf[kk], p1); }
            }
            bf16x8 vA[4], vB[4];
#pragma unroll
            for (int d = 0; d < 4; ++d) vA[d] = trfrag(Vt, d, 0, fb);
            float pmax = max3f(p0[0], p1[0], p0[1]);
            pmax = max3f(pmax, p1[1], p0[2]);
#pragma unroll
            for (int r = 2; r < 15; ++r) pmax = max3f(pmax, p1[r], p0[r + 1]);
            pmax = fmaxf(pmax, p1[15]);
            pmax = swap_max(pmax);
            if (__builtin_expect(!__all(pmax <= DTHR) || false, 0)) {
                const float dlt = false ? pmax : fmaxf(pmax, 0.f), alpha = false ? 1.f : __builtin_amdgcn_exp2f(-dlt);
                m_run += dlt;
#pragma unroll
                for (int r = 0; r < 16; ++r) { p0[r] -= dlt; p1[r] -= dlt; negm[r] = -m_run; }
                if (hi == 0) wsf[r32] = alpha;
#pragma unroll
                for (int r = 0; r < 16; ++r) { const float al = wsf[crow(r, hi)]; lacc[r] *= al;
#pragma unroll
                    for (int d = 0; d < 4; ++d) o[d][r] *= al; }
            }
#pragma unroll
            for (int r = 0; r < 16; ++r) { p0[r] = __builtin_amdgcn_exp2f(p0[r]); p1[r] = __builtin_amdgcn_exp2f(p1[r]); }
            bf16x8 pa[4];
            PK4(p0, 0, pa[0]); PK4(p0, 8, pa[1]); PK4(p1, 0, pa[2]); PK4(p1, 8, pa[3]);
#define DA_PV_STEP(KS, VC, VN) do { if ((KS) < 3) { _Pragma("unroll") for (int d = 0; d < 4; ++d) VN[d] = trfrag(Vt, d, (KS) + 1, fb); } SBAR(); \
                lacc = MFMA32(pa[KS], ones, lacc); _Pragma("unroll") for (int d = 0; d < 4; ++d) o[d] = MFMA32(pa[KS], VC[d], o[d]); SBAR(); } while (0)
            DA_PV_STEP(0, vA, vB); DA_PV_STEP(1, vB, vA); DA_PV_STEP(2, vA, vB); DA_PV_STEP(3, vB, vA);
#undef DA_PV_STEP
            if (j + 2 < NT) DA_WRITE(0);
            __syncthreads();
          }
        }
        float rl[16];
#pragma unroll
        for (int r = 0; r < 16; ++r) rl[r] = 1.f / lacc[r];
        if (map == 1) {
#pragma unroll
            for (int d = 0; d < 4; ++d)
#pragma unroll
                for (int r = 0; r < 16; ++r) OS[(qw * 32 + crow(r, hi)) * 132 + d * 32 + r32] = -lam * o[d][r] * rl[r];
        }
        __syncthreads();
        if (map == 0) {
#pragma unroll
            for (int d = 0; d < 4; ++d)
#pragma unroll
                for (int r = 0; r < 16; ++r) OS[(qw * 32 + crow(r, hi)) * 132 + d * 32 + r32] += o[d][r] * rl[r];
        }
        __syncthreads();
        const float g0 = normg[lane], g1 = normg[64 + lane];
        for (int i = 0; i < 16; ++i) {
            const int row = wave * 16 + i;
            const float v0 = OS[row * 132 + lane], v1 = OS[row * 132 + 64 + lane];
            const float rs = 1.f / sqrtf(wave_sum(v0 * v0 + v1 * v1) * (1.f / 128.f) + NORM_EPS) * oscale;
            bf16_t* orow = MIXh + (size_t)(row0 + qb * 128 + row) * DM + 512 + head * 128;
            orow[lane] = (bf16_t)f2bf(v0 * rs * g0); orow[64 + lane] = (bf16_t)f2bf(v1 * rs * g1);
        }
        __syncthreads();
#undef DA_LOAD
#undef DA_WRITE
#undef DA_LOAD2
#undef DA_WRITE2
    }
}

constexpr int ML_NCH = MH / 64;
constexpr int MSC_B = 0, MSC_ICB = 8 * MH, MSC_PMX = 16 * MH, MSC_WL = 24 * MH, MSC_G = 32 * MH, MSC_AMAX = MSC_G + 8 * ML_NCH, MSC_MPREV = MSC_AMAX + 8 * ML_NCH;
static_assert((size_t)(MSC_MPREV + 8 * ML_NCH) * 4 <= 4 * MiB, "MSC fits");
__device__ __forceinline__ void unpack8(const u32x4 v, float (&f)[8]) {
#pragma unroll
    for (int e = 0; e < 4; ++e) { f[2 * e] = __builtin_bit_cast(float, v[e] << 16); f[2 * e + 1] = __builtin_bit_cast(float, v[e] & 0xffff0000u); }
}
__device__ __forceinline__ void mlstm_conv_phase(const Frame& F0, int half, const bf16_t* PR, bf16_t* QKC, const float* cw, const float* cb) {
    PHASE_FRAME(F0);
    const long gt = (long)F.vcu * (NWAVES * 64) + F.tid, NT = (long)F.G * NWAVES * 64;
    for (long it = gt; it < (long)(MH / 16) * 128; it += NT) {
        const int cg = (int)(it & 127), tb = (int)(it >> 7), c0 = cg * 8;
        float w[5][8], bias[8];
#pragma unroll
        for (int j = 0; j < 5; ++j) { const f32x4 a = *(const f32x4*)(cw + j * 1024 + c0), b = *(const f32x4*)(cw + j * 1024 + c0 + 4);
            w[j][0] = a[0]; w[j][1] = a[1]; w[j][2] = a[2]; w[j][3] = a[3]; w[j][4] = b[0]; w[j][5] = b[1]; w[j][6] = b[2]; w[j][7] = b[3]; }
        { const f32x4 a = *(const f32x4*)(cb + c0), b = *(const f32x4*)(cb + c0 + 4); bias[0] = a[0]; bias[1] = a[1]; bias[2] = a[2]; bias[3] = a[3]; bias[4] = b[0]; bias[5] = b[1]; bias[6] = b[2]; bias[7] = b[3]; }
        const float osc = cg >= 64 ? 0.08838834764831845f : 1.f;
        const int rowb = tb * 16, posb = tpos(half, rowb), T = (half == 0 && rowb < 16384) ? 8192 : 4096;
        u32x4 rr[20];
#pragma unroll
        for (int q = 0; q < 20; ++q) { const int pp = posb + q - 2;
            rr[q] = (pp >= 0 && pp < T) ? *(const u32x4*)(PR + (size_t)(rowb + q - 2) * PRJ_LD + c0) : (u32x4){0u, 0u, 0u, 0u}; }
#pragma unroll
        for (int i = 0; i < 16; ++i) {
            float acc[8];
#pragma unroll
            for (int e = 0; e < 8; ++e) acc[e] = bias[e];
#pragma unroll
            for (int j = 0; j < 5; ++j) { float x[8]; unpack8(rr[i + j], x);
#pragma unroll
                for (int e = 0; e < 8; ++e) acc[e] += w[j][e] * x[e]; }
            u32x4 o;
#pragma unroll
            for (int e = 0; e < 4; ++e) o[e] = pk2(fast_silu(acc[2 * e]) * osc, fast_silu(acc[2 * e + 1]) * osc);
            *(u32x4*)(QKC + (size_t)(rowb + i) * 1024 + c0) = o;
        }
    }
}
__device__ __forceinline__ float log_sigmoid(float x) { return fminf(x, 0.f) - log1pf(expf(-fabsf(x))); }
__device__ __forceinline__ void mlstm_scalar_phase(const Frame& F0, const float* GT, float* MSC) {
    PHASE_FRAME(F0);
    const int gw = F.vcu * NWAVES + F.wave, NGW = F.G * NWAVES, lane = F.lane;
    for (int it = gw; it < ML_NCH * 8; it += NGW) {
        const int jc = it >> 3, hd = it & 7, h = hd >> 1, dir = hd & 1, row = jc * 64 + lane;
        const float ic = GT[(size_t)row * 16 + dir * 8 + h], fg = GT[(size_t)row * 16 + dir * 8 + 4 + h];
        const float lf = log_sigmoid(fg);
        float b = lf;
#pragma unroll
        for (int o = 1; o < 64; o <<= 1) { const float t = dir == 0 ? __shfl_up(b, o) : __shfl_down(b, o); if (dir == 0 ? (lane >= o) : (lane + o < 64)) b += t; }
        const float g = dir == 0 ? __shfl(b, 63) : __shfl(b, 0);
        const float a = g - b + ic;
        float amax = a;
#pragma unroll
        for (int o = 1; o < 64; o <<= 1) amax = fmaxf(amax, __shfl_xor(amax, o));
        const float icb = ic - b;
        float pm = icb;
#pragma unroll
        for (int o = 1; o < 64; o <<= 1) { const float t = dir == 0 ? __shfl_up(pm, o) : __shfl_down(pm, o); if (dir == 0 ? (lane >= o) : (lane + o < 64)) pm = fmaxf(pm, t); }
        MSC[MSC_B + hd * MH + row] = b; MSC[MSC_ICB + hd * MH + row] = icb; MSC[MSC_PMX + hd * MH + row] = pm; MSC[MSC_WL + hd * MH + row] = expf(a - amax);
        if (lane == 0) { MSC[MSC_G + hd * ML_NCH + jc] = g; MSC[MSC_AMAX + hd * ML_NCH + jc] = amax; }
    }
}
__device__ __forceinline__ void mlstm_state_phase(const Frame& F0, const bf16_t* PR, const bf16_t* QKC, const float* MSC, bf16_t* CST, float* NST) {
    PHASE_FRAME(F0);
    const int tid = F.tid, lane = F.lane, wave = F.wave, r32 = lane & 31, hi = lane >> 5;
    LAS unsigned char* Vt = F.lds; LAS unsigned char* Kt = F.lds + 16384;
    const int srow = tid >> 4, sch = tid & 15;
    const unsigned so0 = off_a(srow, sch), so1 = off_a(srow + 32, sch);
    const int eb = wave >> 1, db0 = 2 * (wave & 1);
    const FragBase fb = make_fragbase(lane);
    for (int u = blockIdx.x; u < ML_NCH * 4; u += gridDim.x) {
        const int jc = u >> 2, h = u & 3, row0 = jc * 64;
        *(LAS u32x4*)(Vt + so0) = *(const u32x4*)(PR + (size_t)(row0 + srow) * PRJ_LD + PC_MV + h * 128 + sch * 8);
        *(LAS u32x4*)(Vt + so1) = *(const u32x4*)(PR + (size_t)(row0 + srow + 32) * PRJ_LD + PC_MV + h * 128 + sch * 8);
        const u32x4 k0 = *(const u32x4*)(QKC + (size_t)(row0 + srow) * 1024 + 512 + h * 128 + sch * 8);
        const u32x4 k1 = *(const u32x4*)(QKC + (size_t)(row0 + srow + 32) * 1024 + 512 + h * 128 + sch * 8);
        for (int dir = 0; dir < 2; ++dir) {
            const int hd = h * 2 + dir, unit = u * 2 + dir;
            const float w0 = MSC[MSC_WL + hd * MH + row0 + srow], w1 = MSC[MSC_WL + hd * MH + row0 + srow + 32];
            { float x[8]; unpack8(k0, x); u32x4 o;
#pragma unroll
              for (int e = 0; e < 4; ++e) o[e] = pk2(x[2 * e] * w0, x[2 * e + 1] * w0);
              *(LAS u32x4*)(Kt + so0) = o; }
            { float x[8]; unpack8(k1, x); u32x4 o;
#pragma unroll
              for (int e = 0; e < 4; ++e) o[e] = pk2(x[2 * e] * w1, x[2 * e + 1] * w1);
              *(LAS u32x4*)(Kt + so1) = o; }
            __syncthreads();
            f32x16 acc0, acc1;
#pragma unroll
            for (int r = 0; r < 16; ++r) { acc0[r] = 0.f; acc1[r] = 0.f; }
#pragma unroll
            for (int ks = 0; ks < 4; ++ks) {
                const bf16x8 a = trfrag(Vt + eb * 512, 0, ks, fb), b0 = trfrag(Kt + db0 * 512, 0, ks, fb), b1 = trfrag(Kt + db0 * 512, 1, ks, fb);
                acc0 = MFMA32(a, b0, acc0); acc1 = MFMA32(a, b1, acc1);
            }
            bf16_t* cs = CST + (size_t)unit * 16384;
#pragma unroll
            for (int r = 0; r < 16; ++r) { const int e = 32 * eb + crow(r, hi);
                cs[e * 128 + 32 * db0 + r32] = (bf16_t)f2bf(acc0[r]); cs[e * 128 + 32 * (db0 + 1) + r32] = (bf16_t)f2bf(acc1[r]); }
            if (tid < 128) {
                float sum = 0.f;
                for (int l = 0; l < 64; ++l) sum += bf2f(*(const LAS unsigned short*)(Kt + off_a(l, tid >> 3) + (tid & 7) * 2));
                NST[(size_t)unit * 128 + tid] = sum;
            }
            __syncthreads();
        }
    }
}
__device__ __forceinline__ void mlstm_scan_phase(const Frame& F0, int half, float* MSC, bf16_t* CST, float* NST) {
    PHASE_FRAME(F0);
    const int gw = F.vcu * NWAVES + F.wave, NGW = F.G * NWAVES, lane = F.lane;
    const int nchain = (half == 0 ? 4 : 6) * 8;
    for (int it = gw; it < nchain * 33; it += NGW) {
        const int chain = it / 33, wi = it % 33, s = chain >> 3, hd = chain & 7, h = hd >> 1, dir = hd & 1;
        const int row0 = half == 0 ? (s < 2 ? s * 8192 : 16384 + (s - 2) * 4096) : s * 4096, T = (half == 0 && s < 2) ? 8192 : 4096;
        const int c0 = row0 / 64, nc = T / 64;
        float m = 0.f;
        if (wi < 32) {
            const int grp = wi * 64 + lane;
            float C[8];
#pragma unroll
            for (int e = 0; e < 8; ++e) C[e] = 0.f;
            for (int j0 = 0; j0 < nc; j0 += 16) {
                u32x4 U[16];
#pragma unroll
                for (int q = 0; q < 16; ++q) { const int jc = dir == 0 ? c0 + j0 + q : c0 + nc - 1 - (j0 + q); U[q] = *(const u32x4*)(CST + ((size_t)(jc * 4 + h) * 2 + dir) * 16384 + grp * 8); }
#pragma unroll
                for (int q = 0; q < 16; ++q) {
                    const int jc = dir == 0 ? c0 + j0 + q : c0 + nc - 1 - (j0 + q);
                    const float g = MSC[MSC_G + hd * ML_NCH + jc], am = MSC[MSC_AMAX + hd * ML_NCH + jc];
                    const float mn = fmaxf(g + m, am), dec = expf(g + m - mn), inc = expf(am - mn);
                    if (wi == 0 && lane == 0) MSC[MSC_MPREV + hd * ML_NCH + jc] = m;
                    m = mn;
                    u32x4 o;
#pragma unroll
                    for (int e = 0; e < 4; ++e) o[e] = pk2(C[2 * e], C[2 * e + 1]);
                    *(u32x4*)(CST + ((size_t)(jc * 4 + h) * 2 + dir) * 16384 + grp * 8) = o;
                    float x[8]; unpack8(U[q], x);
#pragma unroll
                    for (int e = 0; e < 8; ++e) C[e] = dec * C[e] + inc * x[e];
                }
            }
        } else {
            float n0 = 0.f, n1 = 0.f;
            for (int j = 0; j < nc; ++j) {
                const int jc = dir == 0 ? c0 + j : c0 + nc - 1 - j;
                const float g = MSC[MSC_G + hd * ML_NCH + jc], am = MSC[MSC_AMAX + hd * ML_NCH + jc];
                const float mn = fmaxf(g + m, am), dec = expf(g + m - mn), inc = expf(am - mn);
                m = mn;
                float* np = NST + ((size_t)(jc * 4 + h) * 2 + dir) * 128 + lane * 2;
                const f32x2 uu = *(const f32x2*)np;
                *(f32x2*)np = (f32x2){n0, n1};
                n0 = dec * n0 + inc * uu[0]; n1 = dec * n1 + inc * uu[1];
            }
        }
    }
}
__device__ __forceinline__ void mlstm_out_phase(const Frame& F0, const bf16_t* PR, const bf16_t* QKC, const float* MSC, const bf16_t* CST, const float* NST, const float* normg, bf16_t* MIXh) {
    PHASE_FRAME(F0);
    const int tid = F.tid, lane = F.lane, wave = F.wave, r32 = lane & 31, hi = lane >> 5;
    LAS unsigned char* Qt = F.lds; LAS unsigned char* Kt = F.lds + 16384; LAS unsigned char* Vt = F.lds + 32768; LAS unsigned char* CT0 = F.lds + 49152;
    LAS float* HS = (LAS float*)F.lds;
    LAS float* SC = (LAS float*)(F.lds + 114688);
    LAS float* wsx = (LAS float*)(F.lds + 118784 + wave * 512);
    const int lb = wave & 1, eb = wave >> 1, l = 32 * lb + r32;
    const FragBase fb = make_fragbase(lane);
    const int NU = ML_NCH * 4;
    u32x4 gq0, gq1, gk0, gk1, gv0, gv1, gc0[4], gc1[4]; float gs0, gs1; unsigned go[8];
#define MO_GATES(uu) do { const int jc_ = (uu) >> 2, h_ = (uu) & 3, l_ = opaque_tid(wave) & 63; \
        _Pragma("unroll") for (int i = 0; i < 8; ++i) go[i] = *(const unsigned*)(PR + (size_t)(jc_ * 64 + wave * 8 + i) * PRJ_LD + PC_MO + h_ * 128 + 2 * l_); } while (0)
#define MO_LOADS(uu) do { const int jc_ = (uu) >> 2, h_ = (uu) & 3, t_ = opaque_tid(wave), srow = t_ >> 4, sch = t_ & 15; const size_t r0_ = (size_t)(jc_ * 64 + srow), r1_ = r0_ + 32; \
        gq0 = *(const u32x4*)(QKC + r0_ * 1024 + h_ * 128 + sch * 8);       gq1 = *(const u32x4*)(QKC + r1_ * 1024 + h_ * 128 + sch * 8); \
        gk0 = *(const u32x4*)(QKC + r0_ * 1024 + 512 + h_ * 128 + sch * 8); gk1 = *(const u32x4*)(QKC + r1_ * 1024 + 512 + h_ * 128 + sch * 8); \
        gv0 = *(const u32x4*)(PR + r0_ * PRJ_LD + PC_MV + h_ * 128 + sch * 8); gv1 = *(const u32x4*)(PR + r1_ * PRJ_LD + PC_MV + h_ * 128 + sch * 8); \
        { const bf16_t* cs_ = CST + (size_t)(uu) * 2 * 16384; \
          _Pragma("unroll") for (int i = 0; i < 4; ++i) { const int id = t_ + 512 * i; gc0[i] = *(const u32x4*)(cs_ + id * 8); gc1[i] = *(const u32x4*)(cs_ + 16384 + id * 8); } } \
        { const int d_ = t_ / 320, j_ = t_ % 320, hd_ = h_ * 2 + d_; \
          gs0 = j_ < 64 ? MSC[MSC_B + hd_ * MH + jc_ * 64 + j_] : j_ < 128 ? MSC[MSC_ICB + hd_ * MH + jc_ * 64 + j_ - 64] : j_ < 192 ? MSC[MSC_PMX + hd_ * MH + jc_ * 64 + j_ - 128] : NST[((size_t)(uu) * 2 + d_) * 128 + j_ - 192]; } \
        if (t_ < 128) gs1 = NST[((size_t)(uu) * 2 + 1) * 128 + t_]; } while (0)
#define MO_WRITE() do { const int t_ = opaque_tid(wave), srow = t_ >> 4, sch = t_ & 15; const unsigned so0 = off_a(srow, sch), so1 = off_a(srow + 32, sch); \
        *(LAS u32x4*)(Qt + so0) = gq0; *(LAS u32x4*)(Qt + so1) = gq1; *(LAS u32x4*)(Kt + so0) = gk0; *(LAS u32x4*)(Kt + so1) = gk1; *(LAS u32x4*)(Vt + so0) = gv0; *(LAS u32x4*)(Vt + so1) = gv1; \
        _Pragma("unroll") for (int i = 0; i < 4; ++i) { const int id = t_ + 512 * i, e = id >> 4, ch = id & 15; *(LAS u32x4*)(CT0 + off_a(e, ch)) = gc0[i]; *(LAS u32x4*)(CT0 + 32768 + off_a(e, ch)) = gc1[i]; } \
        SC[t_] = gs0; if (t_ < 128) SC[512 + t_] = gs1; } while (0)
    int u = blockIdx.x;
    if (u < NU) { MO_LOADS(u); MO_GATES(u); }
    for (; u < NU; u += gridDim.x) {
        const int jc = u >> 2, h = u & 3, row0 = jc * 64;
        MO_WRITE();
        const float m_prev0 = MSC[MSC_MPREV + (h * 2) * ML_NCH + jc], m_prev1 = MSC[MSC_MPREV + (h * 2 + 1) * ML_NCH + jc];
        __syncthreads();
        if (u + (int)gridDim.x < NU) MO_LOADS(u + (int)gridDim.x);
        f32x16 hsum;
#pragma unroll
        for (int r = 0; r < 16; ++r) hsum[r] = 0.f;
#pragma unroll 1
        for (int dir = 0; dir < 2; ++dir) {
            const LAS unsigned char* CT = CT0 + dir * 32768;
            const LAS float* SCb = SC + dir * 320; const LAS float* SCi = SCb + 64; const LAS float* SCp = SCb + 128; const LAS float* SCn = SCb + 192;
            const float m_prev = dir == 0 ? m_prev0 : m_prev1;
            f32x16 s0, s1;
#pragma unroll
            for (int r = 0; r < 16; ++r) { s0[r] = 0.f; s1[r] = 0.f; }
#pragma unroll
            for (int ks = 0; ks < 8; ++ks) { const bf16x8 bq = rowfrag(Qt + lb * 8192, 0, ks, fb); s0 = MFMA32(rowfrag(Kt, 0, ks, fb), bq, s0); s1 = MFMA32(rowfrag(Kt, 1, ks, fb), bq, s1); }
            int l_ = l; asm volatile("" : "+v"(l_));
            const float b_l = SCb[l], m_t = b_l + fmaxf(m_prev, SCp[l]), sint = __expf(b_l + m_prev - m_t), bm = b_l - m_t;
            float rs = 0.f;
#pragma unroll
            for (int r = 0; r < 16; ++r) {
                const int sa = crow(r, hi), sb = 32 + sa;
                const bool va = dir == 0 ? (sa <= l_) : (sa >= l_), vb = dir == 0 ? (sb <= l_) : (sb >= l_);
                const float ia = SCi[sa], ib = SCi[sb];
                s0[r] *= __expf(va ? bm + ia : -1e30f); s1[r] *= __expf(vb ? bm + ib : -1e30f);
                rs += s0[r] + s1[r];
            }
            rs = swap_add(rs);
            float qn = 0.f;
#pragma unroll
            for (int c = 0; c < 8; ++c) { float x[8]; unpack8(*(const LAS u32x4*)(Qt + off_a(l, 8 * hi + c)), x);
#pragma unroll
                for (int e = 0; e < 8; ++e) qn += x[e] * SCn[64 * hi + 8 * c + e]; }
            qn = swap_add(qn);
            const float den = fmaxf(fabsf(sint * qn + rs), __expf(-m_t)), dinv = 1.f / den;
            if (hi == 0) { wsx[r32] = sint * dinv; wsx[32 + r32] = dinv; }
            bf16x8 pa[4];
            PK4(s0, 0, pa[0]); PK4(s0, 8, pa[1]); PK4(s1, 0, pa[2]); PK4(s1, 8, pa[3]);
            f32x16 ao, ai;
#pragma unroll
            for (int r = 0; r < 16; ++r) { ao[r] = 0.f; ai[r] = 0.f; }
#pragma unroll
            for (int ks = 0; ks < 4; ++ks) ao = MFMA32(pa[ks], trfrag(Vt + eb * 512, 0, ks, fb), ao);
#pragma unroll
            for (int ks = 0; ks < 8; ++ks) ai = MFMA32(rowfrag(Qt + lb * 8192, 0, ks, fb), rowfrag(CT + eb * 8192, 0, ks, fb), ai);
#pragma unroll
            for (int r = 0; r < 16; ++r) { const int lr = crow(r, hi); hsum[r] += ai[r] * wsx[lr] + ao[r] * wsx[32 + lr]; }
        }
        __syncthreads();
#pragma unroll
        for (int r = 0; r < 16; ++r) HS[(32 * lb + crow(r, hi)) * 132 + 32 * eb + r32] = hsum[r];
        __syncthreads();
        { const f32x2 gg = *(const f32x2*)(normg + h * 128 + 2 * lane);
#pragma unroll
          for (int i = 0; i < 8; ++i) {
            const int row = wave * 8 + i;
            const f32x2 v = *(const LAS f32x2*)(HS + row * 132 + 2 * lane);
            const float rr = 1.f / sqrtf(wave_sum(v.x * v.x + v.y * v.y) * (1.f / 128.f) + NORM_EPS);
            const float o0 = __builtin_bit_cast(float, go[i] << 16), o1 = __builtin_bit_cast(float, go[i] & 0xffff0000u);
            *(unsigned*)(MIXh + (size_t)(row0 + row) * DM + h * 128 + 2 * lane) = pk2(v.x * rr * gg.x / (1.f + __expf(-o0)), v.y * rr * gg.y / (1.f + __expf(-o1)));
          } }
        __syncthreads();
        if (u + (int)gridDim.x < NU) MO_GATES(u + (int)gridDim.x);
    }
#undef MO_LOADS
#undef MO_WRITE
#undef MO_GATES
}

constexpr size_t W_LBL = W_GLU + 512 * 1024;
__device__ __forceinline__ void s5_build_phase(const Frame& F0, int layer, const float* const* in, bf16_t* MR, bf16_t* PM, float* LBL) {
    PHASE_FRAME(F0);
    const int tid = F.tid;
    LAS float* PWr = (LAS float*)F.lds; LAS float* PWi = PWr + 2 * 34 * 64;
    LAS float* BBr = PWi + 2 * 34 * 64; LAS float* BBi = BBr + 2 * 64 * 16;
    LAS float* CCr = BBi + 2 * 64 * 16; LAS float* CCi = CCr + 16 * 64;
    LAS float* KT = CCi + 16 * 64;
    for (int ug = blockIdx.x; ug < 256; ug += gridDim.x) {
        const int g = ug >> 3, part = ug & 7;
        const float* lre = in[15] + (size_t)layer * 2 * 32 * 64; const float* lim = in[16] + (size_t)layer * 2 * 32 * 64; const float* lst = in[17] + layer * 2 * 32;
        const float* bre = in[18] + ((size_t)layer * 32 + g) * 64 * 16; const float* bim = in[19] + ((size_t)layer * 32 + g) * 64 * 16;
        const float* cre = in[20] + ((size_t)layer * 32 + g) * 16 * 64; const float* cim = in[21] + ((size_t)layer * 32 + g) * 16 * 64;
        const float* dsk = in[22] + ((size_t)layer * 32 + g) * 16;
        for (int idx = tid; idx < 2 * 34 * 64; idx += NWAVES * 64) {
            const int dir = idx / (34 * 64), tau = (idx / 64) % 34, p = idx & 63;
            const float st = expf(lst[dir * 32 + g]), x = lre[(dir * 32 + g) * 64 + p] * st * (float)tau, y = lim[(dir * 32 + g) * 64 + p] * st * (float)tau;
            float sn, cs; sincosf(y, &sn, &cs); const float ex = expf(x);
            PWr[idx] = ex * cs; PWi[idx] = ex * sn;
        }
        for (int idx = tid; idx < 2 * 64 * 16; idx += NWAVES * 64) {
            const int dir = idx >> 10, p = (idx >> 4) & 63, c = idx & 15;
            const float lr = lre[(dir * 32 + g) * 64 + p], li = lim[(dir * 32 + g) * 64 + p], st = expf(lst[dir * 32 + g]), x = lr * st, y = li * st;
            float sn, cs; sincosf(y, &sn, &cs); float sh, ch; sincosf(0.5f * y, &sh, &ch);
            const float er = expm1f(x) * cs - 2.f * sh * sh, ei = expf(x) * sn;
            const float dn = 1.f / (lr * lr + li * li), qr = (er * lr + ei * li) * dn, qi = (ei * lr - er * li) * dn;
            const float br = bre[p * 16 + c], bi = bim[p * 16 + c];
            BBr[idx] = qr * br - qi * bi; BBi[idx] = qr * bi + qi * br;
        }
        for (int idx = tid; idx < 16 * 64; idx += NWAVES * 64) { CCr[idx] = cre[idx]; CCi[idx] = cim[idx]; }
        __syncthreads();
        for (int idx = tid; idx < 2 * 32 * 16; idx += NWAVES * 64) {
            const int dir = idx >> 9, tau = (idx >> 4) & 31, c = idx & 15;
            f32x4 a0 = {0.f, 0.f, 0.f, 0.f}, a1 = a0, a2 = a0, a3 = a0;
            for (int p = 0; p < 64; ++p) {
                const float pr = PWr[(dir * 34 + tau) * 64 + p], pi = PWi[(dir * 34 + tau) * 64 + p], cr = CCr[c * 64 + p], ci = CCi[c * 64 + p];
                const float wr = cr * pr - ci * pi, wi = cr * pi + ci * pr;
                const LAS f32x4* br = (const LAS f32x4*)(BBr + (dir * 64 + p) * 16); const LAS f32x4* bi = (const LAS f32x4*)(BBi + (dir * 64 + p) * 16);
                a0 += br[0] * wr - bi[0] * wi; a1 += br[1] * wr - bi[1] * wi; a2 += br[2] * wr - bi[2] * wi; a3 += br[3] * wr - bi[3] * wi;
            }
            LAS f32x4* kt = (LAS f32x4*)(KT + ((dir * 32 + tau) * 16 + c) * 16);
            kt[0] = a0; kt[1] = a1; kt[2] = a2; kt[3] = a3;
        }
        __syncthreads();
        bf16_t* mr = MR + (size_t)g * 512 * S5K;
        for (int idx = tid; idx < 64 * (S5K / 2); idx += NWAVES * 64) {
            const int row = part * 64 + idx / (S5K / 2), col = (idx % (S5K / 2)) * 2, i = row >> 4, c = row & 15;
            float v[2];
#pragma unroll
            for (int e = 0; e < 2; ++e) {
                const int cc = col + e;
                if (cc < 512) {
                    const int k = cc >> 4, c2 = cc & 15; float a = 0.f;
                    if (k <= i) a += KT[((0 * 32 + (i - k)) * 16 + c) * 16 + c2];
                    if (k >= i) a += KT[((1 * 32 + (k - i)) * 16 + c) * 16 + c2];
                    if (k == i && c == c2) a += dsk[c];
                    v[e] = a;
                } else {
                    const int x = cc - 512, dir = x >> 7, p = (x >> 1) & 63, ri = x & 1, tau = dir == 0 ? i + 1 : S5L - i;
                    const float pr = PWr[(dir * 34 + tau) * 64 + p], pi = PWi[(dir * 34 + tau) * 64 + p], cr = CCr[c * 64 + p], ci = CCi[c * 64 + p];
                    v[e] = ri == 0 ? (cr * pr - ci * pi) : -(cr * pi + ci * pr);
                }
            }
            *(unsigned*)(mr + (size_t)row * S5K + col) = pk2(v[0], v[1]);
        }
        bf16_t* pm = PM + (size_t)g * 256 * 512;
        for (int idx = tid; idx < 32 * 256; idx += NWAVES * 64) {
            const int n = part * 32 + (idx >> 8), col = (idx & 255) * 2, dir = n >> 7, p = (n >> 1) & 63, ri = n & 1;
            float v[2];
#pragma unroll
            for (int e = 0; e < 2; ++e) {
                const int cc = col + e, k = cc >> 4, c2 = cc & 15, tau = dir == 0 ? S5L - 1 - k : k;
                const float pr = PWr[(dir * 34 + tau) * 64 + p], pi = PWi[(dir * 34 + tau) * 64 + p], br = BBr[(dir * 64 + p) * 16 + c2], bi = BBi[(dir * 64 + p) * 16 + c2];
                v[e] = ri == 0 ? (pr * br - pi * bi) : (pr * bi + pi * br);
            }
            *(unsigned*)(pm + (size_t)n * 512 + col) = pk2(v[0], v[1]);
        }
        if (part == 0 && tid < 128) { const int dir = tid >> 6, p = tid & 63; LBL[((g * 2 + dir) * 64 + p) * 2] = PWr[(dir * 34 + S5L) * 64 + p]; LBL[((g * 2 + dir) * 64 + p) * 2 + 1] = PWi[(dir * 34 + S5L) * 64 + p]; }
        __syncthreads();
    }
}
namespace pg8 {
struct S5OrderA { int G, c;
    __device__ bool next(int i, Unit& u) const { const int L = i * G + c; if (L >= 96) return false; const int g = L / 3; u.pm = L; u.pn = g; return true; }
    __device__ __forceinline__ void a_ready(const Unit&) const {} __device__ __forceinline__ void done(const Unit&) const {} };
struct S5OrderB { int G, c;
    __device__ bool next(int i, Unit& u) const { const int L = i * G + c; if (L >= 192) return false; const int g = L / 6, r = L % 6; u.pm = g * 3 + r % 3; u.pn = g * 2 + r / 3; return true; }
    __device__ __forceinline__ void a_ready(const Unit&) const {} __device__ __forceinline__ void done(const Unit&) const {} };
struct EpiS5E {
    static constexpr bool PERM = true; float* E;
    __device__ __forceinline__ void operator()(const f32x4 (&acc)[2][2][4][2], const Unit& u, int wr, int wc, int fr, int fq) const {
        const int row0 = u.pm * BM + wr * 64 + fr, col0 = wc * 32 + 8 * fq;
#pragma unroll
        for (int ai = 0; ai < 2; ++ai)
#pragma unroll
            for (int m = 0; m < 4; ++m) { float* rowp = E + (size_t)(row0 + ai * HALF + m * 16) * 256 + col0;
#pragma unroll
                for (int bj = 0; bj < 2; ++bj) { *(f32x4*)(rowp + bj * HALF) = acc[ai][bj][m][0]; *(f32x4*)(rowp + bj * HALF + 4) = acc[ai][bj][m][1]; } }
    }
};
__device__ __forceinline__ float gelu_tanh(float x) { const float t = 1.5957691216057308f * (x + 0.044715f * x * x * x); return x * __builtin_amdgcn_rcpf(1.f + __expf(-t)); }
struct EpiS5Z {
    static constexpr bool PERM = true; bf16_t* Z;
    __device__ __forceinline__ void operator()(const f32x4 (&acc)[2][2][4][2], const Unit& u, int wr, int wc, int fr, int fq) const {
        const int g = u.pn >> 1, row0 = u.pm * BM + wr * 64 + fr - g * S5NCH;
#pragma unroll
        for (int ai = 0; ai < 2; ++ai)
#pragma unroll
            for (int m = 0; m < 4; ++m) { const int chunk = row0 + ai * HALF + m * 16;
#pragma unroll
                for (int bj = 0; bj < 2; ++bj) { const int col = (u.pn & 1) * BM + bj * HALF + wc * 32 + 8 * fq, i = col >> 4, c0 = col & 15;
                    const f32x4 v0 = acc[ai][bj][m][0], v1 = acc[ai][bj][m][1];
                    u32x4 w; w.x = cvt_pk_bf16(gelu_tanh(v0[0]), gelu_tanh(v0[1])); w.y = cvt_pk_bf16(gelu_tanh(v0[2]), gelu_tanh(v0[3]));
                    w.z = cvt_pk_bf16(gelu_tanh(v1[0]), gelu_tanh(v1[1])); w.w = cvt_pk_bf16(gelu_tanh(v1[2]), gelu_tanh(v1[3]));
                    *(u32x4*)(Z + (size_t)(chunk * S5L + i) * GWID + 16 * g + c0) = w; } }
    }
};
struct EpiGlu {
    static constexpr bool PERM = true; const bf16_t* Z; const float* bias; bf16_t* O;
    __device__ __forceinline__ void operator()(const f32x4 (&acc)[2][2][4][2], const Unit& u, int wr, int wc, int fr, int fq) const {
        const int row0 = u.pm * BM + wr * 64 + fr, col0 = u.pn * BM + wc * 32 + 8 * fq;
#pragma unroll
        for (int ai = 0; ai < 2; ++ai)
#pragma unroll
            for (int m = 0; m < 4; ++m) { const size_t row = (size_t)(row0 + ai * HALF + m * 16);
#pragma unroll
                for (int bj = 0; bj < 2; ++bj) { const int col = col0 + bj * HALF;
                    const u32x4 zz = *(const u32x4*)(Z + row * GWID + col);
                    const f32x4 b0 = *(const f32x4*)(bias + col), b1 = *(const f32x4*)(bias + col + 4);
                    const f32x4 v0 = acc[ai][bj][m][0] + b0, v1 = acc[ai][bj][m][1] + b1;
                    float z[8];
#pragma unroll
                    for (int e = 0; e < 4; ++e) { z[2 * e] = __builtin_bit_cast(float, zz[e] << 16); z[2 * e + 1] = __builtin_bit_cast(float, zz[e] & 0xffff0000u); }
                    u32x4 w;
                    w.x = cvt_pk_bf16(z[0] * __builtin_amdgcn_rcpf(1.f + __expf(-v0[0])), z[1] * __builtin_amdgcn_rcpf(1.f + __expf(-v0[1])));
                    w.y = cvt_pk_bf16(z[2] * __builtin_amdgcn_rcpf(1.f + __expf(-v0[2])), z[3] * __builtin_amdgcn_rcpf(1.f + __expf(-v0[3])));
                    w.z = cvt_pk_bf16(z[4] * __builtin_amdgcn_rcpf(1.f + __expf(-v1[0])), z[5] * __builtin_amdgcn_rcpf(1.f + __expf(-v1[1])));
                    w.w = cvt_pk_bf16(z[6] * __builtin_amdgcn_rcpf(1.f + __expf(-v1[2])), z[7] * __builtin_amdgcn_rcpf(1.f + __expf(-v1[3])));
                    *(u32x4*)(O + row * DM + 1536 + col) = w; } }
    }
};
}
__device__ __forceinline__ void s5_scan_phase(const Frame& F0, int half, const float* E, const float* LBL, bf16_t* UG) {
    PHASE_FRAME(F0);
    const int gt = F.vcu * (NWAVES * 64) + F.tid, NT = F.G * NWAVES * 64;
    const int nseq = half == 0 ? 4 : 6;
    for (int it = gt; it < nseq * 4096; it += NT) {
        const int s = it >> 12, g = (it >> 7) & 31, dir = (it >> 6) & 1, p = it & 63;
        const int row0 = half == 0 ? (s < 2 ? s * 8192 : 16384 + (s - 2) * 4096) : s * 4096, T = (half == 0 && s < 2) ? 8192 : 4096;
        const int c0 = row0 / S5L, ncs = T / S5L;
        const float ar = LBL[((g * 2 + dir) * 64 + p) * 2], ai = LBL[((g * 2 + dir) * 64 + p) * 2 + 1];
        float sr = 0.f, si = 0.f;
        for (int j0 = 0; j0 < ncs; j0 += 32) {
            f32x2 ev[32];
#pragma unroll
            for (int q = 0; q < 32; ++q) { const int ch = dir == 0 ? c0 + j0 + q : c0 + ncs - 1 - (j0 + q); ev[q] = *(const f32x2*)(E + ((size_t)g * S5NCH + ch) * 256 + dir * 128 + 2 * p); }
#pragma unroll
            for (int q = 0; q < 32; ++q) { const int ch = dir == 0 ? c0 + j0 + q : c0 + ncs - 1 - (j0 + q);
                *(unsigned*)(UG + ((size_t)g * S5NCH + ch) * S5K + 512 + dir * 128 + 2 * p) = pk2(sr, si);
                const float nr = ar * sr - ai * si + ev[q][0], ni = ar * si + ai * sr + ev[q][1]; sr = nr; si = ni; }
        }
    }
}

__device__ __forceinline__ void na_phase(const Frame& F0, int half, const bf16_t* PR, const float* rpb, bf16_t* MIXh) {
    PHASE_FRAME(F0);
    const int tid = F.tid, lane = F.lane, wave = F.wave, r32 = lane & 31, hi = lane >> 5;
    LAS unsigned char* Qt = F.lds; LAS unsigned char* Kt = F.lds + 32768; LAS unsigned char* Vt = F.lds + 65536;
    LAS float* RP = (LAS float*)(F.lds + 98304);
    LAS float* wsx = (LAS float*)(F.lds + 114688 + wave * 256);
    const int hl = wave >> 1, qb = wave & 1, qc = 32 * qb + r32, cs = min(max(qc - 8, 0), 48);
    const FragBase fb = make_fragbase(lane);
    constexpr float QS2 = 0.125f * 1.4426950408889634f, LOG2E = 1.4426950408889634f;
    { const int t1 = opaque_tid(wave); for (int i = t1; i < 8 * 465; i += NWAVES * 64) RP[i] = rpb[i]; }
    for (int u = F.vcu; u < (MH / 64) * 2; u += gridDim.x) {
        const int gr = u >> 1, hq = u & 1;
        int row0, r, rows;
        if (half == 0) { if (gr < 256) { row0 = (gr >> 7) * 8192; r = gr & 127; rows = 128; } else { const int g2 = gr - 256; row0 = 16384 + (g2 >> 6) * 4096; r = g2 & 63; rows = 64; } }
        else { row0 = (gr >> 6) * 4096; r = gr & 63; rows = 64; }
        const int rs = min(max(r - 4, 0), rows - 8);
        { const int t2 = opaque_tid(wave);
#pragma unroll
        for (int i = 0; i < 4; ++i) { const int id = t2 + 512 * i, row = id >> 5, c32 = id & 31;
            *(LAS u32x4*)(Qt + (c32 >> 4) * 16384 + off_a(row, c32 & 15)) = *(const u32x4*)(PR + (size_t)(row0 + r * 64 + row) * PRJ_LD + PC_NQ + hq * 256 + c32 * 8); }
        }
        u32x4 kA[4], vA[4], kB[4], vB[4];
#define NA_LOAD(KS, VS, kr) do { _Pragma("unroll") for (int i = 0; i < 4; ++i) { const int id = tid + 512 * i, row = id >> 5, c32 = id & 31; \
            const bf16_t* gp = PR + (size_t)(row0 + (rs + (kr)) * 64 + row) * PRJ_LD + hq * 256 + c32 * 8; KS[i] = *(const u32x4*)(gp + PC_NK); VS[i] = *(const u32x4*)(gp + PC_NV); } } while (0)
#define NA_WRITE(KS, VS) do { _Pragma("unroll") for (int i = 0; i < 4; ++i) { const int id = tid + 512 * i, row = id >> 5, c32 = id & 31; const unsigned o_ = (c32 >> 4) * 16384 + off_a(row, c32 & 15); \
            *(LAS u32x4*)(Kt + o_) = KS[i]; *(LAS u32x4*)(Vt + o_) = VS[i]; } } while (0)
        NA_LOAD(kA, vA, 0); NA_LOAD(kB, vB, 1);
        float m_run = -1e30f, l_run = 0.f;
        f32x16 o[2];
#pragma unroll
        for (int r_ = 0; r_ < 16; ++r_) { o[0][r_] = 0.f; o[1][r_] = 0.f; }
        bf16x8 qf[4];
#pragma unroll 1
        for (int kr = 0; kr < 8; kr += 2) {
            NA_WRITE(kA, vA);
            __syncthreads();
            if (kr == 0) {
#pragma unroll
                for (int kk = 0; kk < 4; ++kk) qf[kk] = rowfrag(Qt + (hl >> 1) * 16384 + qb * 8192 + (hl & 1) * 1024, 0, kk, fb);
            }
            if (kr + 2 < 8) NA_LOAD(kA, vA, kr + 2);
            {
            const LAS unsigned char* Kh = Kt + (hl >> 1) * 16384 + (hl & 1) * 1024; const LAS unsigned char* Vh = Vt + (hl >> 1) * 16384 + (hl & 1) * 1024;
            f32x16 p0, p1;
#pragma unroll
            for (int r_ = 0; r_ < 16; ++r_) { p0[r_] = 0.f; p1[r_] = 0.f; }
#pragma unroll
            for (int kk = 0; kk < 4; ++kk) { p0 = MFMA32(rowfrag(Kh, 0, kk, fb), qf[kk], p0); p1 = MFMA32(rowfrag(Kh, 1, kk, fb), qf[kk], p1); }
            const LAS float* rp = RP + (hq * 4 + hl) * 465 + (rs + (kr) - r + 7) * 31;
            int bq_ = 15 - qc; asm volatile("" : "+v"(bq_));
            int cs_ = cs; asm volatile("" : "+v"(cs_));
            float pmax = -1e30f;
#pragma unroll
            for (int r_ = 0; r_ < 16; ++r_) {
                const int ka = crow(r_, hi), kb = 32 + ka;
                const bool va = (unsigned)(ka - cs_) < 16u, vb = (unsigned)(kb - cs_) < 16u;
                const float ba = rp[min(max(ka + bq_, 0), 30)], bb = rp[min(max(kb + bq_, 0), 30)];
                p0[r_] = va ? p0[r_] * QS2 + ba * LOG2E : -1e30f; p1[r_] = vb ? p1[r_] * QS2 + bb * LOG2E : -1e30f;
                pmax = fmaxf(pmax, fmaxf(p0[r_], p1[r_]));
            }
            pmax = swap_max(pmax);
            const float mn = fmaxf(m_run, pmax), alpha = __builtin_amdgcn_exp2f(m_run - mn); m_run = mn;
            float ps = 0.f;
#pragma unroll
            for (int r_ = 0; r_ < 16; ++r_) { p0[r_] = __builtin_amdgcn_exp2f(p0[r_] - mn); p1[r_] = __builtin_amdgcn_exp2f(p1[r_] - mn); ps += p0[r_] + p1[r_]; }
            ps = swap_add(ps); l_run = l_run * alpha + ps;
            if (hi == 0) wsx[r32] = alpha;
#pragma unroll
            for (int r_ = 0; r_ < 16; ++r_) { const float al = wsx[crow(r_, hi)]; o[0][r_] *= al; o[1][r_] *= al; }
            bf16x8 pa[4];
            PK4(p0, 0, pa[0]); PK4(p0, 8, pa[1]); PK4(p1, 0, pa[2]); PK4(p1, 8, pa[3]);
#pragma unroll
            for (int d = 0; d < 2; ++d)
#pragma unroll
                for (int ks = 0; ks < 4; ++ks) o[d] = MFMA32(pa[ks], trfrag(Vh, d, ks, fb), o[d]);
            }
            __syncthreads();
            NA_WRITE(kB, vB);
            __syncthreads();
            if (kr + 3 < 8) NA_LOAD(kB, vB, kr + 3);
            {
            const LAS unsigned char* Kh = Kt + (hl >> 1) * 16384 + (hl & 1) * 1024; const LAS unsigned char* Vh = Vt + (hl >> 1) * 16384 + (hl & 1) * 1024;
            f32x16 p0, p1;
#pragma unroll
            for (int r_ = 0; r_ < 16; ++r_) { p0[r_] = 0.f; p1[r_] = 0.f; }
#pragma unroll
            for (int kk = 0; kk < 4; ++kk) { p0 = MFMA32(rowfrag(Kh, 0, kk, fb), qf[kk], p0); p1 = MFMA32(rowfrag(Kh, 1, kk, fb), qf[kk], p1); }
            const LAS float* rp = RP + (hq * 4 + hl) * 465 + (rs + (kr + 1) - r + 7) * 31;
            int bq_ = 15 - qc; asm volatile("" : "+v"(bq_));
            int cs_ = cs; asm volatile("" : "+v"(cs_));
            float pmax = -1e30f;
#pragma unroll
            for (int r_ = 0; r_ < 16; ++r_) {
                const int ka = crow(r_, hi), kb = 32 + ka;
                const bool va = (unsigned)(ka - cs_) < 16u, vb = (unsigned)(kb - cs_) < 16u;
                const float ba = rp[min(max(ka + bq_, 0), 30)], bb = rp[min(max(kb + bq_, 0), 30)];
                p0[r_] = va ? p0[r_] * QS2 + ba * LOG2E : -1e30f; p1[r_] = vb ? p1[r_] * QS2 + bb * LOG2E : -1e30f;
                pmax = fmaxf(pmax, fmaxf(p0[r_], p1[r_]));
            }
            pmax = swap_max(pmax);
            const float mn = fmaxf(m_run, pmax), alpha = __builtin_amdgcn_exp2f(m_run - mn); m_run = mn;
            float ps = 0.f;
#pragma unroll
            for (int r_ = 0; r_ < 16; ++r_) { p0[r_] = __builtin_amdgcn_exp2f(p0[r_] - mn); p1[r_] = __builtin_amdgcn_exp2f(p1[r_] - mn); ps += p0[r_] + p1[r_]; }
            ps = swap_add(ps); l_run = l_run * alpha + ps;
            if (hi == 0) wsx[r32] = alpha;
#pragma unroll
            for (int r_ = 0; r_ < 16; ++r_) { const float al = wsx[crow(r_, hi)]; o[0][r_] *= al; o[1][r_] *= al; }
            bf16x8 pa[4];
            PK4(p0, 0, pa[0]); PK4(p0, 8, pa[1]); PK4(p1, 0, pa[2]); PK4(p1, 8, pa[3]);
#pragma unroll
            for (int d = 0; d < 2; ++d)
#pragma unroll
                for (int ks = 0; ks < 4; ++ks) o[d] = MFMA32(pa[ks], trfrag(Vh, d, ks, fb), o[d]);
            }
            __syncthreads();
        }
        if (hi == 0) wsx[32 + r32] = l_run;
        const int head = hq * 4 + hl;
#pragma unroll
        for (int r_ = 0; r_ < 16; ++r_) { const int q = 32 * qb + crow(r_, hi); const float rl = 1.f / wsx[32 + crow(r_, hi)];
            bf16_t* op = MIXh + (size_t)(row0 + r * 64 + q) * DM + 1024 + head * 64;
            op[r32] = (bf16_t)f2bf(o[0][r_] * rl); op[32 + r32] = (bf16_t)f2bf(o[1][r_] * rl); }
#undef NA_LOAD
#undef NA_WRITE
    }
}

__device__ __forceinline__ void zero_mixed_cols(const Frame& F0, bf16_t* MIXh, int c0) {
    PHASE_FRAME(F0);
    const long gt = (long)F.vcu * (NWAVES * 64) + F.tid, NT = (long)F.G * NWAVES * 64;
    for (long it = gt; it < (long)MH * 64; it += NT) { const int row = (int)(it >> 6), ch = (int)(it & 63);
        *(u32x4*)(MIXh + (size_t)row * DM + c0 + ch * 8) = (u32x4){0u, 0u, 0u, 0u}; }
}

#ifndef EN_DIFF
#define EN_DIFF 1
#endif
#ifndef EN_MLSTM
#define EN_MLSTM 1
#endif
#ifndef EN_NA
#define EN_NA 1
#endif
#ifndef EN_S5
#define EN_S5 1
#endif
struct Args { const float* in[31]; float* out; unsigned char* ws; int ph_lo, ph_hi; };
constexpr size_t SZ_WGATE = (size_t)DM * DFF, SZ_WDOWN = (size_t)DFF * DM;

__global__ void __launch_bounds__(NWAVES * 64, 2) mk_fwd(Args args) {
    extern __shared__ __attribute__((aligned(16))) unsigned char lds_raw[];
    Frame F;
    F.lds = (LAS unsigned char*)lds_raw;
    F.MISC = (volatile LAS unsigned*)(F.lds + MISC_OFF);
    F.tid = threadIdx.x; F.lane = F.tid & 63; F.wave = __builtin_amdgcn_readfirstlane(F.tid >> 6);
    F.G = gridDim.x; { const int bx = blockIdx.x; F.vcu = (F.G % 8 == 0) ? (bx % 8) * (F.G / 8) + bx / 8 : bx; }
    unsigned char* ws = args.ws;
    unsigned* ctl = (unsigned*)(ws + WS_CTL);
    for (int u = F.tid; u < (LDS_BYTES - LDSCTL_OFF) / 4; u += NWAVES * 64) ((LAS unsigned*)(F.lds + LDSCTL_OFF))[u] = 0u;
    __syncthreads();
    XcdBarrier bar = xcd_barrier_post(ctl + CW_BAR, F.MISC + 8);
    const int lo = args.ph_lo, hi = args.ph_hi;
    int ph = 0;
#define IN_PH() (lo <= ph && ph < hi)
#define END_PH() do { if (lo <= ph && ph + 1 < hi) xcd_barrier(bar, F.wave); ++ph; } while (0)

    float* X = args.out;
    _Float16* XH = (_Float16*)((unsigned char*)args.out + (size_t)MTOT * DM * 2);
    bf16_t* XN = (bf16_t*)(ws + WS_XN);
    bf16_t* HB = (bf16_t*)(ws + WS_BIG);
    bf16_t* PROJ = (bf16_t*)(ws + MX_PROJ);
    bf16_t* UG = (bf16_t*)(ws + MX_UG);
    float* GATES = (float*)(ws + MX_GATES);
    float* ROPE = (float*)(ws + WS_ROPE);
    float* S5E = (float*)(ws + MX_E); bf16_t* S5Z = (bf16_t*)(ws + MX_Z);
    bf16_t* QKC = (bf16_t*)(ws + MX_QKC); bf16_t* CST = (bf16_t*)(ws + MX_CST); float* NST = (float*)(ws + MX_NST); float* MSC = (float*)(ws + MX_MSC);

{ constexpr int layer = 0;
        if (IN_PH()) {
{ constexpr int rep = 0;
            convert_ffn_weights(F, args.in[3] + layer * SZ_WGATE, args.in[4] + layer * SZ_WGATE, args.in[5] + layer * SZ_WDOWN, (bf16_t*)(ws + W_GU1), (bf16_t*)(ws + W_D1));
            convert_ffn_weights(F, args.in[27] + layer * SZ_WGATE, args.in[28] + layer * SZ_WGATE, args.in[29] + layer * SZ_WDOWN, (bf16_t*)(ws + W_GU2), (bf16_t*)(ws + W_D2));
            convert_mixer_weights(F, args.in[7] + (size_t)layer * DM * IN_W, args.in[25] + (size_t)layer * DM * DM, args.in[23] + (size_t)layer * GWID * GWID,
                                  (bf16_t*)(ws + W_IN), (bf16_t*)(ws + W_OUT), (bf16_t*)(ws + W_GLU));
}
            if (layer == 0) rope_table_phase(F, ROPE);
            __syncthreads();
{ constexpr int rep = 0;
            if (EN_S5) s5_build_phase(F, layer, args.in, (bf16_t*)(ws + W_S5MR), (bf16_t*)(ws + W_S5P), (float*)(ws + W_LBL));
}
            if (layer == 0) rms_phase(F, args.in[0], args.in[1], nullptr, nullptr, nullptr, args.in[2] + layer * DM, XN, nullptr);
            else rms_phase(F, nullptr, nullptr, XH, XN, XN, args.in[2] + layer * DM, XN, XH);
        }
        END_PH();
{ constexpr int f = 0;
            if (f == 1) {
            if (IN_PH()) rms_phase(F, nullptr, nullptr, XH, (const bf16_t*)(ws + WS_SPARE), HB, args.in[26] + layer * DM, XN, XH);
            END_PH();
            }
            if (IN_PH()) {
{ constexpr int rep = 0;
                pg8::Gemm g{XN, (const bf16_t*)(ws + (f == 0 ? W_GU1 : W_GU2)), DM, DM, DM};
                pg8::StaticOrder S; S.init(MTOT / 256, 2 * DFF / 256, F.G, (int)blockIdx.x, 32);
                pg8::EpiSwiglu E{HB, DFF};
                pg8::gemm_phase<pg8::EpiSwiglu, pg8::StaticOrder, true, true>(F.lds, g, S, E, F.wave);
}
            }
            END_PH();
            if (IN_PH()) {
{ constexpr int rep = 0;
                pg8::Gemm g{HB, (const bf16_t*)(ws + (f == 0 ? W_D1 : W_D2)), DFF, DFF, DFF};
                pg8::StaticOrder S; S.init(MTOT / 256, DM / 256, F.G, (int)blockIdx.x, 4, 0);
                pg8::EpiDelta E{XN, DM, 0.5f};
                pg8::gemm_phase<pg8::EpiDelta, pg8::StaticOrder, true, true>(F.lds, g, S, E, F.wave);
}
            }
            END_PH();
            if (f == 0) {
                if (IN_PH()) { if (layer == 0) rms_phase(F, args.in[0], args.in[1], nullptr, XN, XN, args.in[6] + layer * DM, XN, XH);
                    else rms_phase(F, nullptr, nullptr, XH, XN, XN, args.in[6] + layer * DM, XN, XH); }
                END_PH();
{ constexpr int half = 0;
                    bf16_t* MIXh = XN + (size_t)half * MH * DM;
                    if (IN_PH()) {
{ constexpr int rep = 0;
                        pg8::Gemm g{XN + (size_t)half * MH * DM, (const bf16_t*)(ws + W_IN), DM, DM, DM};
                        pg8::StaticOrder S; S.init(MH / 256, IN_WP / 256, F.G, (int)blockIdx.x, 32);
                        pg8::EpiInProj E{PROJ, UG, GATES, args.in[10] + layer * 16, ROPE, half};
                        pg8::gemm_phase<pg8::EpiInProj, pg8::StaticOrder, true, true>(F.lds, g, S, E, F.wave);
}
                        if (half == 1) {
                            pg8::Gemm g0{XN, (const bf16_t*)(ws + W_OUT), DM, DM, DM};
                            pg8::StaticOrder S0; S0.init(MH / 256, DM / 256, F.G, (int)blockIdx.x, 32);
                            pg8::EpiDelta E0{(bf16_t*)(ws + WS_SPARE), DM, 1.0f};
                            pg8::gemm_phase<pg8::EpiDelta, pg8::StaticOrder, true, true>(F.lds, g0, S0, E0, F.wave);
                        }
                    }
                    END_PH();
                    if (IN_PH()) {
{ constexpr int rep = 0;
                        if (EN_MLSTM) { mlstm_conv_phase(F, half, PROJ, QKC, args.in[8] + layer * 5 * 1024, args.in[9] + layer * 1024); mlstm_scalar_phase(F, GATES, MSC); }
}
                        if (!EN_MLSTM) zero_mixed_cols(F, MIXh, 0);
                        if (!EN_DIFF) zero_mixed_cols(F, MIXh, 512);
                        if (!EN_NA) zero_mixed_cols(F, MIXh, 1024);
                        if (!EN_S5) zero_mixed_cols(F, MIXh, 1536);
                        if (EN_S5) { __syncthreads();
                            pg8::Gemm g{UG, (const bf16_t*)(ws + W_S5P), 512, S5K, 512}; pg8::S5OrderA S{F.G, (int)blockIdx.x}; pg8::EpiS5E E{S5E};
                            pg8::gemm_phase<pg8::EpiS5E, pg8::S5OrderA, true, true>(F.lds, g, S, E, F.wave); }
                    }
                    END_PH();
                    if (IN_PH()) {
{ constexpr int rep = 0;
                        if (EN_S5) s5_scan_phase(F, half, S5E, (const float*)(ws + W_LBL), UG);
}
{ constexpr int rep = 0;
                        if (EN_NA) { na_phase(F, half, PROJ, args.in[14] + (size_t)layer * 8 * 465, MIXh); __syncthreads(); }
}
{ constexpr int rep = 0;
                        if (EN_MLSTM) mlstm_state_phase(F, PROJ, QKC, MSC, CST, NST);
}
                    }
                    END_PH();
                    if (IN_PH()) {
                        if (EN_MLSTM) mlstm_scan_phase(F, half, MSC, CST, NST);
{ constexpr int rep = 0;
                        if (EN_S5) { pg8::Gemm g{UG, (const bf16_t*)(ws + W_S5MR), S5K, S5K, S5K}; pg8::S5OrderB S{F.G, (int)blockIdx.x}; pg8::EpiS5Z E{S5Z};
                            pg8::gemm_phase<pg8::EpiS5Z, pg8::S5OrderB, true, true>(F.lds, g, S, E, F.wave); __syncthreads(); }
}
{ constexpr int rep = 0;
                        if (EN_DIFF) diffattn_phase(F, half, layer, PROJ, MIXh, args.in[12] + layer * 256, args.in[13] + layer * 128);
}
                    }
                    END_PH();
                    if (IN_PH()) {
{ constexpr int rep = 0;
                        if (EN_MLSTM) mlstm_out_phase(F, PROJ, QKC, MSC, CST, NST, args.in[11] + layer * GWID, MIXh);
}
                        if (EN_S5) { __syncthreads();
                            pg8::Gemm g{S5Z, (const bf16_t*)(ws + W_GLU), GWID, GWID, GWID}; pg8::StaticOrder S; S.init(MH / 256, GWID / 256, F.G, (int)blockIdx.x);
                            pg8::EpiGlu E{S5Z, args.in[24] + layer * GWID, MIXh};
                            pg8::gemm_phase<pg8::EpiGlu, pg8::StaticOrder, true, true>(F.lds, g, S, E, F.wave); }
                    }
                    END_PH();
                    if (half == 1) {
                    if (IN_PH()) {
                        pg8::Gemm g{MIXh, (const bf16_t*)(ws + W_OUT), DM, DM, DM};
                        pg8::StaticOrder S; S.init(MH / 256, DM / 256, F.G, (int)blockIdx.x, 32);
                        pg8::EpiDelta E{HB + (size_t)MH * DM, DM, 1.0f};
                        pg8::gemm_phase<pg8::EpiDelta, pg8::StaticOrder, true, true>(F.lds, g, S, E, F.wave);
                    }
                    END_PH();
                    }
}
{ constexpr int half = 1;
                    bf16_t* MIXh = XN + (size_t)half * MH * DM;
                    if (IN_PH()) {
{ constexpr int rep = 0;
                        pg8::Gemm g{XN + (size_t)half * MH * DM, (const bf16_t*)(ws + W_IN), DM, DM, DM};
                        pg8::StaticOrder S; S.init(MH / 256, IN_WP / 256, F.G, (int)blockIdx.x, 32);
                        pg8::EpiInProj E{PROJ, UG, GATES, args.in[10] + layer * 16, ROPE, half};
                        pg8::gemm_phase<pg8::EpiInProj, pg8::StaticOrder, true, true>(F.lds, g, S, E, F.wave);
}
                        if (half == 1) {
                            pg8::Gemm g0{XN, (const bf16_t*)(ws + W_OUT), DM, DM, DM};
                            pg8::StaticOrder S0; S0.init(MH / 256, DM / 256, F.G, (int)blockIdx.x, 32);
                            pg8::EpiDelta E0{(bf16_t*)(ws + WS_SPARE), DM, 1.0f};
                            pg8::gemm_phase<pg8::EpiDelta, pg8::StaticOrder, true, true>(F.lds, g0, S0, E0, F.wave);
                        }
                    }
                    END_PH();
                    if (IN_PH()) {
{ constexpr int rep = 0;
                        if (EN_MLSTM) { mlstm_conv_phase(F, half, PROJ, QKC, args.in[8] + layer * 5 * 1024, args.in[9] + layer * 1024); mlstm_scalar_phase(F, GATES, MSC); }
}
                        if (!EN_MLSTM) zero_mixed_cols(F, MIXh, 0);
                        if (!EN_DIFF) zero_mixed_cols(F, MIXh, 512);
                        if (!EN_NA) zero_mixed_cols(F, MIXh, 1024);
                        if (!EN_S5) zero_mixed_cols(F, MIXh, 1536);
                        if (EN_S5) { __syncthreads();
                            pg8::Gemm g{UG, (const bf16_t*)(ws + W_S5P), 512, S5K, 512}; pg8::S5OrderA S{F.G, (int)blockIdx.x}; pg8::EpiS5E E{S5E};
                            pg8::gemm_phase<pg8::EpiS5E, pg8::S5OrderA, true, true>(F.lds, g, S, E, F.wave); }
                    }
                    END_PH();
                    if (IN_PH()) {
{ constexpr int rep = 0;
                        if (EN_S5) s5_scan_phase(F, half, S5E, (const float*)(ws + W_LBL), UG);
}
{ constexpr int rep = 0;
                        if (EN_NA) { na_phase(F, half, PROJ, args.in[14] + (size_t)layer * 8 * 465, MIXh); __syncthreads(); }
}
{ constexpr int rep = 0;
                        if (EN_MLSTM) mlstm_state_phase(F, PROJ, QKC, MSC, CST, NST);
}
                    }
                    END_PH();
                    if (IN_PH()) {
                        if (EN_MLSTM) mlstm_scan_phase(F, half, MSC, CST, NST);
{ constexpr int rep = 0;
                        if (EN_S5) { pg8::Gemm g{UG, (const bf16_t*)(ws + W_S5MR), S5K, S5K, S5K}; pg8::S5OrderB S{F.G, (int)blockIdx.x}; pg8::EpiS5Z E{S5Z};
                            pg8::gemm_phase<pg8::EpiS5Z, pg8::S5OrderB, true, true>(F.lds, g, S, E, F.wave); __syncthreads(); }
}
{ constexpr int rep = 0;
                        if (EN_DIFF) diffattn_phase(F, half, layer, PROJ, MIXh, args.in[12] + layer * 256, args.in[13] + layer * 128);
}
                    }
                    END_PH();
                    if (IN_PH()) {
{ constexpr int rep = 0;
                        if (EN_MLSTM) mlstm_out_phase(F, PROJ, QKC, MSC, CST, NST, args.in[11] + layer * GWID, MIXh);
}
                        if (EN_S5) { __syncthreads();
                            pg8::Gemm g{S5Z, (const bf16_t*)(ws + W_GLU), GWID, GWID, GWID}; pg8::StaticOrder S; S.init(MH / 256, GWID / 256, F.G, (int)blockIdx.x);
                            pg8::EpiGlu E{S5Z, args.in[24] + layer * GWID, MIXh};
                            pg8::gemm_phase<pg8::EpiGlu, pg8::StaticOrder, true, true>(F.lds, g, S, E, F.wave); }
                    }
                    END_PH();
                    if (half == 1) {
                    if (IN_PH()) {
                        pg8::Gemm g{MIXh, (const bf16_t*)(ws + W_OUT), DM, DM, DM};
                        pg8::StaticOrder S; S.init(MH / 256, DM / 256, F.G, (int)blockIdx.x, 32);
                        pg8::EpiDelta E{HB + (size_t)MH * DM, DM, 1.0f};
                        pg8::gemm_phase<pg8::EpiDelta, pg8::StaticOrder, true, true>(F.lds, g, S, E, F.wave);
                    }
                    END_PH();
                    }
}
            }
}
{ constexpr int f = 1;
            if (f == 1) {
            if (IN_PH()) rms_phase(F, nullptr, nullptr, XH, (const bf16_t*)(ws + WS_SPARE), HB, args.in[26] + layer * DM, XN, XH);
            END_PH();
            }
            if (IN_PH()) {
{ constexpr int rep = 0;
                pg8::Gemm g{XN, (const bf16_t*)(ws + (f == 0 ? W_GU1 : W_GU2)), DM, DM, DM};
                pg8::StaticOrder S; S.init(MTOT / 256, 2 * DFF / 256, F.G, (int)blockIdx.x, 32);
                pg8::EpiSwiglu E{HB, DFF};
                pg8::gemm_phase<pg8::EpiSwiglu, pg8::StaticOrder, true, true>(F.lds, g, S, E, F.wave);
}
            }
            END_PH();
            if (IN_PH()) {
{ constexpr int rep = 0;
                pg8::Gemm g{HB, (const bf16_t*)(ws + (f == 0 ? W_D1 : W_D2)), DFF, DFF, DFF};
                pg8::StaticOrder S; S.init(MTOT / 256, DM / 256, F.G, (int)blockIdx.x, 4, 0);
                pg8::EpiDelta E{XN, DM, 0.5f};
                pg8::gemm_phase<pg8::EpiDelta, pg8::StaticOrder, true, true>(F.lds, g, S, E, F.wave);
}
            }
            END_PH();
            if (f == 0) {
                if (IN_PH()) { if (layer == 0) rms_phase(F, args.in[0], args.in[1], nullptr, XN, XN, args.in[6] + layer * DM, XN, XH);
                    else rms_phase(F, nullptr, nullptr, XH, XN, XN, args.in[6] + layer * DM, XN, XH); }
                END_PH();
{ constexpr int half = 0;
                    bf16_t* MIXh = XN + (size_t)half * MH * DM;
                    if (IN_PH()) {
{ constexpr int rep = 0;
                        pg8::Gemm g{XN + (size_t)half * MH * DM, (const bf16_t*)(ws + W_IN), DM, DM, DM};
                        pg8::StaticOrder S; S.init(MH / 256, IN_WP / 256, F.G, (int)blockIdx.x, 32);
                        pg8::EpiInProj E{PROJ, UG, GATES, args.in[10] + layer * 16, ROPE, half};
                        pg8::gemm_phase<pg8::EpiInProj, pg8::StaticOrder, true, true>(F.lds, g, S, E, F.wave);
}
                        if (half == 1) {
                            pg8::Gemm g0{XN, (const bf16_t*)(ws + W_OUT), DM, DM, DM};
                            pg8::StaticOrder S0; S0.init(MH / 256, DM / 256, F.G, (int)blockIdx.x, 32);
                            pg8::EpiDelta E0{(bf16_t*)(ws + WS_SPARE), DM, 1.0f};
                            pg8::gemm_phase<pg8::EpiDelta, pg8::StaticOrder, true, true>(F.lds, g0, S0, E0, F.wave);
                        }
                    }
                    END_PH();
                    if (IN_PH()) {
{ constexpr int rep = 0;
                        if (EN_MLSTM) { mlstm_conv_phase(F, half, PROJ, QKC, args.in[8] + layer * 5 * 1024, args.in[9] + layer * 1024); mlstm_scalar_phase(F, GATES, MSC); }
}
                        if (!EN_MLSTM) zero_mixed_cols(F, MIXh, 0);
                        if (!EN_DIFF) zero_mixed_cols(F, MIXh, 512);
                        if (!EN_NA) zero_mixed_cols(F, MIXh, 1024);
                        if (!EN_S5) zero_mixed_cols(F, MIXh, 1536);
                        if (EN_S5) { __syncthreads();
                            pg8::Gemm g{UG, (const bf16_t*)(ws + W_S5P), 512, S5K, 512}; pg8::S5OrderA S{F.G, (int)blockIdx.x}; pg8::EpiS5E E{S5E};
                            pg8::gemm_phase<pg8::EpiS5E, pg8::S5OrderA, true, true>(F.lds, g, S, E, F.wave); }
                    }
                    END_PH();
                    if (IN_PH()) {
{ constexpr int rep = 0;
                        if (EN_S5) s5_scan_phase(F, half, S5E, (const float*)(ws + W_LBL), UG);
}
{ constexpr int rep = 0;
                        if (EN_NA) { na_phase(F, half, PROJ, args.in[14] + (size_t)layer * 8 * 465, MIXh); __syncthreads(); }
}
{ constexpr int rep = 0;
                        if (EN_MLSTM) mlstm_state_phase(F, PROJ, QKC, MSC, CST, NST);
}
                    }
                    END_PH();
                    if (IN_PH()) {
                        if (EN_MLSTM) mlstm_scan_phase(F, half, MSC, CST, NST);
{ constexpr int rep = 0;
                        if (EN_S5) { pg8::Gemm g{UG, (const bf16_t*)(ws + W_S5MR), S5K, S5K, S5K}; pg8::S5OrderB S{F.G, (int)blockIdx.x}; pg8::EpiS5Z E{S5Z};
                            pg8::gemm_phase<pg8::EpiS5Z, pg8::S5OrderB, true, true>(F.lds, g, S, E, F.wave); __syncthreads(); }
}
{ constexpr int rep = 0;
                        if (EN_DIFF) diffattn_phase(F, half, layer, PROJ, MIXh, args.in[12] + layer * 256, args.in[13] + layer * 128);
}
                    }
                    END_PH();
                    if (IN_PH()) {
{ constexpr int rep = 0;
                        if (EN_MLSTM) mlstm_out_phase(F, PROJ, QKC, MSC, CST, NST, args.in[11] + layer * GWID, MIXh);
}
                        if (EN_S5) { __syncthreads();
                            pg8::Gemm g{S5Z, (const bf16_t*)(ws + W_GLU), GWID, GWID, GWID}; pg8::StaticOrder S; S.init(MH / 256, GWID / 256, F.G, (int)blockIdx.x);
                            pg8::EpiGlu E{S5Z, args.in[24] + layer * GWID, MIXh};
                            pg8::gemm_phase<pg8::EpiGlu, pg8::StaticOrder, true, true>(F.lds, g, S, E, F.wave); }
                    }
                    END_PH();
                    if (half == 1) {
                    if (IN_PH()) {
                        pg8::Gemm g{MIXh, (const bf16_t*)(ws + W_OUT), DM, DM, DM};
                        pg8::StaticOrder S; S.init(MH / 256, DM / 256, F.G, (int)blockIdx.x, 32);
                        pg8::EpiDelta E{HB + (size_t)MH * DM, DM, 1.0f};
                        pg8::gemm_phase<pg8::EpiDelta, pg8::StaticOrder, true, true>(F.lds, g, S, E, F.wave);
                    }
                    END_PH();
                    }
}
{ constexpr int half = 1;
                    bf16_t* MIXh = XN + (size_t)half * MH * DM;
                    if (IN_PH()) {
{ constexpr int rep = 0;
                        pg8::Gemm g{XN + (size_t)half * MH * DM, (const bf16_t*)(ws + W_IN), DM, DM, DM};
                        pg8::StaticOrder S; S.init(MH / 256, IN_WP / 256, F.G, (int)blockIdx.x, 32);
                        pg8::EpiInProj E{PROJ, UG, GATES, args.in[10] + layer * 16, ROPE, half};
                        pg8::gemm_phase<pg8::EpiInProj, pg8::StaticOrder, true, true>(F.lds, g, S, E, F.wave);
}
                        if (half == 1) {
                            pg8::Gemm g0{XN, (const bf16_t*)(ws + W_OUT), DM, DM, DM};
                            pg8::StaticOrder S0; S0.init(MH / 256, DM / 256, F.G, (int)blockIdx.x, 32);
                            pg8::EpiDelta E0{(bf16_t*)(ws + WS_SPARE), DM, 1.0f};
                            pg8::gemm_phase<pg8::EpiDelta, pg8::StaticOrder, true, true>(F.lds, g0, S0, E0, F.wave);
                        }
                    }
                    END_PH();
                    if (IN_PH()) {
{ constexpr int rep = 0;
                        if (EN_MLSTM) { mlstm_conv_phase(F, half, PROJ, QKC, args.in[8] + layer * 5 * 1024, args.in[9] + layer * 1024); mlstm_scalar_phase(F, GATES, MSC); }
}
                        if (!EN_MLSTM) zero_mixed_cols(F, MIXh, 0);
                        if (!EN_DIFF) zero_mixed_cols(F, MIXh, 512);
                        if (!EN_NA) zero_mixed_cols(F, MIXh, 1024);
                        if (!EN_S5) zero_mixed_cols(F, MIXh, 1536);
                        if (EN_S5) { __syncthreads();
                            pg8::Gemm g{UG, (const bf16_t*)(ws + W_S5P), 512, S5K, 512}; pg8::S5OrderA S{F.G, (int)blockIdx.x}; pg8::EpiS5E E{S5E};
                            pg8::gemm_phase<pg8::EpiS5E, pg8::S5OrderA, true, true>(F.lds, g, S, E, F.wave); }
                    }
                    END_PH();
                    if (IN_PH()) {
{ constexpr int rep = 0;
                        if (EN_S5) s5_scan_phase(F, half, S5E, (const float*)(ws + W_LBL), UG);
}
{ constexpr int rep = 0;
                        if (EN_NA) { na_phase(F, half, PROJ, args.in[14] + (size_t)layer * 8 * 465, MIXh); __syncthreads(); }
}
{ constexpr int rep = 0;
                        if (EN_MLSTM) mlstm_state_phase(F, PROJ, QKC, MSC, CST, NST);
}
                    }
                    END_PH();
                    if (IN_PH()) {
                        if (EN_MLSTM) mlstm_scan_phase(F, half, MSC, CST, NST);
{ constexpr int rep = 0;
                        if (EN_S5) { pg8::Gemm g{UG, (const bf16_t*)(ws + W_S5MR), S5K, S5K, S5K}; pg8::S5OrderB S{F.G, (int)blockIdx.x}; pg8::EpiS5Z E{S5Z};
                            pg8::gemm_phase<pg8::EpiS5Z, pg8::S5OrderB, true, true>(F.lds, g, S, E, F.wave); __syncthreads(); }
}
{ constexpr int rep = 0;
                        if (EN_DIFF) diffattn_phase(F, half, layer, PROJ, MIXh, args.in[12] + layer * 256, args.in[13] + layer * 128);
}
                    }
                    END_PH();
                    if (IN_PH()) {
{ constexpr int rep = 0;
                        if (EN_MLSTM) mlstm_out_phase(F, PROJ, QKC, MSC, CST, NST, args.in[11] + layer * GWID, MIXh);
}
                        if (EN_S5) { __syncthreads();
                            pg8::Gemm g{S5Z, (const bf16_t*)(ws + W_GLU), GWID, GWID, GWID}; pg8::StaticOrder S; S.init(MH / 256, GWID / 256, F.G, (int)blockIdx.x);
                            pg8::EpiGlu E{S5Z, args.in[24] + layer * GWID, MIXh};
                            pg8::gemm_phase<pg8::EpiGlu, pg8::StaticOrder, true, true>(F.lds, g, S, E, F.wave); }
                    }
                    END_PH();
                    if (half == 1) {
                    if (IN_PH()) {
                        pg8::Gemm g{MIXh, (const bf16_t*)(ws + W_OUT), DM, DM, DM};
                        pg8::StaticOrder S; S.init(MH / 256, DM / 256, F.G, (int)blockIdx.x, 32);
                        pg8::EpiDelta E{HB + (size_t)MH * DM, DM, 1.0f};
                        pg8::gemm_phase<pg8::EpiDelta, pg8::StaticOrder, true, true>(F.lds, g, S, E, F.wave);
                    }
                    END_PH();
                    }
}
            }
}
}
{ constexpr int layer = 1;
        if (IN_PH()) {
{ constexpr int rep = 0;
            convert_ffn_weights(F, args.in[3] + layer * SZ_WGATE, args.in[4] + layer * SZ_WGATE, args.in[5] + layer * SZ_WDOWN, (bf16_t*)(ws + W_GU1), (bf16_t*)(ws + W_D1));
            convert_ffn_weights(F, args.in[27] + layer * SZ_WGATE, args.in[28] + layer * SZ_WGATE, args.in[29] + layer * SZ_WDOWN, (bf16_t*)(ws + W_GU2), (bf16_t*)(ws + W_D2));
            convert_mixer_weights(F, args.in[7] + (size_t)layer * DM * IN_W, args.in[25] + (size_t)layer * DM * DM, args.in[23] + (size_t)layer * GWID * GWID,
                                  (bf16_t*)(ws + W_IN), (bf16_t*)(ws + W_OUT), (bf16_t*)(ws + W_GLU));
}
            if (layer == 0) rope_table_phase(F, ROPE);
            __syncthreads();
{ constexpr int rep = 0;
            if (EN_S5) s5_build_phase(F, layer, args.in, (bf16_t*)(ws + W_S5MR), (bf16_t*)(ws + W_S5P), (float*)(ws + W_LBL));
}
            if (layer == 0) rms_phase(F, args.in[0], args.in[1], nullptr, nullptr, nullptr, args.in[2] + layer * DM, XN, nullptr);
            else rms_phase(F, nullptr, nullptr, XH, XN, XN, args.in[2] + layer * DM, XN, XH);
        }
        END_PH();
{ constexpr int f = 0;
            if (f == 1) {
            if (IN_PH()) rms_phase(F, nullptr, nullptr, XH, (const bf16_t*)(ws + WS_SPARE), HB, args.in[26] + layer * DM, XN, XH);
            END_PH();
            }
            if (IN_PH()) {
{ constexpr int rep = 0;
                pg8::Gemm g{XN, (const bf16_t*)(ws + (f == 0 ? W_GU1 : W_GU2)), DM, DM, DM};
                pg8::StaticOrder S; S.init(MTOT / 256, 2 * DFF / 256, F.G, (int)blockIdx.x, 32);
                pg8::EpiSwiglu E{HB, DFF};
                pg8::gemm_phase<pg8::EpiSwiglu, pg8::StaticOrder, true, true>(F.lds, g, S, E, F.wave);
}
            }
            END_PH();
            if (IN_PH()) {
{ constexpr int rep = 0;
                pg8::Gemm g{HB, (const bf16_t*)(ws + (f == 0 ? W_D1 : W_D2)), DFF, DFF, DFF};
                pg8::StaticOrder S; S.init(MTOT / 256, DM / 256, F.G, (int)blockIdx.x, 4, 0);
                pg8::EpiDelta E{XN, DM, 0.5f};
                pg8::gemm_phase<pg8::EpiDelta, pg8::StaticOrder, true, true>(F.lds, g, S, E, F.wave);
}
            }
            END_PH();
            if (f == 0) {
                if (IN_PH()) { if (layer == 0) rms_phase(F, args.in[0], args.in[1], nullptr, XN, XN, args.in[6] + layer * DM, XN, XH);
                    else rms_phase(F, nullptr, nullptr, XH, XN, XN, args.in[6] + layer * DM, XN, XH); }
                END_PH();
{ constexpr int half = 0;
                    bf16_t* MIXh = XN + (size_t)half * MH * DM;
                    if (IN_PH()) {
{ constexpr int rep = 0;
                        pg8::Gemm g{XN + (size_t)half * MH * DM, (const bf16_t*)(ws + W_IN), DM, DM, DM};
                        pg8::StaticOrder S; S.init(MH / 256, IN_WP / 256, F.G, (int)blockIdx.x, 32);
                        pg8::EpiInProj E{PROJ, UG, GATES, args.in[10] + layer * 16, ROPE, half};
                        pg8::gemm_phase<pg8::EpiInProj, pg8::StaticOrder, true, true>(F.lds, g, S, E, F.wave);
}
                        if (half == 1) {
                            pg8::Gemm g0{XN, (const bf16_t*)(ws + W_OUT), DM, DM, DM};
                            pg8::StaticOrder S0; S0.init(MH / 256, DM / 256, F.G, (int)blockIdx.x, 32);
                            pg8::EpiDelta E0{(bf16_t*)(ws + WS_SPARE), DM, 1.0f};
                            pg8::gemm_phase<pg8::EpiDelta, pg8::StaticOrder, true, true>(F.lds, g0, S0, E0, F.wave);
                        }
                    }
                    END_PH();
                    if (IN_PH()) {
{ constexpr int rep = 0;
                        if (EN_MLSTM) { mlstm_conv_phase(F, half, PROJ, QKC, args.in[8] + layer * 5 * 1024, args.in[9] + layer * 1024); mlstm_scalar_phase(F, GATES, MSC); }
}
                        if (!EN_MLSTM) zero_mixed_cols(F, MIXh, 0);
                        if (!EN_DIFF) zero_mixed_cols(F, MIXh, 512);
                        if (!EN_NA) zero_mixed_cols(F, MIXh, 1024);
                        if (!EN_S5) zero_mixed_cols(F, MIXh, 1536);
                        if (EN_S5) { __syncthreads();
                            pg8::Gemm g{UG, (const bf16_t*)(ws + W_S5P), 512, S5K, 512}; pg8::S5OrderA S{F.G, (int)blockIdx.x}; pg8::EpiS5E E{S5E};
                            pg8::gemm_phase<pg8::EpiS5E, pg8::S5OrderA, true, true>(F.lds, g, S, E, F.wave); }
                    }
                    END_PH();
                    if (IN_PH()) {
{ constexpr int rep = 0;
                        if (EN_S5) s5_scan_phase(F, half, S5E, (const float*)(ws + W_LBL), UG);
}
{ constexpr int rep = 0;
                        if (EN_NA) { na_phase(F, half, PROJ, args.in[14] + (size_t)layer * 8 * 465, MIXh); __syncthreads(); }
}
{ constexpr int rep = 0;
                        if (EN_MLSTM) mlstm_state_phase(F, PROJ, QKC, MSC, CST, NST);
}
                    }
                    END_PH();
                    if (IN_PH()) {
                        if (EN_MLSTM) mlstm_scan_phase(F, half, MSC, CST, NST);
{ constexpr int rep = 0;
                        if (EN_S5) { pg8::Gemm g{UG, (const bf16_t*)(ws + W_S5MR), S5K, S5K, S5K}; pg8::S5OrderB S{F.G, (int)blockIdx.x}; pg8::EpiS5Z E{S5Z};
                            pg8::gemm_phase<pg8::EpiS5Z, pg8::S5OrderB, true, true>(F.lds, g, S, E, F.wave); __syncthreads(); }
}
{ constexpr int rep = 0;
                        if (EN_DIFF) diffattn_phase(F, half, layer, PROJ, MIXh, args.in[12] + layer * 256, args.in[13] + layer * 128);
}
                    }
                    END_PH();
                    if (IN_PH()) {
{ constexpr int rep = 0;
                        if (EN_MLSTM) mlstm_out_phase(F, PROJ, QKC, MSC, CST, NST, args.in[11] + layer * GWID, MIXh);
}
                        if (EN_S5) { __syncthreads();
                            pg8::Gemm g{S5Z, (const bf16_t*)(ws + W_GLU), GWID, GWID, GWID}; pg8::StaticOrder S; S.init(MH / 256, GWID / 256, F.G, (int)blockIdx.x);
                            pg8::EpiGlu E{S5Z, args.in[24] + layer * GWID, MIXh};
                            pg8::gemm_phase<pg8::EpiGlu, pg8::StaticOrder, true, true>(F.lds, g, S, E, F.wave); }
                    }
                    END_PH();
                    if (half == 1) {
                    if (IN_PH()) {
                        pg8::Gemm g{MIXh, (const bf16_t*)(ws + W_OUT), DM, DM, DM};
                        pg8::StaticOrder S; S.init(MH / 256, DM / 256, F.G, (int)blockIdx.x, 32);
                        pg8::EpiDelta E{HB + (size_t)MH * DM, DM, 1.0f};
                        pg8::gemm_phase<pg8::EpiDelta, pg8::StaticOrder, true, true>(F.lds, g, S, E, F.wave);
                    }
                    END_PH();
                    }
}
{ constexpr int half = 1;
                    bf16_t* MIXh = XN + (size_t)half * MH * DM;
                    if (IN_PH()) {
{ constexpr int rep = 0;
                        pg8::Gemm g{XN + (size_t)half * MH * DM, (const bf16_t*)(ws + W_IN), DM, DM, DM};
                        pg8::StaticOrder S; S.init(MH / 256, IN_WP / 256, F.G, (int)blockIdx.x, 32);
                        pg8::EpiInProj E{PROJ, UG, GATES, args.in[10] + layer * 16, ROPE, half};
                        pg8::gemm_phase<pg8::EpiInProj, pg8::StaticOrder, true, true>(F.lds, g, S, E, F.wave);
}
                        if (half == 1) {
                            pg8::Gemm g0{XN, (const bf16_t*)(ws + W_OUT), DM, DM, DM};
                            pg8::StaticOrder S0; S0.init(MH / 256, DM / 256, F.G, (int)blockIdx.x, 32);
                            pg8::EpiDelta E0{(bf16_t*)(ws + WS_SPARE), DM, 1.0f};
                            pg8::gemm_phase<pg8::EpiDelta, pg8::StaticOrder, true, true>(F.lds, g0, S0, E0, F.wave);
                        }
                    }
                    END_PH();
                    if (IN_PH()) {
{ constexpr int rep = 0;
                        if (EN_MLSTM) { mlstm_conv_phase(F, half, PROJ, QKC, args.in[8] + layer * 5 * 1024, args.in[9] + layer * 1024); mlstm_scalar_phase(F, GATES, MSC); }
}
                        if (!EN_MLSTM) zero_mixed_cols(F, MIXh, 0);
                        if (!EN_DIFF) zero_mixed_cols(F, MIXh, 512);
                        if (!EN_NA) zero_mixed_cols(F, MIXh, 1024);
                        if (!EN_S5) zero_mixed_cols(F, MIXh, 1536);
                        if (EN_S5) { __syncthreads();
                            pg8::Gemm g{UG, (const bf16_t*)(ws + W_S5P), 512, S5K, 512}; pg8::S5OrderA S{F.G, (int)blockIdx.x}; pg8::EpiS5E E{S5E};
                            pg8::gemm_phase<pg8::EpiS5E, pg8::S5OrderA, true, true>(F.lds, g, S, E, F.wave); }
                    }
                    END_PH();
                    if (IN_PH()) {
{ constexpr int rep = 0;
                        if (EN_S5) s5_scan_phase(F, half, S5E, (const float*)(ws + W_LBL), UG);
}
{ constexpr int rep = 0;
                        if (EN_NA) { na_phase(F, half, PROJ, args.in[14] + (size_t)layer * 8 * 465, MIXh); __syncthreads(); }
}
{ constexpr int rep = 0;
                        if (EN_MLSTM) mlstm_state_phase(F, PROJ, QKC, MSC, CST, NST);
}
                    }
                    END_PH();
                    if (IN_PH()) {
                        if (EN_MLSTM) mlstm_scan_phase(F, half, MSC, CST, NST);
{ constexpr int rep = 0;
                        if (EN_S5) { pg8::Gemm g{UG, (const bf16_t*)(ws + W_S5MR), S5K, S5K, S5K}; pg8::S5OrderB S{F.G, (int)blockIdx.x}; pg8::EpiS5Z E{S5Z};
                            pg8::gemm_phase<pg8::EpiS5Z, pg8::S5OrderB, true, true>(F.lds, g, S, E, F.wave); __syncthreads(); }
}
{ constexpr int rep = 0;
                        if (EN_DIFF) diffattn_phase(F, half, layer, PROJ, MIXh, args.in[12] + layer * 256, args.in[13] + layer * 128);
}
                    }
                    END_PH();
                    if (IN_PH()) {
{ constexpr int rep = 0;
                        if (EN_MLSTM) mlstm_out_phase(F, PROJ, QKC, MSC, CST, NST, args.in[11] + layer * GWID, MIXh);
}
                        if (EN_S5) { __syncthreads();
                            pg8::Gemm g{S5Z, (const bf16_t*)(ws + W_GLU), GWID, GWID, GWID}; pg8::StaticOrder S; S.init(MH / 256, GWID / 256, F.G, (int)blockIdx.x);
                            pg8::EpiGlu E{S5Z, args.in[24] + layer * GWID, MIXh};
                            pg8::gemm_phase<pg8::EpiGlu, pg8::StaticOrder, true, true>(F.lds, g, S, E, F.wave); }
                    }
                    END_PH();
                    if (half == 1) {
                    if (IN_PH()) {
                        pg8::Gemm g{MIXh, (const bf16_t*)(ws + W_OUT), DM, DM, DM};
                        pg8::StaticOrder S; S.init(MH / 256, DM / 256, F.G, (int)blockIdx.x, 32);
                        pg8::EpiDelta E{HB + (size_t)MH * DM, DM, 1.0f};
                        pg8::gemm_phase<pg8::EpiDelta, pg8::StaticOrder, true, true>(F.lds, g, S, E, F.wave);
                    }
                    END_PH();
                    }
}
            }
}
{ constexpr int f = 1;
            if (f == 1) {
            if (IN_PH()) rms_phase(F, nullptr, nullptr, XH, (const bf16_t*)(ws + WS_SPARE), HB, args.in[26] + layer * DM, XN, XH);
            END_PH();
            }
            if (IN_PH()) {
{ constexpr int rep = 0;
                pg8::Gemm g{XN, (const bf16_t*)(ws + (f == 0 ? W_GU1 : W_GU2)), DM, DM, DM};
                pg8::StaticOrder S; S.init(MTOT / 256, 2 * DFF / 256, F.G, (int)blockIdx.x, 32);
                pg8::EpiSwiglu E{HB, DFF};
                pg8::gemm_phase<pg8::EpiSwiglu, pg8::StaticOrder, true, true>(F.lds, g, S, E, F.wave);
}
            }
            END_PH();
            if (IN_PH()) {
{ constexpr int rep = 0;
                pg8::Gemm g{HB, (const bf16_t*)(ws + (f == 0 ? W_D1 : W_D2)), DFF, DFF, DFF};
                pg8::StaticOrder S; S.init(MTOT / 256, DM / 256, F.G, (int)blockIdx.x, 4, 0);
                pg8::EpiDelta E{XN, DM, 0.5f};
                pg8::gemm_phase<pg8::EpiDelta, pg8::StaticOrder, true, true>(F.lds, g, S, E, F.wave);
}
            }
            END_PH();
            if (f == 0) {
                if (IN_PH()) { if (layer == 0) rms_phase(F, args.in[0], args.in[1], nullptr, XN, XN, args.in[6] + layer * DM, XN, XH);
                    else rms_phase(F, nullptr, nullptr, XH, XN, XN, args.in[6] + layer * DM, XN, XH); }
                END_PH();
{ constexpr int half = 0;
                    bf16_t* MIXh = XN + (size_t)half * MH * DM;
                    if (IN_PH()) {
{ constexpr int rep = 0;
                        pg8::Gemm g{XN + (size_t)half * MH * DM, (const bf16_t*)(ws + W_IN), DM, DM, DM};
                        pg8::StaticOrder S; S.init(MH / 256, IN_WP / 256, F.G, (int)blockIdx.x, 32);
                        pg8::EpiInProj E{PROJ, UG, GATES, args.in[10] + layer * 16, ROPE, half};
                        pg8::gemm_phase<pg8::EpiInProj, pg8::StaticOrder, true, true>(F.lds, g, S, E, F.wave);
}
                        if (half == 1) {
                            pg8::Gemm g0{XN, (const bf16_t*)(ws + W_OUT), DM, DM, DM};
                            pg8::StaticOrder S0; S0.init(MH / 256, DM / 256, F.G, (int)blockIdx.x, 32);
                            pg8::EpiDelta E0{(bf16_t*)(ws + WS_SPARE), DM, 1.0f};
                            pg8::gemm_phase<pg8::EpiDelta, pg8::StaticOrder, true, true>(F.lds, g0, S0, E0, F.wave);
                        }
                    }
                    END_PH();
                    if (IN_PH()) {
{ constexpr int rep = 0;
                        if (EN_MLSTM) { mlstm_conv_phase(F, half, PROJ, QKC, args.in[8] + layer * 5 * 1024, args.in[9] + layer * 1024); mlstm_scalar_phase(F, GATES, MSC); }
}
                        if (!EN_MLSTM) zero_mixed_cols(F, MIXh, 0);
                        if (!EN_DIFF) zero_mixed_cols(F, MIXh, 512);
                        if (!EN_NA) zero_mixed_cols(F, MIXh, 1024);
                        if (!EN_S5) zero_mixed_cols(F, MIXh, 1536);
                        if (EN_S5) { __syncthreads();
                            pg8::Gemm g{UG, (const bf16_t*)(ws + W_S5P), 512, S5K, 512}; pg8::S5OrderA S{F.G, (int)blockIdx.x}; pg8::EpiS5E E{S5E};
                            pg8::gemm_phase<pg8::EpiS5E, pg8::S5OrderA, true, true>(F.lds, g, S, E, F.wave); }
                    }
                    END_PH();
                    if (IN_PH()) {
{ constexpr int rep = 0;
                        if (EN_S5) s5_scan_phase(F, half, S5E, (const float*)(ws + W_LBL), UG);
}
{ constexpr int rep = 0;
                        if (EN_NA) { na_phase(F, half, PROJ, args.in[14] + (size_t)layer * 8 * 465, MIXh); __syncthreads(); }
}
{ constexpr int rep = 0;
                        if (EN_MLSTM) mlstm_state_phase(F, PROJ, QKC, MSC, CST, NST);
}
                    }
                    END_PH();
                    if (IN_PH()) {
                        if (EN_MLSTM) mlstm_scan_phase(F, half, MSC, CST, NST);
{ constexpr int rep = 0;
                        if (EN_S5) { pg8::Gemm g{UG, (const bf16_t*)(ws + W_S5MR), S5K, S5K, S5K}; pg8::S5OrderB S{F.G, (int)blockIdx.x}; pg8::EpiS5Z E{S5Z};
                            pg8::gemm_phase<pg8::EpiS5Z, pg8::S5OrderB, true, true>(F.lds, g, S, E, F.wave); __syncthreads(); }
}
{ constexpr int rep = 0;
                        if (EN_DIFF) diffattn_phase(F, half, layer, PROJ, MIXh, args.in[12] + layer * 256, args.in[13] + layer * 128);
}
                    }
                    END_PH();
                    if (IN_PH()) {
{ constexpr int rep = 0;
                        if (EN_MLSTM) mlstm_out_phase(F, PROJ, QKC, MSC, CST, NST, args.in[11] + layer * GWID, MIXh);
}
                        if (EN_S5) { __syncthreads();
                            pg8::Gemm g{S5Z, (const bf16_t*)(ws + W_GLU), GWID, GWID, GWID}; pg8::StaticOrder S; S.init(MH / 256, GWID / 256, F.G, (int)blockIdx.x);
                            pg8::EpiGlu E{S5Z, args.in[24] + layer * GWID, MIXh};
                            pg8::gemm_phase<pg8::EpiGlu, pg8::StaticOrder, true, true>(F.lds, g, S, E, F.wave); }
                    }
                    END_PH();
                    if (half == 1) {
                    if (IN_PH()) {
                        pg8::Gemm g{MIXh, (const bf16_t*)(ws + W_OUT), DM, DM, DM};
                        pg8::StaticOrder S; S.init(MH / 256, DM / 256, F.G, (int)blockIdx.x, 32);
                        pg8::EpiDelta E{HB + (size_t)MH * DM, DM, 1.0f};
                        pg8::gemm_phase<pg8::EpiDelta, pg8::StaticOrder, true, true>(F.lds, g, S, E, F.wave);
                    }
                    END_PH();
                    }
}
{ constexpr int half = 1;
                    bf16_t* MIXh = XN + (size_t)half * MH * DM;
                    if (IN_PH()) {
{ constexpr int rep = 0;
                        pg8::Gemm g{XN + (size_t)half * MH * DM, (const bf16_t*)(ws + W_IN), DM, DM, DM};
                        pg8::StaticOrder S; S.init(MH / 256, IN_WP / 256, F.G, (int)blockIdx.x, 32);
                        pg8::EpiInProj E{PROJ, UG, GATES, args.in[10] + layer * 16, ROPE, half};
                        pg8::gemm_phase<pg8::EpiInProj, pg8::StaticOrder, true, true>(F.lds, g, S, E, F.wave);
}
                        if (half == 1) {
                            pg8::Gemm g0{XN, (const bf16_t*)(ws + W_OUT), DM, DM, DM};
                            pg8::StaticOrder S0; S0.init(MH / 256, DM / 256, F.G, (int)blockIdx.x, 32);
                            pg8::EpiDelta E0{(bf16_t*)(ws + WS_SPARE), DM, 1.0f};
                            pg8::gemm_phase<pg8::EpiDelta, pg8::StaticOrder, true, true>(F.lds, g0, S0, E0, F.wave);
                        }
                    }
                    END_PH();
                    if (IN_PH()) {
{ constexpr int rep = 0;
                        if (EN_MLSTM) { mlstm_conv_phase(F, half, PROJ, QKC, args.in[8] + layer * 5 * 1024, args.in[9] + layer * 1024); mlstm_scalar_phase(F, GATES, MSC); }
}
                        if (!EN_MLSTM) zero_mixed_cols(F, MIXh, 0);
                        if (!EN_DIFF) zero_mixed_cols(F, MIXh, 512);
                        if (!EN_NA) zero_mixed_cols(F, MIXh, 1024);
                        if (!EN_S5) zero_mixed_cols(F, MIXh, 1536);
                        if (EN_S5) { __syncthreads();
                            pg8::Gemm g{UG, (const bf16_t*)(ws + W_S5P), 512, S5K, 512}; pg8::S5OrderA S{F.G, (int)blockIdx.x}; pg8::EpiS5E E{S5E};
                            pg8::gemm_phase<pg8::EpiS5E, pg8::S5OrderA, true, true>(F.lds, g, S, E, F.wave); }
                    }
                    END_PH();
                    if (IN_PH()) {
{ constexpr int rep = 0;
                        if (EN_S5) s5_scan_phase(F, half, S5E, (const float*)(ws + W_LBL), UG);
}
{ constexpr int rep = 0;
                        if (EN_NA) { na_phase(F, half, PROJ, args.in[14] + (size_t)layer * 8 * 465, MIXh); __syncthreads(); }
}
{ constexpr int rep = 0;
                        if (EN_MLSTM) mlstm_state_phase(F, PROJ, QKC, MSC, CST, NST);
}
                    }
                    END_PH();
                    if (IN_PH()) {
                        if (EN_MLSTM) mlstm_scan_phase(F, half, MSC, CST, NST);
{ constexpr int rep = 0;
                        if (EN_S5) { pg8::Gemm g{UG, (const bf16_t*)(ws + W_S5MR), S5K, S5K, S5K}; pg8::S5OrderB S{F.G, (int)blockIdx.x}; pg8::EpiS5Z E{S5Z};
                            pg8::gemm_phase<pg8::EpiS5Z, pg8::S5OrderB, true, true>(F.lds, g, S, E, F.wave); __syncthreads(); }
}
{ constexpr int rep = 0;
                        if (EN_DIFF) diffattn_phase(F, half, layer, PROJ, MIXh, args.in[12] + layer * 256, args.in[13] + layer * 128);
}
                    }
                    END_PH();
                    if (IN_PH()) {
{ constexpr int rep = 0;
                        if (EN_MLSTM) mlstm_out_phase(F, PROJ, QKC, MSC, CST, NST, args.in[11] + layer * GWID, MIXh);
}
                        if (EN_S5) { __syncthreads();
                            pg8::Gemm g{S5Z, (const bf16_t*)(ws + W_GLU), GWID, GWID, GWID}; pg8::StaticOrder S; S.init(MH / 256, GWID / 256, F.G, (int)blockIdx.x);
                            pg8::EpiGlu E{S5Z, args.in[24] + layer * GWID, MIXh};
                            pg8::gemm_phase<pg8::EpiGlu, pg8::StaticOrder, true, true>(F.lds, g, S, E, F.wave); }
                    }
                    END_PH();
                    if (half == 1) {
                    if (IN_PH()) {
                        pg8::Gemm g{MIXh, (const bf16_t*)(ws + W_OUT), DM, DM, DM};
                        pg8::StaticOrder S; S.init(MH / 256, DM / 256, F.G, (int)blockIdx.x, 32);
                        pg8::EpiDelta E{HB + (size_t)MH * DM, DM, 1.0f};
                        pg8::gemm_phase<pg8::EpiDelta, pg8::StaticOrder, true, true>(F.lds, g, S, E, F.wave);
                    }
                    END_PH();
                    }
}
            }
}
}
    if (IN_PH()) {
        constexpr int FT = 3072, A_END = MH - FT;
        _Float16* XT = (_Float16*)(ws + WS_SPARE);
        { const long gt = (long)F.vcu * (NWAVES * 64) + opaque_tid(F.wave), NT = (long)F.G * NWAVES * 64;
          for (long i = gt; i < (long)FT * DM / 8; i += NT) *(u32x4*)(XT + i * 8) = *(const u32x4*)(XH + (size_t)(MTOT - FT) * DM + i * 8); }
        final_norm_rows(F, X, XH, XN, args.in[30], 0, MH, 0);
        for (int a0 = 0; a0 < A_END; ) {
            xcd_barrier(bar, F.wave);
            const int a1 = (a0 + MH) / 2;
            final_norm_rows(F, X, XH, XN, args.in[30], MH + a0, MH + a1, 0);
            a0 = a1;
        }
        xcd_barrier(bar, F.wave);
        final_norm_rows(F, X, XT, XN, args.in[30], MTOT - FT, MTOT, MTOT - FT);
        if (xb_ld(ctl + CW_BAR + XB_TMO) != 0u) {
            const int gw = F.vcu * NWAVES + F.wave, NGW = F.G * NWAVES, ln = opaque_tid(F.wave) & 63; const float q = __builtin_nanf("");
            for (int m = gw; m < MTOT; m += NGW) X[(size_t)m * DM + ln] = q;
        }
    }
    ++ph;
#undef IN_PH
#undef END_PH
}

extern "C" void kernel_launch(void* const* d_in, const int* in_sizes, int n_in, void* d_out, int out_size, void* d_ws, size_t ws_size, hipStream_t stream) {
    static int grid = 0;
    if (grid == 0) {
        if (n_in != 31 || out_size != MTOT * DM || ws_size < WS_END) { fprintf(stderr, "kernel_launch: shape mismatch: n_in %d out %d ws %zu (need %zu)\n", n_in, out_size, ws_size, (size_t)WS_END); grid = -1; return; }
        int dev = 0, cus = 0, per_cu = 0;
        if (hipGetDevice(&dev) != hipSuccess || hipDeviceGetAttribute(&cus, hipDeviceAttributeMultiprocessorCount, dev) != hipSuccess) { grid = -1; return; }
        if (hipFuncSetAttribute((const void*)mk_fwd, hipFuncAttributeMaxDynamicSharedMemorySize, LDS_BYTES) != hipSuccess) { fprintf(stderr, "kernel_launch: hipFuncSetAttribute failed\n"); grid = -1; return; }
        if (hipOccupancyMaxActiveBlocksPerMultiprocessor(&per_cu, (const void*)mk_fwd, NWAVES * 64, LDS_BYTES) != hipSuccess || per_cu < 1) { fprintf(stderr, "kernel_launch: occupancy query says %d\n", per_cu); (void)hipGetLastError(); grid = -1; return; }
        grid = cus;
    }
    if (grid < 0) return;
    (void)hipMemsetAsync((char*)d_ws + WS_CTL, 0, CTL_ZERO_BYTES, stream);
    Args a{};
    for (int i = 0; i < 31; ++i) a.in[i] = (const float*)d_in[i];
    a.out = (float*)d_out; a.ws = (unsigned char*)d_ws; a.ph_lo = 0; a.ph_hi = 1 << 30;
    hipLaunchKernelGGL(mk_fwd, dim3(grid), dim3(NWAVES * 64), LDS_BYTES, stream, a);
    const hipError_t le = hipPeekAtLastError();
    if (le != hipSuccess) fprintf(stderr, "kernel_launch: launch failed: %s\n", hipGetErrorName(le));
}
```

```cpp
#include <hip/hip_runtime.h>
#include <cstdio>
#include <cstdint>

#define GAS __attribute__((address_space(1)))
#define LAS __attribute__((address_space(3)))
typedef unsigned short bf16_t;
typedef short bf16x8 __attribute__((ext_vector_type(8)));
typedef float f32x4 __attribute__((ext_vector_type(4)));
typedef float f32x2 __attribute__((ext_vector_type(2)));
typedef float f32x16 __attribute__((ext_vector_type(16)));
typedef unsigned u32x4 __attribute__((ext_vector_type(4)));
typedef unsigned u32x2 __attribute__((ext_vector_type(2)));

constexpr int DM = 2048, DFF = 5632, DEPTH = 2, GWID = 512;
constexpr int T_P = 8192, B_P = 2, T_S = 4096, B_S = 8;
constexpr int M_P = B_P * T_P, M_S = B_S * T_S, MTOT = M_P + M_S;
constexpr float NORM_EPS = 1e-6f;
constexpr int NWAVES = 8;

constexpr size_t MiB = 1u << 20;
constexpr size_t WS_CTL = 0, CTL_ZERO_BYTES = 32 * 1024;
constexpr size_t WS_ROPE = 1 * MiB;
constexpr size_t WS_W = 4 * MiB;
constexpr size_t W_GU1 = WS_W, W_D1 = W_GU1 + 44 * MiB, W_GU2 = W_D1 + 22 * MiB, W_D2 = W_GU2 + 44 * MiB;
constexpr size_t W_IN = W_D2 + 22 * MiB, W_OUT = W_IN + 23 * MiB, W_GLU = W_OUT + 8 * MiB, W_S5MR = W_GLU + 1 * MiB, W_S5P = W_S5MR + 24 * MiB, W_END = W_S5P + 8 * MiB;
constexpr size_t WS_XN = 200 * MiB;
constexpr size_t WS_BIG = 392 * MiB;
constexpr size_t WS_SPARE = 920 * MiB;
constexpr size_t WS_END = 1016 * MiB;
static_assert(W_END <= WS_XN, "weights fit");
constexpr int CW_BAR = 4096;
static_assert((CW_BAR + 3456) * 4 <= (int)CTL_ZERO_BYTES, "barrier words inside the per-call memset");

constexpr int RING_BYTES = 131072;
constexpr int LDSCTL_OFF = RING_BYTES, MISC_OFF = LDSCTL_OFF + 320;
constexpr int LDS_BYTES = 147456;

#define RLX_AGENT __ATOMIC_RELAXED, __HIP_MEMORY_SCOPE_AGENT
#define LDS_WAIT() asm volatile("s_waitcnt lgkmcnt(0)" ::: "memory")
#define VM_WAIT() asm volatile("s_waitcnt vmcnt(0)" ::: "memory")
__device__ __forceinline__ unsigned f2bf(float f) { unsigned u = __builtin_bit_cast(unsigned, f); return (u + 0x7fffu + ((u >> 16) & 1u)) >> 16; }
__device__ __forceinline__ unsigned pk2(float lo, float hi) { return f2bf(lo) | (f2bf(hi) << 16); }
__device__ __forceinline__ float bf2f(unsigned short b) { return __builtin_bit_cast(float, (unsigned)b << 16); }
__device__ __forceinline__ unsigned cvt_pk_bf16(float lo, float hi) { unsigned r; asm volatile("v_cvt_pk_bf16_f32 %0, %1, %2" : "=v"(r) : "v"(lo), "v"(hi)); return r; }
__device__ __forceinline__ float wave_sum(float v) {
#pragma unroll
    for (int o = 1; o < 64; o <<= 1) v += __shfl_xor(v, o);
    return v;
}
__device__ __forceinline__ int opaque_tid(int wave) { int l_; asm volatile("v_mbcnt_lo_u32_b32 %0, -1, 0\n\tv_mbcnt_hi_u32_b32 %0, -1, %0" : "=v"(l_)); return wave * 64 + l_; }
__device__ __forceinline__ float fast_silu(float g) { return g * __builtin_amdgcn_rcpf(1.f + __expf(-g)); }

namespace pg8 {
constexpr int BM = 256, BK = 64, HALF = 128, HTB = HALF * BK * 2, STAGE_BYTES = 8 * HTB, NXCD = 8, WGM = 8;
__host__ __device__ __forceinline__ int lds_byte(int r, int c) { const int st = (r >> 4) * 2 + (c >> 5), rr = r & 15, cc = c & 31, ob = rr * 64 + cc * 2; return st * 1024 + (ob ^ (((ob >> 9) & 1) << 5)); }
__host__ __device__ __forceinline__ void stage_rc(int b, int& R, int& C) { const int st = b / 1024, sb = b % 1024, swz = sb ^ (((sb >> 9) & 1) << 5); R = (st >> 1) * 16 + swz / 64; C = (st & 1) * 32 + (swz % 64) / 2; }
__host__ __device__ __forceinline__ int perm32(int rho) { const int n = rho >> 4, i = rho & 15; return 8 * (i >> 2) + 4 * n + (i & 3); }

struct Unit { int pm, pn; };
struct Gemm { const bf16_t* A; const bf16_t* Bt; int K, lda, ldb; };

struct StaticOrder {
    int nM, nN, nwg, G, c, wgm, rev;
    __host__ __device__ void init(int nM_, int nN_, int G_, int c_, int wgm_ = WGM, int rev_ = 0) { nM = nM_; nN = nN_; nwg = nM * nN; G = G_; c = c_; wgm = wgm_; rev = rev_; }
    __host__ __device__ bool next(int i, Unit& u) const {
        const long L = (long)i * G + c; if (L >= nwg) return false;
        int wgid = rev ? nwg - 1 - (int)L : (int)L;
        const int nig = wgm * nN, gid = wgid / nig, fm = gid * wgm, gsz = (nM - fm) < wgm ? (nM - fm) : wgm;
        u.pm = fm + ((wgid % nig) % gsz); u.pn = (wgid % nig) / gsz; return true;
    }
    __device__ __forceinline__ void a_ready(const Unit&) const {}
    __device__ __forceinline__ void done(const Unit&) const {}
};

template <class Epi, class Sched, bool ALIGN_EPI = false, bool SP2 = false>
__device__ __forceinline__ void gemm_phase(LAS unsigned char* lds, const Gemm g, const Sched& S, const Epi& E, const int wave0) {
    const int tid = opaque_tid(wave0), wid = wave0, lane = tid & 63, wr = wid >> 2, wc = wid & 3, fr = lane & 15, fq = lane >> 4;
    const int K = g.K, nt = K / BK;
    unsigned voffA[2], voffB[2];
#pragma unroll
    for (int i = 0; i < 2; ++i) { int R, C; stage_rc(tid * 16 + i * 8192, R, C); const int Rb = Epi::PERM ? ((R & ~31) + perm32(R & 31)) : R;
        voffA[i] = (unsigned)(R * g.lda + C) * 2u; voffB[i] = (unsigned)(Rb * g.ldb + C) * 2u; }
    const size_t kstep = (size_t)(BK * 2);
    const size_t hstepA = (size_t)HALF * g.lda * 2, hstepB = (size_t)HALF * g.ldb * 2;
    const size_t tstepA = 2 * hstepA, tstepB = 2 * hstepB;
    const unsigned ldsw = (unsigned)wid * 1024u;
    const int aoff = lds_byte(wr * 64 + fr, fq * 8), boff = lds_byte(wc * 32 + fr, fq * 8);
#define PG8_SA(b, h) (((b) * 2 + (h)) * HTB)
#define PG8_SB(b, h) ((4 + (b) * 2 + (h)) * HTB)
#define PG8_STAGE(bufoff, gbase, voff) do { _Pragma("unroll") for (int _i = 0; _i < 2; ++_i) \
        __builtin_amdgcn_global_load_lds((const unsigned*)((const char*)(gbase) + (voff)[_i]), (LAS unsigned*)(lds + (bufoff) + ldsw + _i * 8192), 16, 0, 0); } while (0)
#define PG8_LDA(dst, b, h) do { _Pragma("unroll") for (int m = 0; m < 4; ++m) _Pragma("unroll") for (int k = 0; k < 2; ++k) dst[m][k] = *(const LAS bf16x8*)(lds + PG8_SA(b, h) + aoff + m * 2048 + k * 1024); } while (0)
#define PG8_LDB(dst, b, h) do { _Pragma("unroll") for (int n = 0; n < 2; ++n) _Pragma("unroll") for (int k = 0; k < 2; ++k) dst[n][k] = *(const LAS bf16x8*)(lds + PG8_SB(b, h) + boff + n * 2048 + k * 1024); } while (0)
#define PG8_MMA(ai, bj, At, Bt) do { __builtin_amdgcn_s_setprio(1); _Pragma("unroll") for (int m = 0; m < 4; ++m) _Pragma("unroll") for (int n = 0; n < 2; ++n) _Pragma("unroll") for (int k = 0; k < 2; ++k) \
        acc[ai][bj][m][n] = __builtin_amdgcn_mfma_f32_16x16x32_bf16(Bt[n][k], At[m][k], acc[ai][bj][m][n], 0, 0, 0); __builtin_amdgcn_s_setprio(0); } while (0)
#define PG8_WAIT_V(n) asm volatile("s_waitcnt vmcnt(" #n ")" ::: "memory")
#define PG8_WAIT_L(n) asm volatile("s_waitcnt lgkmcnt(" #n ")" ::: "memory")
#define PG8_BAR __builtin_amdgcn_s_barrier()
#define PG8_SCHED __builtin_amdgcn_sched_barrier(0)
    Unit cur, nxt; int ui = 0;
    if (!S.next(0, cur)) return;
    f32x4 acc[2][2][4][2];
#pragma unroll
    for (int a = 0; a < 2; ++a)
#pragma unroll
        for (int b = 0; b < 2; ++b)
#pragma unroll
            for (int m = 0; m < 4; ++m)
#pragma unroll
                for (int n = 0; n < 2; ++n) acc[a][b][m][n] = (f32x4){0.f, 0.f, 0.f, 0.f};
    bf16x8 At[4][2], B0[2][2], B1[2][2];
    const char* cA = (const char*)g.A + (size_t)cur.pm * tstepA; const char* cB = (const char*)g.Bt + (size_t)cur.pn * tstepB;
    S.a_ready(cur);
    if constexpr (SP2) {
        PG8_STAGE(PG8_SB(0, 0), cB, voffB); PG8_STAGE(PG8_SB(0, 1), cB + hstepB, voffB); PG8_STAGE(PG8_SA(0, 0), cA, voffA); PG8_STAGE(PG8_SA(0, 1), cA + hstepA, voffA);
        if (wr == 1) PG8_BAR;
        PG8_WAIT_V(2); PG8_BAR;
        PG8_STAGE(PG8_SB(1, 0), cB + kstep, voffB); PG8_STAGE(PG8_SA(1, 0), cA + kstep, voffA); PG8_STAGE(PG8_SB(1, 1), cB + hstepB + kstep, voffB);
        PG8_WAIT_V(6); PG8_BAR;
    } else {
        PG8_STAGE(PG8_SB(0, 0), cB, voffB); PG8_STAGE(PG8_SA(0, 0), cA, voffA); PG8_STAGE(PG8_SB(0, 1), cB + hstepB, voffB); PG8_STAGE(PG8_SA(0, 1), cA + hstepA, voffA);
        if (wr == 1) PG8_BAR;
        PG8_WAIT_V(4); PG8_BAR;
        PG8_STAGE(PG8_SB(1, 0), cB + kstep, voffB); PG8_STAGE(PG8_SA(1, 0), cA + kstep, voffA); PG8_STAGE(PG8_SB(1, 1), cB + hstepB + kstep, voffB);
        PG8_WAIT_V(6); PG8_BAR;
    }
    for (;;) {
        const bool has_next = S.next(ui + 1, nxt);
        const char* nA = has_next ? (const char*)g.A + (size_t)nxt.pm * tstepA : cA; const char* nB = has_next ? (const char*)g.Bt + (size_t)nxt.pn * tstepB : cB;
        for (int t = 0; t < nt; t += 2) {
            const bool last = (t == nt - 2);
            const char* a1 = cA + (size_t)(t + 1) * kstep;
            const char* a2 = last ? nA : cA + (size_t)(t + 2) * kstep; const char* b2 = last ? nB : cB + (size_t)(t + 2) * kstep;
            const char* a3 = a2 + kstep; const char* b3 = b2 + kstep;
            if (last && has_next) S.a_ready(nxt);
            if constexpr (SP2) {
            PG8_LDB(B0, 0, 0); PG8_LDB(B1, 0, 1); PG8_SCHED; PG8_LDA(At, 0, 0); PG8_STAGE(PG8_SA(1, 1), a1 + hstepA, voffA);
            PG8_WAIT_V(8); PG8_WAIT_L(0); PG8_BAR; PG8_MMA(0, 0, At, B0); PG8_MMA(0, 1, At, B1); PG8_BAR; PG8_SCHED;
            PG8_LDA(At, 0, 1); PG8_STAGE(PG8_SB(0, 0), b2, voffB); PG8_STAGE(PG8_SB(0, 1), b2 + hstepB, voffB); PG8_STAGE(PG8_SA(0, 0), a2, voffA);
            PG8_WAIT_V(8); PG8_WAIT_L(0); PG8_BAR; PG8_MMA(1, 0, At, B0); PG8_MMA(1, 1, At, B1); PG8_BAR; PG8_SCHED;
            PG8_LDB(B0, 1, 0); PG8_LDB(B1, 1, 1); PG8_SCHED; PG8_LDA(At, 1, 0); PG8_STAGE(PG8_SA(0, 1), a2 + hstepA, voffA);
            PG8_WAIT_V(8); PG8_WAIT_L(0); PG8_BAR; PG8_MMA(0, 0, At, B0); PG8_MMA(0, 1, At, B1); PG8_BAR; PG8_SCHED;
            PG8_LDA(At, 1, 1); PG8_STAGE(PG8_SB(1, 0), b3, voffB); PG8_STAGE(PG8_SB(1, 1), b3 + hstepB, voffB); PG8_STAGE(PG8_SA(1, 0), a3, voffA);
            PG8_WAIT_V(8); PG8_WAIT_L(0); PG8_BAR; PG8_MMA(1, 0, At, B0); PG8_MMA(1, 1, At, B1); PG8_BAR; PG8_SCHED;
            } else {
            PG8_LDB(B0, 0, 0); PG8_SCHED; PG8_LDA(At, 0, 0); PG8_STAGE(PG8_SA(1, 1), a1 + hstepA, voffA);
            PG8_WAIT_L(8); PG8_BAR; PG8_WAIT_L(0); PG8_MMA(0, 0, At, B0); PG8_BAR; PG8_SCHED;
            PG8_LDB(B1, 0, 1); PG8_STAGE(PG8_SB(0, 0), b2, voffB);
            PG8_BAR; PG8_WAIT_L(0); PG8_MMA(0, 1, At, B1); PG8_BAR;
            PG8_LDA(At, 0, 1); PG8_STAGE(PG8_SA(0, 0), a2, voffA);
            PG8_BAR; PG8_WAIT_L(0); PG8_MMA(1, 0, At, B0); PG8_BAR; PG8_SCHED;
            PG8_STAGE(PG8_SB(0, 1), b2 + hstepB, voffB);
            PG8_WAIT_V(6); PG8_BAR; PG8_MMA(1, 1, At, B1); PG8_BAR;
            PG8_LDB(B0, 1, 0); PG8_SCHED; PG8_LDA(At, 1, 0); PG8_STAGE(PG8_SA(0, 1), a2 + hstepA, voffA);
            PG8_WAIT_L(8); PG8_BAR; PG8_WAIT_L(0); PG8_MMA(0, 0, At, B0); PG8_BAR; PG8_SCHED;
            PG8_LDB(B1, 1, 1); PG8_STAGE(PG8_SB(1, 0), b3, voffB);
            PG8_BAR; PG8_WAIT_L(0); PG8_MMA(0, 1, At, B1); PG8_BAR;
            PG8_LDA(At, 1, 1); PG8_STAGE(PG8_SA(1, 0), a3, voffA);
            PG8_BAR; PG8_WAIT_L(0); PG8_MMA(1, 0, At, B0); PG8_BAR; PG8_SCHED;
            PG8_STAGE(PG8_SB(1, 1), b3 + hstepB, voffB);
            PG8_WAIT_V(6); PG8_BAR; PG8_MMA(1, 1, At, B1); PG8_BAR;
            }
        }
        if constexpr (ALIGN_EPI) { if (wr == 0) PG8_BAR; }
        E(acc, cur, wr, wc, fr, fq); S.done(cur);
        if (!has_next) break;
#pragma unroll
        for (int a = 0; a < 2; ++a)
#pragma unroll
            for (int b = 0; b < 2; ++b)
#pragma unroll
                for (int m = 0; m < 4; ++m)
#pragma unroll
                    for (int n = 0; n < 2; ++n) acc[a][b][m][n] = (f32x4){0.f, 0.f, 0.f, 0.f};
        cur = nxt; cA = nA; cB = nB; ++ui;
        if constexpr (ALIGN_EPI) { if (wr == 1) PG8_BAR; }
    }
    PG8_WAIT_V(0);
    if constexpr (!ALIGN_EPI) { if (wr == 0) PG8_BAR; }
    PG8_BAR;
#undef PG8_SA
#undef PG8_SB
#undef PG8_STAGE
#undef PG8_LDA
#undef PG8_LDB
#undef PG8_MMA
#undef PG8_WAIT_V
#undef PG8_WAIT_L
#undef PG8_BAR
#undef PG8_SCHED
}

struct EpiSwiglu {
    static constexpr bool PERM = true;
    bf16_t* H; int ldh;
    __device__ __forceinline__ void operator()(const f32x4 (&acc)[2][2][4][2], const Unit& u, int wr, int wc, int fr, int fq) const {
        const int row0 = u.pm * BM + wr * 64 + fr, col0 = u.pn * HALF + wc * 32 + 8 * fq;
#pragma unroll
        for (int ai = 0; ai < 2; ++ai)
#pragma unroll
            for (int m = 0; m < 4; ++m) {
                bf16_t* rowp = H + (size_t)(row0 + ai * HALF + m * 16) * ldh + col0;
                const f32x4 g0 = acc[ai][0][m][0], g1 = acc[ai][0][m][1], u0 = acc[ai][1][m][0], u1 = acc[ai][1][m][1];
                u32x4 w;
                w.x = cvt_pk_bf16(fast_silu(g0[0]) * u0[0], fast_silu(g0[1]) * u0[1]); w.y = cvt_pk_bf16(fast_silu(g0[2]) * u0[2], fast_silu(g0[3]) * u0[3]);
                w.z = cvt_pk_bf16(fast_silu(g1[0]) * u1[0], fast_silu(g1[1]) * u1[1]); w.w = cvt_pk_bf16(fast_silu(g1[2]) * u1[2], fast_silu(g1[3]) * u1[3]);
                *(u32x4*)rowp = w;
            }
    }
};
struct EpiDelta {
    static constexpr bool PERM = true;
    bf16_t* D; int ldd; float s;
    __device__ __forceinline__ void operator()(const f32x4 (&acc)[2][2][4][2], const Unit& u, int wr, int wc, int fr, int fq) const {
        const int row0 = u.pm * BM + wr * 64 + fr, col0 = u.pn * BM + wc * 32 + 8 * fq;
#pragma unroll
        for (int ai = 0; ai < 2; ++ai)
#pragma unroll
            for (int m = 0; m < 4; ++m) { bf16_t* rowp = D + (size_t)(row0 + ai * HALF + m * 16) * ldd + col0;
#pragma unroll
                for (int bj = 0; bj < 2; ++bj) { const f32x4 v0 = acc[ai][bj][m][0] * s, v1 = acc[ai][bj][m][1] * s;
                    u32x4 w; w.x = cvt_pk_bf16(v0[0], v0[1]); w.y = cvt_pk_bf16(v0[2], v0[3]); w.z = cvt_pk_bf16(v1[0], v1[1]); w.w = cvt_pk_bf16(v1[2], v1[3]);
                    *(u32x4*)(rowp + bj * HALF) = w; } }
    }
};
struct EpiResid {
    static constexpr bool PERM = true;
    float* X; int ldx; float s;
    __device__ __forceinline__ void operator()(const f32x4 (&acc)[2][2][4][2], const Unit& u, int wr, int wc, int fr, int fq) const {
        const int row0 = u.pm * BM + wr * 64 + fr, col0 = u.pn * BM + wc * 32 + 8 * fq;
#pragma unroll
        for (int ai = 0; ai < 2; ++ai)
#pragma unroll
            for (int m = 0; m < 4; ++m) {
                float* rowp = X + (size_t)(row0 + ai * HALF + m * 16) * ldx + col0;
#pragma unroll
                for (int bj = 0; bj < 2; ++bj) {
                    f32x4 a = *(const f32x4*)(rowp + bj * HALF), b = *(const f32x4*)(rowp + bj * HALF + 4);
                    a = a + acc[ai][bj][m][0] * s; b = b + acc[ai][bj][m][1] * s;
                    *(f32x4*)(rowp + bj * HALF) = a; *(f32x4*)(rowp + bj * HALF + 4) = b;
                }
            }
    }
};
}

#define XB_TMO      128
#define XB_XCNT(j)  (256  + 64 * (j))
#define XB_XSUB(j)  (1280 + 64 * (j))
#define XB_XGEN(j)  (2304 + 64 * (j))
#define XB_TOP      3328
#define XB_TOPGEN   3392
#define XCD_BAR_WORDS 3456
#define XB_SPIN_CAP (1u << 18)
__device__ __forceinline__ unsigned xb_ld(unsigned* p)              { return __hip_atomic_load(p, __ATOMIC_RELAXED, __HIP_MEMORY_SCOPE_AGENT); }
__device__ __forceinline__ unsigned xb_add(unsigned* p, unsigned v) { return __hip_atomic_fetch_add(p, v, __ATOMIC_RELAXED, __HIP_MEMORY_SCOPE_AGENT); }
__device__ __forceinline__ unsigned xb_xcc_id() { return (unsigned)__builtin_amdgcn_s_getreg((3 << 11) | 20) & 0xFu; }
#define XB_SPIN(cond, bar) do { unsigned _sp = 0; while (cond) { __builtin_amdgcn_s_sleep(1); \
    if ((++_sp & 255u) == 0u) { if (xb_ld(&(bar)[XB_TMO])) break; if (_sp > XB_SPIN_CAP) { atomicAdd(&(bar)[XB_TMO], 1u); break; } } } } while (0)
struct XcdBarrier { unsigned* bar; unsigned x; volatile LAS unsigned* st; };
__device__ __forceinline__ XcdBarrier xcd_barrier_post(unsigned* bar, volatile LAS unsigned* st) {
    XcdBarrier b; b.bar = bar; b.x = xb_xcc_id(); b.st = st;
    if (threadIdx.x == 0) (void)xb_add(&bar[XB_XCNT(b.x)], 1u);
    return b;
}
__device__ __forceinline__ void xcd_barrier_complete(unsigned* bar, unsigned x, unsigned& nloc, unsigned& nx) {
    const unsigned G = gridDim.x * gridDim.y * gridDim.z;
    unsigned sum, cnt, mine, sp = 0u;
    for (;;) {
        sum = 0u; cnt = 0u; mine = 0u;
#pragma unroll
        for (unsigned j = 0; j < 16; ++j) { const unsigned c = xb_ld(&bar[XB_XCNT(j)]); sum += c; cnt += (c > 0u) ? 1u : 0u; mine = (j == x) ? c : mine; }
        if (sum == G) break;
        __builtin_amdgcn_s_sleep(1);
        if ((++sp & 255u) == 0u) { if (xb_ld(&bar[XB_TMO])) break; if (sp > XB_SPIN_CAP) { atomicAdd(&bar[XB_TMO], 1u); break; } }
    }
    nloc = mine > 0u ? mine : 1u; nx = cnt > 0u ? cnt : 1u;
}
__device__ __forceinline__ void xcd_barrier(const XcdBarrier& b, const int wave) {
    asm volatile("s_waitcnt vmcnt(0)" ::: "memory");
    __syncthreads();
    if (opaque_tid(wave) == 0) {
        unsigned* bar = b.bar;
        __builtin_amdgcn_s_waitcnt(0);
        unsigned nloc = b.st[0], nx = b.st[1];
        if (nloc == 0u) { xcd_barrier_complete(bar, b.x, nloc, nx); b.st[0] = nloc; b.st[1] = nx; }
        const unsigned old = xb_add(&bar[XB_XSUB(b.x)], 1u);
        const unsigned gen = old / nloc;
        if (old + 1u == (gen + 1u) * nloc) {
            __builtin_amdgcn_fence(__ATOMIC_RELEASE, "agent");
            asm volatile("s_waitcnt vmcnt(0)" ::: "memory");
            const unsigned og = xb_add(&bar[XB_TOP], 1u);
            const unsigned tg = og / nx;
            if (og + 1u == (tg + 1u) * nx) xb_add(&bar[XB_TOPGEN], 1u);
            else XB_SPIN(xb_ld(&bar[XB_TOPGEN]) == tg, bar);
            __builtin_amdgcn_fence(__ATOMIC_ACQUIRE, "agent");
            xb_add(&bar[XB_XGEN(b.x)], 1u);
            asm volatile("s_waitcnt vmcnt(0)" ::: "memory");
        } else {
            XB_SPIN(xb_ld(&bar[XB_XGEN(b.x)]) == gen, bar);
            __builtin_amdgcn_fence(__ATOMIC_ACQUIRE, "agent");
            asm volatile("s_waitcnt vmcnt(0)" ::: "memory");
        }
    }
    __syncthreads();
}

struct Frame {
    LAS unsigned char* lds;
    volatile LAS unsigned* MISC;
    int tid, lane, wave, vcu, G;
};
#define PHASE_FRAME(F0) Frame F = (F0); { const int t_ = opaque_tid(F.wave); F.tid = t_; F.lane = t_ & 63; }

__device__ __forceinline__ void tr_item(const float* W, int ldw, bf16_t* WT, int ldt, int k0, int s0, int d0, int nvalid, LAS float* scr, int lane, bool perm = false) {
    if (!perm && nvalid == 32) {
        const int r8 = lane >> 3, n4 = (lane & 7) * 4;
        f32x4 v[8];
#pragma unroll
        for (int i = 0; i < 8; ++i) v[i] = *(const f32x4*)(W + (size_t)(k0 + 8 * i + r8) * ldw + s0 + n4);
#pragma unroll
        for (int i = 0; i < 8; ++i) { LAS float* p = scr + (8 * i + r8) * 33 + n4; p[0] = v[i].x; p[1] = v[i].y; p[2] = v[i].z; p[3] = v[i].w; }
    } else {
        const int c32 = lane & 31, sc = perm ? s0 + (c32 >> 1) + 32 * (c32 & 1) : s0 + c32;
#pragma unroll 8
        for (int i = 0; i < 32; ++i) { const int kk = 2 * i + (lane >> 5); scr[kk * 33 + c32] = (c32 < nvalid) ? W[(size_t)(k0 + kk) * ldw + sc] : 0.f; }
    }
    LDS_WAIT(); asm volatile("" ::: "memory");
    const int c = lane & 7;
#pragma unroll
    for (int j = 0; j < 4; ++j) { const int n = (lane >> 3) + 8 * j; const LAS float* s = scr + (8 * c) * 33 + n;
        u32x4 o; o.x = pk2(s[0 * 33], s[1 * 33]); o.y = pk2(s[2 * 33], s[3 * 33]); o.z = pk2(s[4 * 33], s[5 * 33]); o.w = pk2(s[6 * 33], s[7 * 33]);
        *(u32x4*)(WT + (size_t)(d0 + n) * ldt + k0 + 8 * c) = o; }
    LDS_WAIT(); asm volatile("" ::: "memory");
}

typedef _Float16 f16x4 __attribute__((ext_vector_type(4)));
__device__ __forceinline__ void rms_phase(const Frame& F0, const float* srcP, const float* srcS, const _Float16* srcH, const bf16_t* deltaLo, const bf16_t* deltaHi, const float* g, bf16_t* dst, _Float16* xout) {
    PHASE_FRAME(F0);
    const int gw = F.vcu * NWAVES + F.wave, NGW = F.G * NWAVES;
    f32x4 gv[8];
#pragma unroll
    for (int j = 0; j < 8; ++j) gv[j] = *(const f32x4*)(g + 4 * F.lane + 256 * j);
    for (int m = gw; m < MTOT; m += NGW) {
        f32x4 v[8]; float s = 0.f;
        if (srcH) {
#pragma unroll
            for (int j = 0; j < 8; ++j) { const f16x4 h = *(const f16x4*)(srcH + (size_t)m * DM + 4 * F.lane + 256 * j); v[j] = (f32x4){(float)h.x, (float)h.y, (float)h.z, (float)h.w}; }
        } else {
            const float* xrow = (m < M_P) ? srcP + (size_t)m * DM : srcS + (size_t)(m - M_P) * DM;
#pragma unroll
            for (int j = 0; j < 8; ++j) v[j] = *(const f32x4*)(xrow + 4 * F.lane + 256 * j);
        }
        if (deltaLo) {
            const bf16_t* delta = m < MTOT / 2 ? deltaLo : deltaHi;
#pragma unroll
            for (int j = 0; j < 8; ++j) { const u32x2 d = *(const u32x2*)(delta + (size_t)m * DM + 4 * F.lane + 256 * j);
                v[j].x += __builtin_bit_cast(float, d.x << 16); v[j].y += __builtin_bit_cast(float, d.x & 0xffff0000u); v[j].z += __builtin_bit_cast(float, d.y << 16); v[j].w += __builtin_bit_cast(float, d.y & 0xffff0000u); }
        }
#pragma unroll
        for (int j = 0; j < 8; ++j) s += (v[j].x * v[j].x + v[j].y * v[j].y) + (v[j].z * v[j].z + v[j].w * v[j].w);
        const float r = 1.f / sqrtf(wave_sum(s) * (1.f / DM) + NORM_EPS);
        bf16_t* orow = dst + (size_t)m * DM;
#pragma unroll
        for (int j = 0; j < 8; ++j) {
            if (xout) *(f16x4*)(xout + (size_t)m * DM + 4 * F.lane + 256 * j) = (f16x4){(_Float16)v[j].x, (_Float16)v[j].y, (_Float16)v[j].z, (_Float16)v[j].w};
            const f32x4 y = v[j] * r * gv[j];
            u32x2 o; o.x = pk2(y.x, y.y); o.y = pk2(y.z, y.w);
            *(u32x2*)(orow + 4 * F.lane + 256 * j) = o;
        }
    }
}
__device__ __forceinline__ void final_norm_rows(const Frame& F0, float* OUT, const _Float16* XH, const bf16_t* delta, const float* g, int m0, int m1, int src_base) {
    PHASE_FRAME(F0);
    const int gw = F.vcu * NWAVES + F.wave, NGW = F.G * NWAVES;
    for (int m = m0 + gw; m < m1; m += NGW) {
        f32x4 v[8]; float s = 0.f;
#pragma unroll
        for (int j = 0; j < 8; ++j) { const f16x4 h = *(const f16x4*)(XH + (size_t)(m - src_base) * DM + 4 * F.lane + 256 * j); const u32x2 d = *(const u32x2*)(delta + (size_t)m * DM + 4 * F.lane + 256 * j);
            v[j].x = (float)h.x + __builtin_bit_cast(float, d.x << 16); v[j].y = (float)h.y + __builtin_bit_cast(float, d.x & 0xffff0000u);
            v[j].z = (float)h.z + __builtin_bit_cast(float, d.y << 16); v[j].w = (float)h.w + __builtin_bit_cast(float, d.y & 0xffff0000u);
            s += (v[j].x * v[j].x + v[j].y * v[j].y) + (v[j].z * v[j].z + v[j].w * v[j].w); }
        const float r = 1.f / sqrtf(wave_sum(s) * (1.f / DM) + NORM_EPS);
#pragma unroll
        for (int j = 0; j < 8; ++j) *(f32x4*)(OUT + (size_t)m * DM + 4 * F.lane + 256 * j) = v[j] * r * (*(const f32x4*)(g + 4 * F.lane + 256 * j));
    }
}

__device__ __forceinline__ void convert_ffn_weights(const Frame& F0, const float* wg, const float* wu, const float* wd, bf16_t* GU, bf16_t* D) {
    PHASE_FRAME(F0);
    LAS float* scr = (LAS float*)(F.lds + F.wave * 16384);
    const int gw = F.vcu * NWAVES + F.wave, NGW = F.G * NWAVES;
    constexpr int NB_FF = DFF / 32, KB_DM = DM / 64, I_G = KB_DM * NB_FF;
    constexpr int NB_DM = DM / 32, KB_FF = DFF / 64, I_D = KB_FF * NB_DM;
    for (int it = gw; it < 2 * I_G + I_D; it += NGW) {
        if (it < 2 * I_G) {
            const int up = it >= I_G, r = it - up * I_G, kb = r / NB_FF, nb = r % NB_FF, n0 = nb * 32;
            const int d0 = 256 * (n0 >> 7) + (n0 & 127) + up * 128;
            tr_item(up ? wu : wg, DFF, GU, DM, kb * 64, n0, d0, 32, scr, F.lane);
        } else {
            const int r = it - 2 * I_G, kb = r / NB_DM, nb = r % NB_DM;
            tr_item(wd, DM, D, DFF, kb * 64, nb * 32, nb * 32, 32, scr, F.lane);
        }
    }
}

constexpr int MH = MTOT / 2;
constexpr int IN_W = 5648, IN_WP = 5888, PRJ_LD = 5120;
constexpr int PC_MQ = 0, PC_MK = 512, PC_MV = 1024, PC_MO = 1536, PC_DQ = 2048, PC_DK = 2560, PC_DV = 3072, PC_NQ = 3584, PC_NK = 4096, PC_NV = 4608;
constexpr int S5L = 32, S5NCH = MH / S5L, S5K = 16 * S5L + 256;
constexpr size_t MX_PROJ = WS_BIG, MX_UG = MX_PROJ + 240 * MiB, MX_QKC = MX_UG + 36 * MiB, MX_CST = MX_QKC + 48 * MiB, MX_E = MX_CST + 96 * MiB, MX_Z = MX_E + 24 * MiB;
constexpr size_t MX_GATES = MX_Z + 24 * MiB, MX_NST = MX_GATES + 2 * MiB, MX_MSC = MX_NST + 2 * MiB, MX_END = MX_MSC + 4 * MiB;
static_assert(MX_END <= WS_END, "mixer buffers fit in BIG");
constexpr float QSCALE = 0.125f * 1.4426950408889634f;

__device__ __forceinline__ int tpos(int half, int row) { return (half == 0 && row < 16384) ? (row & 8191) : (row & 4095); }

typedef short v4i16_t __attribute__((ext_vector_type(4)));
__device__ __forceinline__ unsigned off_a(unsigned row, unsigned ch) { return 2048u * (row >> 3) + 512u * (ch >> 2) + 64u * (row & 7) + 16u * ((ch & 3) ^ ((row >> 2) & 3)); }
struct FragBase { unsigned r0, r1, t0, t1; };
__device__ __forceinline__ FragBase make_fragbase(int lane) {
    const unsigned r32 = lane & 31, h = lane >> 5, blk = (lane >> 4) & 1, q = (lane & 15) >> 2, p = lane & 3;
    FragBase fb;
    fb.r0 = 2048u * (r32 >> 3) + 64u * (r32 & 7) + 16u * (((0u + h) & 3) ^ ((r32 >> 2) & 3));
    fb.r1 = 2048u * (r32 >> 3) + 64u * (r32 & 7) + 16u * (((2u + h) & 3) ^ ((r32 >> 2) & 3));
    fb.t0 = 2048u * h + 64u * q + 16u * ((2u * blk + (p >> 1)) ^ ((2u * h) & 3)) + 8u * (p & 1);
    fb.t1 = 2048u * h + 256u + 64u * q + 16u * ((2u * blk + (p >> 1)) ^ ((2u * h + 1u) & 3)) + 8u * (p & 1);
    return fb;
}
__device__ __forceinline__ bf16x8 rowfrag(const LAS unsigned char* tile, int rb, int s, const FragBase& fb) {
    return *(const LAS bf16x8*)(tile + rb * 8192 + (s >> 1) * 512 + ((s & 1) ? fb.r1 : fb.r0));
}
__device__ __forceinline__ bf16x8 trfrag(const LAS unsigned char* tile, int c, int ks, const FragBase& fb) {
    const v4i16_t lo = __builtin_amdgcn_ds_read_tr16_b64_v4i16((LAS v4i16_t*)(tile + ks * 4096 + c * 512 + fb.t0));
    const v4i16_t hi = __builtin_amdgcn_ds_read_tr16_b64_v4i16((LAS v4i16_t*)(tile + ks * 4096 + c * 512 + fb.t1));
    return (bf16x8){lo[0], lo[1], lo[2], lo[3], hi[0], hi[1], hi[2], hi[3]};
}
__device__ __forceinline__ float max3f(float a, float b, float c) { float r; asm("v_max3_f32 %0, %1, %2, %3" : "=v"(r) : "v"(a), "v"(b), "v"(c)); return r; }
#define SBAR() __builtin_amdgcn_sched_barrier(0)
__device__ __forceinline__ int crow(int r, int hi) { return (r & 3) + 8 * (r >> 2) + 4 * hi; }
#define MFMA32(a, b, c) __builtin_amdgcn_mfma_f32_32x32x16_bf16((a), (b), (c), 0, 0, 0)
__device__ __forceinline__ float swap_max(float v) { auto rr = __builtin_amdgcn_permlane32_swap(__float_as_uint(v), __float_as_uint(v), false, false); return fmaxf(__uint_as_float(rr[0]), __uint_as_float(rr[1])); }
__device__ __forceinline__ float swap_add(float v) { auto rr = __builtin_amdgcn_permlane32_swap(__float_as_uint(v), __float_as_uint(v), false, false); return __uint_as_float(rr[0]) + __uint_as_float(rr[1]); }
#define PK4(P, BASE, OUT) do { unsigned a0_ = cvt_pk_bf16(P[BASE + 0], P[BASE + 1]), a1_ = cvt_pk_bf16(P[BASE + 2], P[BASE + 3]); \
    unsigned b0_ = cvt_pk_bf16(P[BASE + 4], P[BASE + 5]), b1_ = cvt_pk_bf16(P[BASE + 6], P[BASE + 7]); \
    auto r0_ = __builtin_amdgcn_permlane32_swap(a0_, b0_, false, false); auto r1_ = __builtin_amdgcn_permlane32_swap(a1_, b1_, false, false); \
    u32x4 w_ = {r0_[0], r1_[0], r0_[1], r1_[1]}; OUT = __builtin_bit_cast(bf16x8, w_); } while (0)

namespace pg8 {
struct EpiInProj {
    static constexpr bool PERM = true;
    bf16_t* P; bf16_t* UG; float* GT; const float* gbias; const float* rope; int half;
    __device__ __forceinline__ void operator()(const f32x4 (&acc)[2][2][4][2], const Unit& u, int wr, int wc, int fr, int fq) const {
        const int row0 = u.pm * BM + wr * 64 + fr;
        if (u.pn >= 8 && u.pn < 12) {
            const float sc = u.pn < 10 ? QSCALE : 1.f;
#pragma unroll
            for (int ai = 0; ai < 2; ++ai)
#pragma unroll
                for (int m = 0; m < 4; ++m) { const int row = row0 + ai * HALF + m * 16; bf16_t* rowp = P + (size_t)row * PRJ_LD + u.pn * BM + wc * 32 + 8 * fq;
                    const float* tb = rope + ((size_t)tpos(half, row) * 32 + (((wc * 32 + 8 * fq) & 63) >> 1)) * 2;
                    const f32x4 cs0 = *(const f32x4*)tb, cs1 = *(const f32x4*)(tb + 4);
#pragma unroll
                    for (int bj = 0; bj < 2; ++bj) { const f32x4 v0 = acc[ai][bj][m][0], v1 = acc[ai][bj][m][1];
                        u32x4 w;
                        w.x = cvt_pk_bf16((v0[0] * cs0[0] - v0[1] * cs0[1]) * sc, (v0[1] * cs0[0] + v0[0] * cs0[1]) * sc);
                        w.y = cvt_pk_bf16((v0[2] * cs0[2] - v0[3] * cs0[3]) * sc, (v0[3] * cs0[2] + v0[2] * cs0[3]) * sc);
                        w.z = cvt_pk_bf16((v1[0] * cs1[0] - v1[1] * cs1[1]) * sc, (v1[1] * cs1[0] + v1[0] * cs1[1]) * sc);
                        w.w = cvt_pk_bf16((v1[2] * cs1[2] - v1[3] * cs1[3]) * sc, (v1[3] * cs1[2] + v1[2] * cs1[3]) * sc);
                        *(u32x4*)(rowp + bj * HALF) = w; } }
        } else if (u.pn < 20) {
            const int col0 = u.pn * BM + wc * 32 + 8 * fq;
#pragma unroll
            for (int ai = 0; ai < 2; ++ai)
#pragma unroll
                for (int m = 0; m < 4; ++m) { bf16_t* rowp = P + (size_t)(row0 + ai * HALF + m * 16) * PRJ_LD + col0;
#pragma unroll
                    for (int bj = 0; bj < 2; ++bj) { const f32x4 v0 = acc[ai][bj][m][0], v1 = acc[ai][bj][m][1];
                        u32x4 w; w.x = cvt_pk_bf16(v0[0], v0[1]); w.y = cvt_pk_bf16(v0[2], v0[3]); w.z = cvt_pk_bf16(v1[0], v1[1]); w.w = cvt_pk_bf16(v1[2], v1[3]);
                        *(u32x4*)(rowp + bj * HALF) = w; } }
        } else if (u.pn < 22) {
#pragma unroll
            for (int ai = 0; ai < 2; ++ai)
#pragma unroll
                for (int m = 0; m < 4; ++m) { const int row = row0 + ai * HALF + m * 16, chunk = row / S5L, i = row % S5L;
#pragma unroll
                    for (int bj = 0; bj < 2; ++bj) { const int col = (u.pn - 20) * BM + bj * HALF + wc * 32 + 8 * fq, g = col >> 4, c0 = col & 15;
                        const f32x4 v0 = acc[ai][bj][m][0], v1 = acc[ai][bj][m][1];
                        u32x4 w; w.x = cvt_pk_bf16(v0[0], v0[1]); w.y = cvt_pk_bf16(v0[2], v0[3]); w.z = cvt_pk_bf16(v1[0], v1[1]); w.w = cvt_pk_bf16(v1[2], v1[3]);
                        *(u32x4*)(UG + ((size_t)g * S5NCH + chunk) * S5K + i * 16 + c0) = w; } }
        } else {
            if (wc == 0 && fq < 2) {
                const f32x4 b0 = *(const f32x4*)(gbias + 8 * fq), b1 = *(const f32x4*)(gbias + 8 * fq + 4);
#pragma unroll
                for (int ai = 0; ai < 2; ++ai)
#pragma unroll
                    for (int m = 0; m < 4; ++m) { float* gp = GT + (size_t)(row0 + ai * HALF + m * 16) * 16 + 8 * fq;
                        *(f32x4*)gp = acc[ai][0][m][0] + b0; *(f32x4*)(gp + 4) = acc[ai][0][m][1] + b1; }
            }
        }
    }
};
}

__device__ __forceinline__ void convert_mixer_weights(const Frame& F0, const float* win, const float* wout, const float* glu, bf16_t* WIN, bf16_t* WOUT, bf16_t* GLU) {
    PHASE_FRAME(F0);
    LAS float* scr = (LAS float*)(F.lds + F.wave * 16384);
    const int gw = F.vcu * NWAVES + F.wave, NGW = F.G * NWAVES;
    constexpr int I_IN = (DM / 64) * (IN_WP / 32), I_OUT = (DM / 64) * (DM / 32), I_GLU = (GWID / 64) * (GWID / 32);
    for (int it = gw; it < I_IN + I_OUT + I_GLU; it += NGW) {
        if (it < I_IN) {
            const int kb = it / (IN_WP / 32), db = it % (IN_WP / 32), d0 = db * 32;
            int s0, nv; bool perm = false;
            if (d0 < 2048) { s0 = d0; nv = 32; } else if (d0 < 3072) { s0 = (d0 & ~63) + 16 + ((d0 >> 5) & 1) * 16; nv = 32; perm = true; }
            else if (d0 < 5632) { s0 = d0 + 16; nv = 32; } else if (d0 == 5632) { s0 = 2048; nv = 16; } else { s0 = 0; nv = 0; }
            tr_item(win, IN_W, WIN, DM, kb * 64, s0, d0, nv, scr, F.lane, perm);
        } else if (it < I_IN + I_OUT) {
            const int r = it - I_IN, kb = r / (DM / 32), nb = r % (DM / 32);
            tr_item(wout, DM, WOUT, DM, kb * 64, nb * 32, nb * 32, 32, scr, F.lane);
        } else {
            const int r = it - I_IN - I_OUT, kb = r / (GWID / 32), nb = r % (GWID / 32);
            tr_item(glu, GWID, GLU, GWID, kb * 64, nb * 32, nb * 32, 32, scr, F.lane);
        }
    }
}

__device__ __forceinline__ void rope_table_phase(const Frame& F0, float* tab) {
    PHASE_FRAME(F0);
    const int gt = F.vcu * (NWAVES * 64) + F.tid, NT = F.G * NWAVES * 64;
    for (int idx = gt; idx < 8192 * 32; idx += NT) {
        const int t = idx >> 5, i = idx & 31;
        const float inv = powf(10000.f, -(float)(2 * i) / 64.f);
        float s, c; sincosf((float)t * inv, &s, &c);
        tab[2 * idx] = c; tab[2 * idx + 1] = s;
    }
}
__device__ __forceinline__ void rope_apply_phase(const Frame& F0, int half, bf16_t* PR, const float* tab) {
    PHASE_FRAME(F0);
    const long gt = (long)F.vcu * (NWAVES * 64) + F.tid, NT = (long)F.G * NWAVES * 64;
    for (long it = gt; it < (long)MH * 64; it += NT) {
        const int row = (int)(it >> 6), x = (int)(it & 63), vec = x >> 2, ig = x & 3;
        bf16_t* p = PR + (size_t)row * PRJ_LD + PC_DQ + vec * 64 + ig * 8;
        const u32x4 a = *(const u32x4*)p, b = *(const u32x4*)(p + 32);
        const float* tb = tab + ((size_t)tpos(half, row) * 32 + ig * 8) * 2;
        const float sc = vec < 8 ? QSCALE : 1.f;
        u32x4 oa, ob;
#pragma unroll
        for (int e = 0; e < 4; ++e) {
            const f32x4 cs = *(const f32x4*)(tb + 4 * e);
            const float x1a = __builtin_bit_cast(float, a[e] << 16), x1b = __builtin_bit_cast(float, a[e] & 0xffff0000u);
            const float x2a = __builtin_bit_cast(float, b[e] << 16), x2b = __builtin_bit_cast(float, b[e] & 0xffff0000u);
            oa[e] = pk2((x1a * cs[0] - x2a * cs[1]) * sc, (x1b * cs[2] - x2b * cs[3]) * sc);
            ob[e] = pk2((x2a * cs[0] + x1a * cs[1]) * sc, (x2b * cs[2] + x1b * cs[3]) * sc);
        }
        *(u32x4*)p = oa; *(u32x4*)(p + 32) = ob;
    }
}

__device__ __forceinline__ void diffattn_phase(const Frame& F, int half, int layer, const bf16_t* PR, bf16_t* MIXh, const float* lamp, const float* normg) {
    const int tid = opaque_tid(F.wave), lane = tid & 63, wave = F.wave;
    const int map = wave >> 2, qw = wave & 3, r32 = lane & 31, hi = lane >> 5;
    const FragBase fb = make_fragbase(lane);
    LAS unsigned char* lds = F.lds;
    float d01 = 0.f, d23 = 0.f;
    for (int i = 0; i < 64; ++i) { d01 += lamp[i] * lamp[64 + i]; d23 += lamp[128 + i] * lamp[192 + i]; }
    const float lam_init = 0.8f - 0.6f * expf(-0.3f * (float)layer);
    const float lam = expf(d01) - expf(d23) + lam_init, oscale = 1.f - lam_init;
    LAS unsigned char* KB = lds; LAS unsigned char* VB = lds + 32768;
    LAS float* wsf = (LAS float*)(lds + 69632 + wave * 256);
    LAS float* OS = (LAS float*)lds;
    const int srow = tid >> 4, sch = tid & 15;
    const unsigned so0 = off_a(srow, sch), so1 = off_a(srow + 32, sch);
    for (int ui = 0; ; ++ui) {
        int row0, T, head, qb;
        if (gridDim.x == 256) {
            if (ui >= 3) break;
            const int x = blockIdx.x & 7, r = blockIdx.x >> 3;
            if (half == 0) { if (ui < 2) { row0 = (x >> 2) * 8192; T = 8192; head = x & 3; qb = r + 32 * ui; } else { row0 = 16384 + (x >> 2) * 4096; T = 4096; head = x & 3; qb = r; } }
            else { const int p = x + 8 * ui; row0 = (p >> 2) * 4096; T = 4096; head = p & 3; qb = r; }
        } else {
            const int u = blockIdx.x + ui * gridDim.x; if (u >= 768) break;
            if (half == 0) { if (u < 512) { row0 = (u >> 8) * 8192; T = 8192; head = (u >> 6) & 3; qb = u & 63; } else { const int v = u - 512; row0 = 16384 + (v >> 7) * 4096; T = 4096; head = (v >> 5) & 3; qb = v & 31; } }
            else { row0 = (u >> 7) * 4096; T = 4096; head = (u >> 5) & 3; qb = u & 31; }
        }
        const int NT = T / 64;
        const bf16_t* Kg = PR + (size_t)row0 * PRJ_LD + PC_DK + head * 128;
        const bf16_t* Vg = PR + (size_t)row0 * PRJ_LD + PC_DV + head * 128;
        const int qrow = row0 + qb * 128 + qw * 32 + r32;
        bf16x8 qf[4];
#pragma unroll
        for (int kk = 0; kk < 4; ++kk) qf[kk] = *(const bf16x8*)(PR + (size_t)qrow * PRJ_LD + PC_DQ + head * 128 + map * 64 + kk * 16 + hi * 8);
        u32x4 sk0, sk1, sv0, sv1, tk0, tk1, tv0, tv1;
#define DA_LOAD(j) do { const size_t ro_ = (size_t)((j) * 64 + srow) * PRJ_LD + sch * 8; sk0 = *(const u32x4*)(Kg + ro_); sk1 = *(const u32x4*)(Kg + ro_ + 32 * PRJ_LD); \
        sv0 = *(const u32x4*)(Vg + ro_); sv1 = *(const u32x4*)(Vg + ro_ + 32 * PRJ_LD); } while (0)
#define DA_LOAD2(j) do { const size_t ro_ = (size_t)((j) * 64 + srow) * PRJ_LD + sch * 8; tk0 = *(const u32x4*)(Kg + ro_); tk1 = *(const u32x4*)(Kg + ro_ + 32 * PRJ_LD); \
        tv0 = *(const u32x4*)(Vg + ro_); tv1 = *(const u32x4*)(Vg + ro_ + 32 * PRJ_LD); } while (0)
#define DA_WRITE(b) do { *(LAS u32x4*)(KB + (b) * 16384 + so0) = sk0; *(LAS u32x4*)(KB + (b) * 16384 + so1) = sk1; \
        *(LAS u32x4*)(VB + (b) * 16384 + so0) = sv0; *(LAS u32x4*)(VB + (b) * 16384 + so1) = sv1; } while (0)
#define DA_WRITE2(b) do { *(LAS u32x4*)(KB + (b) * 16384 + so0) = tk0; *(LAS u32x4*)(KB + (b) * 16384 + so1) = tk1; \
        *(LAS u32x4*)(VB + (b) * 16384 + so0) = tv0; *(LAS u32x4*)(VB + (b) * 16384 + so1) = tv1; } while (0)
        DA_LOAD(0); DA_WRITE(0); DA_LOAD2(1); __syncthreads();
        constexpr float DTHR = 10.f;
        float m_run = 0.f;
        f32x16 o[4], lacc, negm;
#pragma unroll
        for (int r = 0; r < 16; ++r) { lacc[r] = 0.f; negm[r] = 0.f; }
#pragma unroll
        for (int d = 0; d < 4; ++d)
#pragma unroll
            for (int r = 0; r < 16; ++r) o[d][r] = 0.f;
        const bf16x8 ones = {0x3F80, 0x3F80, 0x3F80, 0x3F80, 0x3F80, 0x3F80, 0x3F80, 0x3F80};
        for (int j = 0; j < NT; j += 2) {
          { const int b = 0;
            if (j + 2 < NT) DA_LOAD(j + 2);
            const LAS unsigned char* Kt = KB + b * 16384; const LAS unsigned char* Vt = VB + b * 16384;
            f32x16 p0, p1;
            {
                bf16x8 ka[4], kb[4];
#pragma unroll
                for (int kk = 0; kk < 4; ++kk) { ka[kk] = rowfrag(Kt + map * 1024, 0, kk, fb); kb[kk] = rowfrag(Kt + map * 1024, 1, kk, fb); }
                SBAR();
                p0 = MFMA32(ka[0], qf[0], negm); p1 = MFMA32(kb[0], qf[0], negm);
#pragma unroll
                for (int kk = 1; kk < 4; ++kk) { p0 = MFMA32(ka[kk], qf[kk], p0); p1 = MFMA32(kb[kk], qf[kk], p1); }
            }
            bf16x8 vA[4], vB[4];
#pragma unroll
            for (int d = 0; d < 4; ++d) vA[d] = trfrag(Vt, d, 0, fb);
            float pmax = max3f(p0[0], p1[0], p0[1]);
            pmax = max3f(pmax, p1[1], p0[2]);
#pragma unroll
            for (int r = 2; r < 15; ++r) pmax = max3f(pmax, p1[r], p0[r + 1]);
            pmax = fmaxf(pmax, p1[15]);
            pmax = swap_max(pmax);
            if (__builtin_expect(!__all(pmax <= DTHR) || j == 0, 0)) {
                const float dlt = j == 0 ? pmax : fmaxf(pmax, 0.f), alpha = j == 0 ? 1.f : __builtin_amdgcn_exp2f(-dlt);
                m_run += dlt;
#pragma unroll
                for (int r = 0; r < 16; ++r) { p0[r] -= dlt; p1[r] -= dlt; negm[r] = -m_run; }
                if (hi == 0) wsf[r32] = alpha;
#pragma unroll
                for (int r = 0; r < 16; ++r) { const float al = wsf[crow(r, hi)]; lacc[r] *= al;
#pragma unroll
                    for (int d = 0; d < 4; ++d) o[d][r] *= al; }
            }
#pragma unroll
            for (int r = 0; r < 16; ++r) { p0[r] = __builtin_amdgcn_exp2f(p0[r]); p1[r] = __builtin_amdgcn_exp2f(p1[r]); }
            bf16x8 pa[4];
            PK4(p0, 0, pa[0]); PK4(p0, 8, pa[1]); PK4(p1, 0, pa[2]); PK4(p1, 8, pa[3]);
#define DA_PV_STEP(KS, VC, VN) do { if ((KS) < 3) { _Pragma("unroll") for (int d = 0; d < 4; ++d) VN[d] = trfrag(Vt, d, (KS) + 1, fb); } SBAR(); \
                lacc = MFMA32(pa[KS], ones, lacc); _Pragma("unroll") for (int d = 0; d < 4; ++d) o[d] = MFMA32(pa[KS], VC[d], o[d]); SBAR(); } while (0)
            DA_PV_STEP(0, vA, vB); DA_PV_STEP(1, vB, vA); DA_PV_STEP(2, vA, vB); DA_PV_STEP(3, vB, vA);
#undef DA_PV_STEP
            DA_WRITE2(1);
            __syncthreads();
          }
          { const int b = 1;
            if (j + 3 < NT) DA_LOAD2(j + 3);
            const LAS unsigned char* Kt = KB + b * 16384; const LAS unsigned char* Vt = VB + b * 16384;
            f32x16 p0, p1;
            {
                bf16x8 ka[4], kb[4];
#pragma unroll
                for (int kk = 0; kk < 4; ++kk) { ka[kk] = rowfrag(Kt + map * 1024, 0, kk, fb); kb[kk] = rowfrag(Kt + map * 1024, 1, kk, fb); }
                SBAR();
                p0 = MFMA32(ka[0], qf[0], negm); p1 = MFMA32(kb[0], qf[0], negm);
#pragma unroll
                for (int kk = 1; kk < 4; ++kk) { p0 = MFMA32(ka[kk], qf[kk], p0); p1 = MFMA32(kb[kk], qf[kk], p1); }
            }
            bf16x8 vA[4], vB[4];
#pragma unroll
            for (int d = 0; d < 4; ++d) vA[d] = trfrag(Vt, d, 0, fb);
            float pmax = max3f(p0[0], p1[0], p0[1]);
            pmax = max3f(pmax, p1[1], p0[2]);
#pragma unroll
            for (int r = 2; r < 15; ++r) pmax = max3f(pmax, p1[r], p0[r + 1]);
            pmax = fmaxf(pmax, p1[15]);
            pmax = swap_max(pmax);
            if (__builtin_expect(!__all(pmax <= DTHR) || false, 0)) {
                const float dlt = false ? pmax : fmaxf(pmax, 0.f), alpha = false ? 1.f : __builtin_amdgcn_exp2f(-dlt);
                m_run += dlt;
#pragma unroll
                for (int r = 0; r < 16; ++r) { p0[r] -= dlt; p1[r] -= dlt; negm[r] = -m_run; }
                if (hi == 0) wsf[r32] = alpha;
#pragma unroll
                for (int r = 0; r < 16; ++r) { const float al = wsf[crow(r, hi)]; lacc[r] *= al;
#pragma unroll
                    for (int d = 0; d < 4; ++d) o[d][r] *= al; }
            }
#pragma unroll
            for (int r = 0; r < 16; ++r) { p0[r] = __builtin_amdgcn_exp2f(p0[r]); p1[r] = __builtin_amdgcn_exp2f(p1[r]); }
            bf16x8 pa[4];
            PK4(p0, 0, pa[0]); PK4(p0, 8, pa[1]); PK4(p1, 0, pa[2]); PK4(p1, 8, pa[3]);
#define DA_PV_STEP(KS, VC, VN) do { if ((KS) < 3) { _Pragma("unroll") for (int d = 0; d < 4; ++d) VN[d] = trfrag(Vt, d, (KS) + 1, fb); } SBAR(); \
                lacc = MFMA32(pa[KS], ones, lacc); _Pragma("unroll") for (int d = 0; d < 4; ++d) o[d] = MFMA32(pa[KS], VC[d], o[d]); SBAR(); } while (0)
            DA_PV_STEP(0, vA, vB); DA_PV_STEP(1, vB, vA); DA_PV_STEP(2, vA, vB); DA_PV_STEP(3, vB, vA);
#undef DA_PV_STEP
            if (j + 2 < NT) DA_WRITE(0);
            __syncthreads();
          }
        }
        float rl[16];
#pragma unroll
        for (int r = 0; r < 16; ++r) rl[r] = 1.f / lacc[r];
        if (map == 1) {
#pragma unroll
            for (int d = 0; d < 4; ++d)
#pragma unroll
                for (int r = 0; r < 16; ++r) OS[(qw * 32 + crow(r, hi)) * 132 + d * 32 + r32] = -lam * o[d][r] * rl[r];
        }
        __syncthreads();
        if (map == 0) {
#pragma unroll
            for (int d = 0; d < 4; ++d)
#pragma unroll
                for (int r = 0; r < 16; ++r) OS[(qw * 32 + crow(r, hi)) * 132 + d * 32 + r32] += o[d][r] * rl[r];
        }
        __syncthreads();
        const float g0 = normg[lane], g1 = normg[64 + lane];
        for (int i = 0; i < 16; ++i) {
            const int row = wave * 16 + i;
            const float v0 = OS[row * 132 + lane], v1 = OS[row * 132 + 64 + lane];
            const float rs = 1.f / sqrtf(wave_sum(v0 * v0 + v1 * v1) * (1.f / 128.f) + NORM_EPS) * oscale;
            bf16_t* orow = MIXh + (size_t)(row0 + qb * 128 + row) * DM + 512 + head * 128;
            orow[lane] = (bf16_t)f2bf(v0 * rs * g0); orow[64 + lane] = (bf16_t)f2bf(v1 * rs * g1);
        }
        __syncthreads();
#undef DA_LOAD
#undef DA_WRITE
#undef DA_LOAD2
#undef DA_WRITE2
    }
}

constexpr int ML_NCH = MH / 64;
constexpr int MSC_B = 0, MSC_ICB = 8 * MH, MSC_PMX = 16 * MH, MSC_WL = 24 * MH, MSC_G = 32 * MH, MSC_AMAX = MSC_G + 8 * ML_NCH, MSC_MPREV = MSC_AMAX + 8 * ML_NCH;
static_assert((size_t)(MSC_MPREV + 8 * ML_NCH) * 4 <= 4 * MiB, "MSC fits");
__device__ __forceinline__ void unpack8(const u32x4 v, float (&f)[8]) {
#pragma unroll
    for (int e = 0; e < 4; ++e) { f[2 * e] = __builtin_bit_cast(float, v[e] << 16); f[2 * e + 1] = __builtin_bit_cast(float, v[e] & 0xffff0000u); }
}
__device__ __forceinline__ void mlstm_conv_phase(const Frame& F0, int half, const bf16_t* PR, bf16_t* QKC, const float* cw, const float* cb) {
    PHASE_FRAME(F0);
    const long gt = (long)F.vcu * (NWAVES * 64) + F.tid, NT = (long)F.G * NWAVES * 64;
    for (long it = gt; it < (long)(MH / 16) * 128; it += NT) {
        const int cg = (int)(it & 127), tb = (int)(it >> 7), c0 = cg * 8;
        float w[5][8], bias[8];
#pragma unroll
        for (int j = 0; j < 5; ++j) { const f32x4 a = *(const f32x4*)(cw + j * 1024 + c0), b = *(const f32x4*)(cw + j * 1024 + c0 + 4);
            w[j][0] = a[0]; w[j][1] = a[1]; w[j][2] = a[2]; w[j][3] = a[3]; w[j][4] = b[0]; w[j][5] = b[1]; w[j][6] = b[2]; w[j][7] = b[3]; }
        { const f32x4 a = *(const f32x4*)(cb + c0), b = *(const f32x4*)(cb + c0 + 4); bias[0] = a[0]; bias[1] = a[1]; bias[2] = a[2]; bias[3] = a[3]; bias[4] = b[0]; bias[5] = b[1]; bias[6] = b[2]; bias[7] = b[3]; }
        const float osc = cg >= 64 ? 0.08838834764831845f : 1.f;
        const int rowb = tb * 16, posb = tpos(half, rowb), T = (half == 0 && rowb < 16384) ? 8192 : 4096;
        u32x4 rr[20];
#pragma unroll
        for (int q = 0; q < 20; ++q) { const int pp = posb + q - 2;
            rr[q] = (pp >= 0 && pp < T) ? *(const u32x4*)(PR + (size_t)(rowb + q - 2) * PRJ_LD + c0) : (u32x4){0u, 0u, 0u, 0u}; }
#pragma unroll
        for (int i = 0; i < 16; ++i) {
            float acc[8];
#pragma unroll
            for (int e = 0; e < 8; ++e) acc[e] = bias[e];
#pragma unroll
            for (int j = 0; j < 5; ++j) { float x[8]; unpack8(rr[i + j], x);
#pragma unroll
                for (int e = 0; e < 8; ++e) acc[e] += w[j][e] * x[e]; }
            u32x4 o;
#pragma unroll
            for (int e = 0; e < 4; ++e) o[e] = pk2(fast_silu(acc[2 * e]) * osc, fast_silu(acc[2 * e + 1]) * osc);
            *(u32x4*)(QKC + (size_t)(rowb + i) * 1024 + c0) = o;
        }
    }
}
__device__ __forceinline__ float log_sigmoid(float x) { return fminf(x, 0.f) - log1pf(expf(-fabsf(x))); }
__device__ __forceinline__ void mlstm_scalar_phase(const Frame& F0, const float* GT, float* MSC) {
    PHASE_FRAME(F0);
    const int gw = F.vcu * NWAVES + F.wave, NGW = F.G * NWAVES, lane = F.lane;
    for (int it = gw; it < ML_NCH * 8; it += NGW) {
        const int jc = it >> 3, hd = it & 7, h = hd >> 1, dir = hd & 1, row = jc * 64 + lane;
        const float ic = GT[(size_t)row * 16 + dir * 8 + h], fg = GT[(size_t)row * 16 + dir * 8 + 4 + h];
        const float lf = log_sigmoid(fg);
        float b = lf;
#pragma unroll
        for (int o = 1; o < 64; o <<= 1) { const float t = dir == 0 ? __shfl_up(b, o) : __shfl_down(b, o); if (dir == 0 ? (lane >= o) : (lane + o < 64)) b += t; }
        const float g = dir == 0 ? __shfl(b, 63) : __shfl(b, 0);
        const float a = g - b + ic;
        float amax = a;
#pragma unroll
        for (int o = 1; o < 64; o <<= 1) amax = fmaxf(amax, __shfl_xor(amax, o));
        const float icb = ic - b;
        float pm = icb;
#pragma unroll
        for (int o = 1; o < 64; o <<= 1) { const float t = dir == 0 ? __shfl_up(pm, o) : __shfl_down(pm, o); if (dir == 0 ? (lane >= o) : (lane + o < 64)) pm = fmaxf(pm, t); }
        MSC[MSC_B + hd * MH + row] = b; MSC[MSC_ICB + hd * MH + row] = icb; MSC[MSC_PMX + hd * MH + row] = pm; MSC[MSC_WL + hd * MH + row] = expf(a - amax);
        if (lane == 0) { MSC[MSC_G + hd * ML_NCH + jc] = g; MSC[MSC_AMAX + hd * ML_NCH + jc] = amax; }
    }
}
__device__ __forceinline__ void mlstm_state_phase(const Frame& F0, const bf16_t* PR, const bf16_t* QKC, const float* MSC, bf16_t* CST, float* NST) {
    PHASE_FRAME(F0);
    const int tid = F.tid, lane = F.lane, wave = F.wave, r32 = lane & 31, hi = lane >> 5;
    LAS unsigned char* Vt = F.lds; LAS unsigned char* Kt = F.lds + 16384;
    const int srow = tid >> 4, sch = tid & 15;
    const unsigned so0 = off_a(srow, sch), so1 = off_a(srow + 32, sch);
    const int eb = wave >> 1, db0 = 2 * (wave & 1);
    const FragBase fb = make_fragbase(lane);
    for (int u = blockIdx.x; u < ML_NCH * 4; u += gridDim.x) {
        const int jc = u >> 2, h = u & 3, row0 = jc * 64;
        *(LAS u32x4*)(Vt + so0) = *(const u32x4*)(PR + (size_t)(row0 + srow) * PRJ_LD + PC_MV + h * 128 + sch * 8);
        *(LAS u32x4*)(Vt + so1) = *(const u32x4*)(PR + (size_t)(row0 + srow + 32) * PRJ_LD + PC_MV + h * 128 + sch * 8);
        const u32x4 k0 = *(const u32x4*)(QKC + (size_t)(row0 + srow) * 1024 + 512 + h * 128 + sch * 8);
        const u32x4 k1 = *(const u32x4*)(QKC + (size_t)(row0 + srow + 32) * 1024 + 512 + h * 128 + sch * 8);
        for (int dir = 0; dir < 2; ++dir) {
            const int hd = h * 2 + dir, unit = u * 2 + dir;
            const float w0 = MSC[MSC_WL + hd * MH + row0 + srow], w1 = MSC[MSC_WL + hd * MH + row0 + srow + 32];
            { float x[8]; unpack8(k0, x); u32x4 o;
#pragma unroll
              for (int e = 0; e < 4; ++e) o[e] = pk2(x[2 * e] * w0, x[2 * e + 1] * w0);
              *(LAS u32x4*)(Kt + so0) = o; }
            { float x[8]; unpack8(k1, x); u32x4 o;
#pragma unroll
              for (int e = 0; e < 4; ++e) o[e] = pk2(x[2 * e] * w1, x[2 * e + 1] * w1);
              *(LAS u32x4*)(Kt + so1) = o; }
            __syncthreads();
            f32x16 acc0, acc1;
#pragma unroll
            for (int r = 0; r < 16; ++r) { acc0[r] = 0.f; acc1[r] = 0.f; }
#pragma unroll
            for (int ks = 0; ks < 4; ++ks) {
                const bf16x8 a = trfrag(Vt + eb * 512, 0, ks, fb), b0 = trfrag(Kt + db0 * 512, 0, ks, fb), b1 = trfrag(Kt + db0 * 512, 1, ks, fb);
                acc0 = MFMA32(a, b0, acc0); acc1 = MFMA32(a, b1, acc1);
            }
            bf16_t* cs = CST + (size_t)unit * 16384;
#pragma unroll
            for (int r = 0; r < 16; ++r) { const int e = 32 * eb + crow(r, hi);
                cs[e * 128 + 32 * db0 + r32] = (bf16_t)f2bf(acc0[r]); cs[e * 128 + 32 * (db0 + 1) + r32] = (bf16_t)f2bf(acc1[r]); }
            if (tid < 128) {
                float sum = 0.f;
                for (int l = 0; l < 64; ++l) sum += bf2f(*(const LAS unsigned short*)(Kt + off_a(l, tid >> 3) + (tid & 7) * 2));
                NST[(size_t)unit * 128 + tid] = sum;
            }
            __syncthreads();
        }
    }
}
__device__ __forceinline__ void mlstm_scan_phase(const Frame& F0, int half, float* MSC, bf16_t* CST, float* NST) {
    PHASE_FRAME(F0);
    const int gw = F.vcu * NWAVES + F.wave, NGW = F.G * NWAVES, lane = F.lane;
    const int nchain = (half == 0 ? 4 : 6) * 8;
    for (int it = F.wave * F.G + F.vcu; it < nchain * 33; it += NGW) {
        const int chain = it / 33, wi = it % 33, s = chain >> 3, hd = chain & 7, h = hd >> 1, dir = hd & 1;
        const int row0 = half == 0 ? (s < 2 ? s * 8192 : 16384 + (s - 2) * 4096) : s * 4096, T = (half == 0 && s < 2) ? 8192 : 4096;
        const int c0 = row0 / 64, nc = T / 64;
        float m = 0.f;
        if (wi < 32) {
            const int grp = wi * 64 + lane;
            float C[8];
#pragma unroll
            for (int e = 0; e < 8; ++e) C[e] = 0.f;
            for (int j0 = 0; j0 < nc; j0 += 16) {
                u32x4 U[16];
#pragma unroll
                for (int q = 0; q < 16; ++q) { const int jc = dir == 0 ? c0 + j0 + q : c0 + nc - 1 - (j0 + q); U[q] = *(const u32x4*)(CST + ((size_t)(jc * 4 + h) * 2 + dir) * 16384 + grp * 8); }
#pragma unroll
                for (int q = 0; q < 16; ++q) {
                    const int jc = dir == 0 ? c0 + j0 + q : c0 + nc - 1 - (j0 + q);
                    const float g = MSC[MSC_G + hd * ML_NCH + jc], am = MSC[MSC_AMAX + hd * ML_NCH + jc];
                    const float mn = fmaxf(g + m, am), dec = expf(g + m - mn), inc = expf(am - mn);
                    if (wi == 0 && lane == 0) MSC[MSC_MPREV + hd * ML_NCH + jc] = m;
                    m = mn;
                    u32x4 o;
#pragma unroll
                    for (int e = 0; e < 4; ++e) o[e] = pk2(C[2 * e], C[2 * e + 1]);
                    *(u32x4*)(CST + ((size_t)(jc * 4 + h) * 2 + dir) * 16384 + grp * 8) = o;
                    float x[8]; unpack8(U[q], x);
#pragma unroll
                    for (int e = 0; e < 8; ++e) C[e] = dec * C[e] + inc * x[e];
                }
            }
        } else {
            float n0 = 0.f, n1 = 0.f;
            for (int j = 0; j < nc; ++j) {
                const int jc = dir == 0 ? c0 + j : c0 + nc - 1 - j;
                const float g = MSC[MSC_G + hd * ML_NCH + jc], am = MSC[MSC_AMAX + hd * ML_NCH + jc];
                const float mn = fmaxf(g + m, am), dec = expf(g + m - mn), inc = expf(am - mn);
                m = mn;
                float* np = NST + ((size_t)(jc * 4 + h) * 2 + dir) * 128 + lane * 2;
                const f32x2 uu = *(const f32x2*)np;
                *(f32x2*)np = (f32x2){n0, n1};
                n0 = dec * n0 + inc * uu[0]; n1 = dec * n1 + inc * uu[1];
            }
        }
    }
}
__device__ __forceinline__ void mlstm_out_phase(const Frame& F0, const bf16_t* PR, const bf16_t* QKC, const float* MSC, const bf16_t* CST, const float* NST, const float* normg, bf16_t* MIXh) {
    PHASE_FRAME(F0);
    const int tid = F.tid, lane = F.lane, wave = F.wave, r32 = lane & 31, hi = lane >> 5;
    LAS unsigned char* Qt = F.lds; LAS unsigned char* Kt = F.lds + 16384; LAS unsigned char* Vt = F.lds + 32768; LAS unsigned char* CT0 = F.lds + 49152;
    LAS float* HS = (LAS float*)F.lds;
    LAS float* SC = (LAS float*)(F.lds + 114688);
    LAS float* wsx = (LAS float*)(F.lds + 118784 + wave * 512);
    const int lb = wave & 1, eb = wave >> 1, l = 32 * lb + r32;
    const FragBase fb = make_fragbase(lane);
    const int NU = ML_NCH * 4;
    u32x4 gq0, gq1, gk0, gk1, gv0, gv1, gc0[4], gc1[4]; float gs0, gs1; unsigned go[8];
#define MO_GATES(uu) do { const int jc_ = (uu) >> 2, h_ = (uu) & 3, l_ = opaque_tid(wave) & 63; \
        _Pragma("unroll") for (int i = 0; i < 8; ++i) go[i] = *(const unsigned*)(PR + (size_t)(jc_ * 64 + wave * 8 + i) * PRJ_LD + PC_MO + h_ * 128 + 2 * l_); } while (0)
#define MO_LOADS(uu) do { const int jc_ = (uu) >> 2, h_ = (uu) & 3, t_ = opaque_tid(wave), srow = t_ >> 4, sch = t_ & 15; const size_t r0_ = (size_t)(jc_ * 64 + srow), r1_ = r0_ + 32; \
        gq0 = *(const u32x4*)(QKC + r0_ * 1024 + h_ * 128 + sch * 8);       gq1 = *(const u32x4*)(QKC + r1_ * 1024 + h_ * 128 + sch * 8); \
        gk0 = *(const u32x4*)(QKC + r0_ * 1024 + 512 + h_ * 128 + sch * 8); gk1 = *(const u32x4*)(QKC + r1_ * 1024 + 512 + h_ * 128 + sch * 8); \
        gv0 = *(const u32x4*)(PR + r0_ * PRJ_LD + PC_MV + h_ * 128 + sch * 8); gv1 = *(const u32x4*)(PR + r1_ * PRJ_LD + PC_MV + h_ * 128 + sch * 8); \
        { const bf16_t* cs_ = CST + (size_t)(uu) * 2 * 16384; \
          _Pragma("unroll") for (int i = 0; i < 4; ++i) { const int id = t_ + 512 * i; gc0[i] = *(const u32x4*)(cs_ + id * 8); gc1[i] = *(const u32x4*)(cs_ + 16384 + id * 8); } } \
        { const int d_ = t_ / 320, j_ = t_ % 320, hd_ = h_ * 2 + d_; \
          gs0 = j_ < 64 ? MSC[MSC_B + hd_ * MH + jc_ * 64 + j_] : j_ < 128 ? MSC[MSC_ICB + hd_ * MH + jc_ * 64 + j_ - 64] : j_ < 192 ? MSC[MSC_PMX + hd_ * MH + jc_ * 64 + j_ - 128] : NST[((size_t)(uu) * 2 + d_) * 128 + j_ - 192]; } \
        if (t_ < 128) gs1 = NST[((size_t)(uu) * 2 + 1) * 128 + t_]; } while (0)
#define MO_WRITE() do { const int t_ = opaque_tid(wave), srow = t_ >> 4, sch = t_ & 15; const unsigned so0 = off_a(srow, sch), so1 = off_a(srow + 32, sch); \
        *(LAS u32x4*)(Qt + so0) = gq0; *(LAS u32x4*)(Qt + so1) = gq1; *(LAS u32x4*)(Kt + so0) = gk0; *(LAS u32x4*)(Kt + so1) = gk1; *(LAS u32x4*)(Vt + so0) = gv0; *(LAS u32x4*)(Vt + so1) = gv1; \
        _Pragma("unroll") for (int i = 0; i < 4; ++i) { const int id = t_ + 512 * i, e = id >> 4, ch = id & 15; *(LAS u32x4*)(CT0 + off_a(e, ch)) = gc0[i]; *(LAS u32x4*)(CT0 + 32768 + off_a(e, ch)) = gc1[i]; } \
        SC[t_] = gs0; if (t_ < 128) SC[512 + t_] = gs1; } while (0)
    int u = blockIdx.x;
    if (u < NU) { MO_LOADS(u); MO_GATES(u); }
    for (; u < NU; u += gridDim.x) {
        const int jc = u >> 2, h = u & 3, row0 = jc * 64;
        MO_WRITE();
        const float m_prev0 = MSC[MSC_MPREV + (h * 2) * ML_NCH + jc], m_prev1 = MSC[MSC_MPREV + (h * 2 + 1) * ML_NCH + jc];
        __syncthreads();
        if (u + (int)gridDim.x < NU) MO_LOADS(u + (int)gridDim.x);
        f32x16 hsum;
#pragma unroll
        for (int r = 0; r < 16; ++r) hsum[r] = 0.f;
#pragma unroll 1
        for (int dir = 0; dir < 2; ++dir) {
            const LAS unsigned char* CT = CT0 + dir * 32768;
            const LAS float* SCb = SC + dir * 320; const LAS float* SCi = SCb + 64; const LAS float* SCp = SCb + 128; const LAS float* SCn = SCb + 192;
            const float m_prev = dir == 0 ? m_prev0 : m_prev1;
            f32x16 s0, s1;
#pragma unroll
            for (int r = 0; r < 16; ++r) { s0[r] = 0.f; s1[r] = 0.f; }
#pragma unroll
            for (int ks = 0; ks < 8; ++ks) { const bf16x8 bq = rowfrag(Qt + lb * 8192, 0, ks, fb); s0 = MFMA32(rowfrag(Kt, 0, ks, fb), bq, s0); s1 = MFMA32(rowfrag(Kt, 1, ks, fb), bq, s1); }
            int l_ = l; asm volatile("" : "+v"(l_));
            const float b_l = SCb[l], m_t = b_l + fmaxf(m_prev, SCp[l]), sint = __expf(b_l + m_prev - m_t), bm = b_l - m_t;
            float rs = 0.f;
#pragma unroll
            for (int r = 0; r < 16; ++r) {
                const int sa = crow(r, hi), sb = 32 + sa;
                const bool va = dir == 0 ? (sa <= l_) : (sa >= l_), vb = dir == 0 ? (sb <= l_) : (sb >= l_);
                const float ia = SCi[sa], ib = SCi[sb];
                s0[r] *= __expf(va ? bm + ia : -1e30f); s1[r] *= __expf(vb ? bm + ib : -1e30f);
                rs += s0[r] + s1[r];
            }
            rs = swap_add(rs);
            float qn = 0.f;
#pragma unroll
            for (int c = 0; c < 8; ++c) { float x[8]; unpack8(*(const LAS u32x4*)(Qt + off_a(l, 8 * hi + c)), x);
#pragma unroll
                for (int e = 0; e < 8; ++e) qn += x[e] * SCn[64 * hi + 8 * c + e]; }
            qn = swap_add(qn);
            const float den = fmaxf(fabsf(sint * qn + rs), __expf(-m_t)), dinv = 1.f / den;
            if (hi == 0) { wsx[r32] = sint * dinv; wsx[32 + r32] = dinv; }
            bf16x8 pa[4];
            PK4(s0, 0, pa[0]); PK4(s0, 8, pa[1]); PK4(s1, 0, pa[2]); PK4(s1, 8, pa[3]);
            f32x16 ao, ai;
#pragma unroll
            for (int r = 0; r < 16; ++r) { ao[r] = 0.f; ai[r] = 0.f; }
#pragma unroll
            for (int ks = 0; ks < 4; ++ks) ao = MFMA32(pa[ks], trfrag(Vt + eb * 512, 0, ks, fb), ao);
#pragma unroll
            for (int ks = 0; ks < 8; ++ks) ai = MFMA32(rowfrag(Qt + lb * 8192, 0, ks, fb), rowfrag(CT + eb * 8192, 0, ks, fb), ai);
#pragma unroll
            for (int r = 0; r < 16; ++r) { const int lr = crow(r, hi); hsum[r] += ai[r] * wsx[lr] + ao[r] * wsx[32 + lr]; }
        }
        __syncthreads();
#pragma unroll
        for (int r = 0; r < 16; ++r) HS[(32 * lb + crow(r, hi)) * 132 + 32 * eb + r32] = hsum[r];
        __syncthreads();
        { const f32x2 gg = *(const f32x2*)(normg + h * 128 + 2 * lane);
#pragma unroll
          for (int i = 0; i < 8; ++i) {
            const int row = wave * 8 + i;
            const f32x2 v = *(const LAS f32x2*)(HS + row * 132 + 2 * lane);
            const float rr = 1.f / sqrtf(wave_sum(v.x * v.x + v.y * v.y) * (1.f / 128.f) + NORM_EPS);
            const float o0 = __builtin_bit_cast(float, go[i] << 16), o1 = __builtin_bit_cast(float, go[i] & 0xffff0000u);
            *(unsigned*)(MIXh + (size_t)(row0 + row) * DM + h * 128 + 2 * lane) = pk2(v.x * rr * gg.x / (1.f + __expf(-o0)), v.y * rr * gg.y / (1.f + __expf(-o1)));
          } }
        __syncthreads();
        if (u + (int)gridDim.x < NU) MO_GATES(u + (int)gridDim.x);
    }
#undef MO_LOADS
#undef MO_WRITE
#undef MO_GATES
}

constexpr size_t W_LBL = W_GLU + 512 * 1024;
__device__ __forceinline__ void s5_build_phase(const Frame& F0, int layer, const float* const* in, bf16_t* MR, bf16_t* PM, float* LBL) {
    PHASE_FRAME(F0);
    const int tid = F.tid;
    LAS float* PWr = (LAS float*)F.lds; LAS float* PWi = PWr + 2 * 34 * 64;
    LAS float* BBr = PWi + 2 * 34 * 64; LAS float* BBi = BBr + 2 * 64 * 16;
    LAS float* CCr = BBi + 2 * 64 * 16; LAS float* CCi = CCr + 16 * 64;
    LAS float* KT = CCi + 16 * 64;
    for (int ug = blockIdx.x; ug < 256; ug += gridDim.x) {
        const int g = ug >> 3, part = ug & 7;
        const float* lre = in[15] + (size_t)layer * 2 * 32 * 64; const float* lim = in[16] + (size_t)layer * 2 * 32 * 64; const float* lst = in[17] + layer * 2 * 32;
        const float* bre = in[18] + ((size_t)layer * 32 + g) * 64 * 16; const float* bim = in[19] + ((size_t)layer * 32 + g) * 64 * 16;
        const float* cre = in[20] + ((size_t)layer * 32 + g) * 16 * 64; const float* cim = in[21] + ((size_t)layer * 32 + g) * 16 * 64;
        const float* dsk = in[22] + ((size_t)layer * 32 + g) * 16;
        for (int idx = tid; idx < 2 * 34 * 64; idx += NWAVES * 64) {
            const int dir = idx / (34 * 64), tau = (idx / 64) % 34, p = idx & 63;
            const float st = expf(lst[dir * 32 + g]), x = lre[(dir * 32 + g) * 64 + p] * st * (float)tau, y = lim[(dir * 32 + g) * 64 + p] * st * (float)tau;
            float sn, cs; sincosf(y, &sn, &cs); const float ex = expf(x);
            PWr[idx] = ex * cs; PWi[idx] = ex * sn;
        }
        for (int idx = tid; idx < 2 * 64 * 16; idx += NWAVES * 64) {
            const int dir = idx >> 10, p = (idx >> 4) & 63, c = idx & 15;
            const float lr = lre[(dir * 32 + g) * 64 + p], li = lim[(dir * 32 + g) * 64 + p], st = expf(lst[dir * 32 + g]), x = lr * st, y = li * st;
            float sn, cs; sincosf(y, &sn, &cs); float sh, ch; sincosf(0.5f * y, &sh, &ch);
            const float er = expm1f(x) * cs - 2.f * sh * sh, ei = expf(x) * sn;
            const float dn = 1.f / (lr * lr + li * li), qr = (er * lr + ei * li) * dn, qi = (ei * lr - er * li) * dn;
            const float br = bre[p * 16 + c], bi = bim[p * 16 + c];
            BBr[idx] = qr * br - qi * bi; BBi[idx] = qr * bi + qi * br;
        }
        for (int idx = tid; idx < 16 * 64; idx += NWAVES * 64) { CCr[idx] = cre[idx]; CCi[idx] = cim[idx]; }
        __syncthreads();
        for (int idx = tid; idx < 2 * 32 * 16; idx += NWAVES * 64) {
            const int dir = idx >> 9, tau = (idx >> 4) & 31, c = idx & 15;
            f32x4 a0 = {0.f, 0.f, 0.f, 0.f}, a1 = a0, a2 = a0, a3 = a0;
            for (int p = 0; p < 64; ++p) {
                const float pr = PWr[(dir * 34 + tau) * 64 + p], pi = PWi[(dir * 34 + tau) * 64 + p], cr = CCr[c * 64 + p], ci = CCi[c * 64 + p];
                const float wr = cr * pr - ci * pi, wi = cr * pi + ci * pr;
                const LAS f32x4* br = (const LAS f32x4*)(BBr + (dir * 64 + p) * 16); const LAS f32x4* bi = (const LAS f32x4*)(BBi + (dir * 64 + p) * 16);
                a0 += br[0] * wr - bi[0] * wi; a1 += br[1] * wr - bi[1] * wi; a2 += br[2] * wr - bi[2] * wi; a3 += br[3] * wr - bi[3] * wi;
            }
            LAS f32x4* kt = (LAS f32x4*)(KT + ((dir * 32 + tau) * 16 + c) * 16);
            kt[0] = a0; kt[1] = a1; kt[2] = a2; kt[3] = a3;
        }
        __syncthreads();
        bf16_t* mr = MR + (size_t)g * 512 * S5K;
        for (int idx = tid; idx < 64 * (S5K / 2); idx += NWAVES * 64) {
            const int row = part * 64 + idx / (S5K / 2), col = (idx % (S5K / 2)) * 2, i = row >> 4, c = row & 15;
            float v[2];
#pragma unroll
            for (int e = 0; e < 2; ++e) {
                const int cc = col + e;
                if (cc < 512) {
                    const int k = cc >> 4, c2 = cc & 15; float a = 0.f;
                    if (k <= i) a += KT[((0 * 32 + (i - k)) * 16 + c) * 16 + c2];
                    if (k >= i) a += KT[((1 * 32 + (k - i)) * 16 + c) * 16 + c2];
                    if (k == i && c == c2) a += dsk[c];
                    v[e] = a;
                } else {
                    const int x = cc - 512, dir = x >> 7, p = (x >> 1) & 63, ri = x & 1, tau = dir == 0 ? i + 1 : S5L - i;
                    const float pr = PWr[(dir * 34 + tau) * 64 + p], pi = PWi[(dir * 34 + tau) * 64 + p], cr = CCr[c * 64 + p], ci = CCi[c * 64 + p];
                    v[e] = ri == 0 ? (cr * pr - ci * pi) : -(cr * pi + ci * pr);
                }
            }
            *(unsigned*)(mr + (size_t)row * S5K + col) = pk2(v[0], v[1]);
        }
        bf16_t* pm = PM + (size_t)g * 256 * 512;
        for (int idx = tid; idx < 32 * 256; idx += NWAVES * 64) {
            const int n = part * 32 + (idx >> 8), col = (idx & 255) * 2, dir = n >> 7, p = (n >> 1) & 63, ri = n & 1;
            float v[2];
#pragma unroll
            for (int e = 0; e < 2; ++e) {
                const int cc = col + e, k = cc >> 4, c2 = cc & 15, tau = dir == 0 ? S5L - 1 - k : k;
                const float pr = PWr[(dir * 34 + tau) * 64 + p], pi = PWi[(dir * 34 + tau) * 64 + p], br = BBr[(dir * 64 + p) * 16 + c2], bi = BBi[(dir * 64 + p) * 16 + c2];
                v[e] = ri == 0 ? (pr * br - pi * bi) : (pr * bi + pi * br);
            }
            *(unsigned*)(pm + (size_t)n * 512 + col) = pk2(v[0], v[1]);
        }
        if (part == 0 && tid < 128) { const int dir = tid >> 6, p = tid & 63; LBL[((g * 2 + dir) * 64 + p) * 2] = PWr[(dir * 34 + S5L) * 64 + p]; LBL[((g * 2 + dir) * 64 + p) * 2 + 1] = PWi[(dir * 34 + S5L) * 64 + p]; }
        __syncthreads();
    }
}
namespace pg8 {
struct S5OrderA { int G, c;
    __device__ bool next(int i, Unit& u) const { const int L = i * G + c; if (L >= 96) return false; const int g = L / 3; u.pm = L; u.pn = g; return true; }
    __device__ __forceinline__ void a_ready(const Unit&) const {} __device__ __forceinline__ void done(const Unit&) const {} };
struct S5OrderB { int G, c;
    __device__ bool next(int i, Unit& u) const { const int L = i * G + c; if (L >= 192) return false; const int g = L / 6, r = L % 6; u.pm = g * 3 + r % 3; u.pn = g * 2 + r / 3; return true; }
    __device__ __forceinline__ void a_ready(const Unit&) const {} __device__ __forceinline__ void done(const Unit&) const {} };
struct EpiS5E {
    static constexpr bool PERM = true; float* E;
    __device__ __forceinline__ void operator()(const f32x4 (&acc)[2][2][4][2], const Unit& u, int wr, int wc, int fr, int fq) const {
        const int row0 = u.pm * BM + wr * 64 + fr, col0 = wc * 32 + 8 * fq;
#pragma unroll
        for (int ai = 0; ai < 2; ++ai)
#pragma unroll
            for (int m = 0; m < 4; ++m) { float* rowp = E + (size_t)(row0 + ai * HALF + m * 16) * 256 + col0;
#pragma unroll
                for (int bj = 0; bj < 2; ++bj) { *(f32x4*)(rowp + bj * HALF) = acc[ai][bj][m][0]; *(f32x4*)(rowp + bj * HALF + 4) = acc[ai][bj][m][1]; } }
    }
};
__device__ __forceinline__ float gelu_tanh(float x) { const float t = 1.5957691216057308f * (x + 0.044715f * x * x * x); return x * __builtin_amdgcn_rcpf(1.f + __expf(-t)); }
struct EpiS5Z {
    static constexpr bool PERM = true; bf16_t* Z;
    __device__ __forceinline__ void operator()(const f32x4 (&acc)[2][2][4][2], const Unit& u, int wr, int wc, int fr, int fq) const {
        const int g = u.pn >> 1, row0 = u.pm * BM + wr * 64 + fr - g * S5NCH;
#pragma unroll
        for (int ai = 0; ai < 2; ++ai)
#pragma unroll
            for (int m = 0; m < 4; ++m) { const int chunk = row0 + ai * HALF + m * 16;
#pragma unroll
                for (int bj = 0; bj < 2; ++bj) { const int col = (u.pn & 1) * BM + bj * HALF + wc * 32 + 8 * fq, i = col >> 4, c0 = col & 15;
                    const f32x4 v0 = acc[ai][bj][m][0], v1 = acc[ai][bj][m][1];
                    u32x4 w; w.x = cvt_pk_bf16(gelu_tanh(v0[0]), gelu_tanh(v0[1])); w.y = cvt_pk_bf16(gelu_tanh(v0[2]), gelu_tanh(v0[3]));
                    w.z = cvt_pk_bf16(gelu_tanh(v1[0]), gelu_tanh(v1[1])); w.w = cvt_pk_bf16(gelu_tanh(v1[2]), gelu_tanh(v1[3]));
                    *(u32x4*)(Z + (size_t)(chunk * S5L + i) * GWID + 16 * g + c0) = w; } }
    }
};
struct EpiGlu {
    static constexpr bool PERM = true; const bf16_t* Z; const float* bias; bf16_t* O;
    __device__ __forceinline__ void operator()(const f32x4 (&acc)[2][2][4][2], const Unit& u, int wr, int wc, int fr, int fq) const {
        const int row0 = u.pm * BM + wr * 64 + fr, col0 = u.pn * BM + wc * 32 + 8 * fq;
#pragma unroll
        for (int ai = 0; ai < 2; ++ai)
#pragma unroll
            for (int m = 0; m < 4; ++m) { const size_t row = (size_t)(row0 + ai * HALF + m * 16);
#pragma unroll
                for (int bj = 0; bj < 2; ++bj) { const int col = col0 + bj * HALF;
                    const u32x4 zz = *(const u32x4*)(Z + row * GWID + col);
                    const f32x4 b0 = *(const f32x4*)(bias + col), b1 = *(const f32x4*)(bias + col + 4);
                    const f32x4 v0 = acc[ai][bj][m][0] + b0, v1 = acc[ai][bj][m][1] + b1;
                    float z[8];
#pragma unroll
                    for (int e = 0; e < 4; ++e) { z[2 * e] = __builtin_bit_cast(float, zz[e] << 16); z[2 * e + 1] = __builtin_bit_cast(float, zz[e] & 0xffff0000u); }
                    u32x4 w;
                    w.x = cvt_pk_bf16(z[0] * __builtin_amdgcn_rcpf(1.f + __expf(-v0[0])), z[1] * __builtin_amdgcn_rcpf(1.f + __expf(-v0[1])));
                    w.y = cvt_pk_bf16(z[2] * __builtin_amdgcn_rcpf(1.f + __expf(-v0[2])), z[3] * __builtin_amdgcn_rcpf(1.f + __expf(-v0[3])));
                    w.z = cvt_pk_bf16(z[4] * __builtin_amdgcn_rcpf(1.f + __expf(-v1[0])), z[5] * __builtin_amdgcn_rcpf(1.f + __expf(-v1[1])));
                    w.w = cvt_pk_bf16(z[6] * __builtin_amdgcn_rcpf(1.f + __expf(-v1[2])), z[7] * __builtin_amdgcn_rcpf(1.f + __expf(-v1[3])));
                    *(u32x4*)(O + row * DM + 1536 + col) = w; } }
    }
};
}
__device__ __forceinline__ void s5_scan_phase(const Frame& F0, int half, const float* E, const float* LBL, bf16_t* UG) {
    PHASE_FRAME(F0);
    const int gt = F.vcu * (NWAVES * 64) + F.tid, NT = F.G * NWAVES * 64;
    const int nseq = half == 0 ? 4 : 6;
    for (int it = gt; it < nseq * 4096; it += NT) {
        const int s = it >> 12, g = (it >> 7) & 31, dir = (it >> 6) & 1, p = it & 63;
        const int row0 = half == 0 ? (s < 2 ? s * 8192 : 16384 + (s - 2) * 4096) : s * 4096, T = (half == 0 && s < 2) ? 8192 : 4096;
        const int c0 = row0 / S5L, ncs = T / S5L;
        const float ar = LBL[((g * 2 + dir) * 64 + p) * 2], ai = LBL[((g * 2 + dir) * 64 + p) * 2 + 1];
        float sr = 0.f, si = 0.f;
        for (int j0 = 0; j0 < ncs; j0 += 32) {
            f32x2 ev[32];
#pragma unroll
            for (int q = 0; q < 32; ++q) { const int ch = dir == 0 ? c0 + j0 + q : c0 + ncs - 1 - (j0 + q); ev[q] = *(const f32x2*)(E + ((size_t)g * S5NCH + ch) * 256 + dir * 128 + 2 * p); }
#pragma unroll
            for (int q = 0; q < 32; ++q) { const int ch = dir == 0 ? c0 + j0 + q : c0 + ncs - 1 - (j0 + q);
                *(unsigned*)(UG + ((size_t)g * S5NCH + ch) * S5K + 512 + dir * 128 + 2 * p) = pk2(sr, si);
                const float nr = ar * sr - ai * si + ev[q][0], ni = ar * si + ai * sr + ev[q][1]; sr = nr; si = ni; }
        }
    }
}

__device__ __forceinline__ void na_phase(const Frame& F0, int half, const bf16_t* PR, const float* rpb, bf16_t* MIXh) {
    PHASE_FRAME(F0);
    const int tid = F.tid, lane = F.lane, wave = F.wave, r32 = lane & 31, hi = lane >> 5;
    LAS unsigned char* Qt = F.lds; LAS unsigned char* Kt = F.lds + 32768; LAS unsigned char* Vt = F.lds + 65536;
    LAS float* RP = (LAS float*)(F.lds + 98304);
    LAS float* wsx = (LAS float*)(F.lds + 114688 + wave * 256);
    const int hl = wave >> 1, qb = wave & 1, qc = 32 * qb + r32, cs = min(max(qc - 8, 0), 48);
    const FragBase fb = make_fragbase(lane);
    constexpr float QS2 = 0.125f * 1.4426950408889634f, LOG2E = 1.4426950408889634f;
    { const int t1 = opaque_tid(wave); for (int i = t1; i < 8 * 465; i += NWAVES * 64) RP[i] = rpb[i]; }
    for (int u = F.vcu; u < (MH / 64) * 2; u += gridDim.x) {
        const int gr = u >> 1, hq = u & 1;
        int row0, r, rows;
        if (half == 0) { if (gr < 256) { row0 = (gr >> 7) * 8192; r = gr & 127; rows = 128; } else { const int g2 = gr - 256; row0 = 16384 + (g2 >> 6) * 4096; r = g2 & 63; rows = 64; } }
        else { row0 = (gr >> 6) * 4096; r = gr & 63; rows = 64; }
        const int rs = min(max(r - 4, 0), rows - 8);
        { const int t2 = opaque_tid(wave);
#pragma unroll
        for (int i = 0; i < 4; ++i) { const int id = t2 + 512 * i, row = id >> 5, c32 = id & 31;
            *(LAS u32x4*)(Qt + (c32 >> 4) * 16384 + off_a(row, c32 & 15)) = *(const u32x4*)(PR + (size_t)(row0 + r * 64 + row) * PRJ_LD + PC_NQ + hq * 256 + c32 * 8); }
        }
        u32x4 kA[4], vA[4], kB[4], vB[4];
#define NA_LOAD(KS, VS, kr) do { _Pragma("unroll") for (int i = 0; i < 4; ++i) { const int id = tid + 512 * i, row = id >> 5, c32 = id & 31; \
            const bf16_t* gp = PR + (size_t)(row0 + (rs + (kr)) * 64 + row) * PRJ_LD + hq * 256 + c32 * 8; KS[i] = *(const u32x4*)(gp + PC_NK); VS[i] = *(const u32x4*)(gp + PC_NV); } } while (0)
#define NA_WRITE(KS, VS) do { _Pragma("unroll") for (int i = 0; i < 4; ++i) { const int id = tid + 512 * i, row = id >> 5, c32 = id & 31; const unsigned o_ = (c32 >> 4) * 16384 + off_a(row, c32 & 15); \
            *(LAS u32x4*)(Kt + o_) = KS[i]; *(LAS u32x4*)(Vt + o_) = VS[i]; } } while (0)
        NA_LOAD(kA, vA, 0); NA_LOAD(kB, vB, 1);
        float m_run = -1e30f, l_run = 0.f;
        f32x16 o[2];
#pragma unroll
        for (int r_ = 0; r_ < 16; ++r_) { o[0][r_] = 0.f; o[1][r_] = 0.f; }
        bf16x8 qf[4];
#pragma unroll 1
        for (int kr = 0; kr < 8; kr += 2) {
            NA_WRITE(kA, vA);
            __syncthreads();
            if (kr == 0) {
#pragma unroll
                for (int kk = 0; kk < 4; ++kk) qf[kk] = rowfrag(Qt + (hl >> 1) * 16384 + qb * 8192 + (hl & 1) * 1024, 0, kk, fb);
            }
            if (kr + 2 < 8) NA_LOAD(kA, vA, kr + 2);
            {
            const LAS unsigned char* Kh = Kt + (hl >> 1) * 16384 + (hl & 1) * 1024; const LAS unsigned char* Vh = Vt + (hl >> 1) * 16384 + (hl & 1) * 1024;
            f32x16 p0, p1;
#pragma unroll
            for (int r_ = 0; r_ < 16; ++r_) { p0[r_] = 0.f; p1[r_] = 0.f; }
#pragma unroll
            for (int kk = 0; kk < 4; ++kk) { p0 = MFMA32(rowfrag(Kh, 0, kk, fb), qf[kk], p0); p1 = MFMA32(rowfrag(Kh, 1, kk, fb), qf[kk], p1); }
            const LAS float* rp = RP + (hq * 4 + hl) * 465 + (rs + (kr) - r + 7) * 31;
            int bq_ = 15 - qc; asm volatile("" : "+v"(bq_));
            int cs_ = cs; asm volatile("" : "+v"(cs_));
            float pmax = -1e30f;
#pragma unroll
            for (int r_ = 0; r_ < 16; ++r_) {
                const int ka = crow(r_, hi), kb = 32 + ka;
                const bool va = (unsigned)(ka - cs_) < 16u, vb = (unsigned)(kb - cs_) < 16u;
                const float ba = rp[min(max(ka + bq_, 0), 30)], bb = rp[min(max(kb + bq_, 0), 30)];
                p0[r_] = va ? p0[r_] * QS2 + ba * LOG2E : -1e30f; p1[r_] = vb ? p1[r_] * QS2 + bb * LOG2E : -1e30f;
                pmax = fmaxf(pmax, fmaxf(p0[r_], p1[r_]));
            }
            pmax = swap_max(pmax);
            const float mn = fmaxf(m_run, pmax), alpha = __builtin_amdgcn_exp2f(m_run - mn); m_run = mn;
            float ps = 0.f;
#pragma unroll
            for (int r_ = 0; r_ < 16; ++r_) { p0[r_] = __builtin_amdgcn_exp2f(p0[r_] - mn); p1[r_] = __builtin_amdgcn_exp2f(p1[r_] - mn); ps += p0[r_] + p1[r_]; }
            ps = swap_add(ps); l_run = l_run * alpha + ps;
            if (hi == 0) wsx[r32] = alpha;
#pragma unroll
            for (int r_ = 0; r_ < 16; ++r_) { const float al = wsx[crow(r_, hi)]; o[0][r_] *= al; o[1][r_] *= al; }
            bf16x8 pa[4];
            PK4(p0, 0, pa[0]); PK4(p0, 8, pa[1]); PK4(p1, 0, pa[2]); PK4(p1, 8, pa[3]);
#pragma unroll
            for (int d = 0; d < 2; ++d)
#pragma unroll
                for (int ks = 0; ks < 4; ++ks) o[d] = MFMA32(pa[ks], trfrag(Vh, d, ks, fb), o[d]);
            }
            __syncthreads();
            NA_WRITE(kB, vB);
            __syncthreads();
            if (kr + 3 < 8) NA_LOAD(kB, vB, kr + 3);
            {
            const LAS unsigned char* Kh = Kt + (hl >> 1) * 16384 + (hl & 1) * 1024; const LAS unsigned char* Vh = Vt + (hl >> 1) * 16384 + (hl & 1) * 1024;
            f32x16 p0, p1;
#pragma unroll
            for (int r_ = 0; r_ < 16; ++r_) { p0[r_] = 0.f; p1[r_] = 0.f; }
#pragma unroll
            for (int kk = 0; kk < 4; ++kk) { p0 = MFMA32(rowfrag(Kh, 0, kk, fb), qf[kk], p0); p1 = MFMA32(rowfrag(Kh, 1, kk, fb), qf[kk], p1); }
            const LAS float* rp = RP + (hq * 4 + hl) * 465 + (rs + (kr + 1) - r + 7) * 31;
            int bq_ = 15 - qc; asm volatile("" : "+v"(bq_));
            int cs_ = cs; asm volatile("" : "+v"(cs_));
            float pmax = -1e30f;
#pragma unroll
            for (int r_ = 0; r_ < 16; ++r_) {
                const int ka = crow(r_, hi), kb = 32 + ka;
                const bool va = (unsigned)(ka - cs_) < 16u, vb = (unsigned)(kb - cs_) < 16u;
                const float ba = rp[min(max(ka + bq_, 0), 30)], bb = rp[min(max(kb + bq_, 0), 30)];
                p0[r_] = va ? p0[r_] * QS2 + ba * LOG2E : -1e30f; p1[r_] = vb ? p1[r_] * QS2 + bb * LOG2E : -1e30f;
                pmax = fmaxf(pmax, fmaxf(p0[r_], p1[r_]));
            }
            pmax = swap_max(pmax);
            const float mn = fmaxf(m_run, pmax), alpha = __builtin_amdgcn_exp2f(m_run - mn); m_run = mn;
            float ps = 0.f;
#pragma unroll
            for (int r_ = 0; r_ < 16; ++r_) { p0[r_] = __builtin_amdgcn_exp2f(p0[r_] - mn); p1[r_] = __builtin_amdgcn_exp2f(p1[r_] - mn); ps += p0[r_] + p1[r_]; }
            ps = swap_add(ps); l_run = l_run * alpha + ps;
            if (hi == 0) wsx[r32] = alpha;
#pragma unroll
            for (int r_ = 0; r_ < 16; ++r_) { const float al = wsx[crow(r_, hi)]; o[0][r_] *= al; o[1][r_] *= al; }
            bf16x8 pa[4];
            PK4(p0, 0, pa[0]); PK4(p0, 8, pa[1]); PK4(p1, 0, pa[2]); PK4(p1, 8, pa[3]);
#pragma unroll
            for (int d = 0; d < 2; ++d)
#pragma unroll
                for (int ks = 0; ks < 4; ++ks) o[d] = MFMA32(pa[ks], trfrag(Vh, d, ks, fb), o[d]);
            }
            __syncthreads();
        }
        if (hi == 0) wsx[32 + r32] = l_run;
        const int head = hq * 4 + hl;
#pragma unroll
        for (int r_ = 0; r_ < 16; ++r_) { const int q = 32 * qb + crow(r_, hi); const float rl = 1.f / wsx[32 + crow(r_, hi)];
            bf16_t* op = MIXh + (size_t)(row0 + r * 64 + q) * DM + 1024 + head * 64;
            op[r32] = (bf16_t)f2bf(o[0][r_] * rl); op[32 + r32] = (bf16_t)f2bf(o[1][r_] * rl); }
#undef NA_LOAD
#undef NA_WRITE
    }
}

__device__ __forceinline__ void zero_mixed_cols(const Frame& F0, bf16_t* MIXh, int c0) {
    PHASE_FRAME(F0);
    const long gt = (long)F.vcu * (NWAVES * 64) + F.tid, NT = (long)F.G * NWAVES * 64;
    for (long it = gt; it < (long)MH * 64; it += NT) { const int row = (int)(it >> 6), ch = (int)(it & 63);
        *(u32x4*)(MIXh + (size_t)row * DM + c0 + ch * 8) = (u32x4){0u, 0u, 0u, 0u}; }
}

#ifndef EN_DIFF
#define EN_DIFF 1
#endif
#ifndef EN_MLSTM
#define EN_MLSTM 1
#endif
#ifndef EN_NA
#define EN_NA 1
#endif
#ifndef EN_S5
#define EN_S5 1
#endif
struct Args { const float* in[31]; float* out; unsigned char* ws; int ph_lo, ph_hi; };
constexpr size_t SZ_WGATE = (size_t)DM * DFF, SZ_WDOWN = (size_t)DFF * DM;

__global__ void __launch_bounds__(NWAVES * 64, 2) mk_fwd(Args args) {
    extern __shared__ __attribute__((aligned(16))) unsigned char lds_raw[];
    Frame F;
    F.lds = (LAS unsigned char*)lds_raw;
    F.MISC = (volatile LAS unsigned*)(F.lds + MISC_OFF);
    F.tid = threadIdx.x; F.lane = F.tid & 63; F.wave = __builtin_amdgcn_readfirstlane(F.tid >> 6);
    F.G = gridDim.x; { const int bx = blockIdx.x; F.vcu = (F.G % 8 == 0) ? (bx % 8) * (F.G / 8) + bx / 8 : bx; }
    unsigned char* ws = args.ws;
    unsigned* ctl = (unsigned*)(ws + WS_CTL);
    for (int u = F.tid; u < (LDS_BYTES - LDSCTL_OFF) / 4; u += NWAVES * 64) ((LAS unsigned*)(F.lds + LDSCTL_OFF))[u] = 0u;
    __syncthreads();
    XcdBarrier bar = xcd_barrier_post(ctl + CW_BAR, F.MISC + 8);
    const int lo = args.ph_lo, hi = args.ph_hi;
    int ph = 0;
#define IN_PH() (lo <= ph && ph < hi)
#define END_PH() do { if (lo <= ph && ph + 1 < hi) xcd_barrier(bar, F.wave); ++ph; } while (0)

    float* X = args.out;
    _Float16* XH = (_Float16*)((unsigned char*)args.out + (size_t)MTOT * DM * 2);
    bf16_t* XN = (bf16_t*)(ws + WS_XN);
    bf16_t* HB = (bf16_t*)(ws + WS_BIG);
    bf16_t* PROJ = (bf16_t*)(ws + MX_PROJ);
    bf16_t* UG = (bf16_t*)(ws + MX_UG);
    float* GATES = (float*)(ws + MX_GATES);
    float* ROPE = (float*)(ws + WS_ROPE);
    float* S5E = (float*)(ws + MX_E); bf16_t* S5Z = (bf16_t*)(ws + MX_Z);
    bf16_t* QKC = (bf16_t*)(ws + MX_QKC); bf16_t* CST = (bf16_t*)(ws + MX_CST); float* NST = (float*)(ws + MX_NST); float* MSC = (float*)(ws + MX_MSC);

{ constexpr int layer = 0;
        if (IN_PH()) {
{ constexpr int rep = 0;
            convert_ffn_weights(F, args.in[3] + layer * SZ_WGATE, args.in[4] + layer * SZ_WGATE, args.in[5] + layer * SZ_WDOWN, (bf16_t*)(ws + W_GU1), (bf16_t*)(ws + W_D1));
            convert_ffn_weights(F, args.in[27] + layer * SZ_WGATE, args.in[28] + layer * SZ_WGATE, args.in[29] + layer * SZ_WDOWN, (bf16_t*)(ws + W_GU2), (bf16_t*)(ws + W_D2));
            convert_mixer_weights(F, args.in[7] + (size_t)layer * DM * IN_W, args.in[25] + (size_t)layer * DM * DM, args.in[23] + (size_t)layer * GWID * GWID,
                                  (bf16_t*)(ws + W_IN), (bf16_t*)(ws + W_OUT), (bf16_t*)(ws + W_GLU));
}
            if (layer == 0) rope_table_phase(F, ROPE);
            __syncthreads();
{ constexpr int rep = 0;
            if (EN_S5) s5_build_phase(F, layer, args.in, (bf16_t*)(ws + W_S5MR), (bf16_t*)(ws + W_S5P), (float*)(ws + W_LBL));
}
            if (layer == 0) rms_phase(F, args.in[0], args.in[1], nullptr, nullptr, nullptr, args.in[2] + layer * DM, XN, nullptr);
            else rms_phase(F, nullptr, nullptr, XH, XN, XN, args.in[2] + layer * DM, XN, XH);
        }
        END_PH();
{ constexpr int f = 0;
            if (f == 1) {
            if (IN_PH()) rms_phase(F, nullptr, nullptr, XH, (const bf16_t*)(ws + WS_SPARE), HB, args.in[26] + layer * DM, XN, XH);
            END_PH();
            }
            if (IN_PH()) {
{ constexpr int rep = 0;
                pg8::Gemm g{XN, (const bf16_t*)(ws + (f == 0 ? W_GU1 : W_GU2)), DM, DM, DM};
                pg8::StaticOrder S; S.init(MTOT / 256, 2 * DFF / 256, F.G, (int)blockIdx.x, 32);
                pg8::EpiSwiglu E{HB, DFF};
                pg8::gemm_phase<pg8::EpiSwiglu, pg8::StaticOrder, true, true>(F.lds, g, S, E, F.wave);
}
            }
            END_PH();
            if (IN_PH()) {
{ constexpr int rep = 0;
                pg8::Gemm g{HB, (const bf16_t*)(ws + (f == 0 ? W_D1 : W_D2)), DFF, DFF, DFF};
                pg8::StaticOrder S; S.init(MTOT / 256, DM / 256, F.G, (int)blockIdx.x, 4, 0);
                pg8::EpiDelta E{XN, DM, 0.5f};
                pg8::gemm_phase<pg8::EpiDelta, pg8::StaticOrder, true, true>(F.lds, g, S, E, F.wave);
}
            }
            END_PH();
            if (f == 0) {
                if (IN_PH()) { if (layer == 0) rms_phase(F, args.in[0], args.in[1], nullptr, XN, XN, args.in[6] + layer * DM, XN, XH);
                    else rms_phase(F, nullptr, nullptr, XH, XN, XN, args.in[6] + layer * DM, XN, XH); }
                END_PH();
{ constexpr int half = 0;
                    bf16_t* MIXh = XN + (size_t)half * MH * DM;
                    if (IN_PH()) {
{ constexpr int rep = 0;
                        pg8::Gemm g{XN + (size_t)half * MH * DM, (const bf16_t*)(ws + W_IN), DM, DM, DM};
                        pg8::StaticOrder S; S.init(MH / 256, IN_WP / 256, F.G, (int)blockIdx.x, 32);
                        pg8::EpiInProj E{PROJ, UG, GATES, args.in[10] + layer * 16, ROPE, half};
                        pg8::gemm_phase<pg8::EpiInProj, pg8::StaticOrder, true, true>(F.lds, g, S, E, F.wave);
}
                        if (half == 1) {
                            pg8::Gemm g0{XN, (const bf16_t*)(ws + W_OUT), DM, DM, DM};
                            pg8::StaticOrder S0; S0.init(MH / 256, DM / 256, F.G, (int)blockIdx.x, 32);
                            pg8::EpiDelta E0{(bf16_t*)(ws + WS_SPARE), DM, 1.0f};
                            pg8::gemm_phase<pg8::EpiDelta, pg8::StaticOrder, true, true>(F.lds, g0, S0, E0, F.wave);
                        }
                    }
                    END_PH();
                    if (IN_PH()) {
{ constexpr int rep = 0;
                        if (EN_MLSTM) { mlstm_conv_phase(F, half, PROJ, QKC, args.in[8] + layer * 5 * 1024, args.in[9] + layer * 1024); mlstm_scalar_phase(F, GATES, MSC); }
}
                        if (!EN_MLSTM) zero_mixed_cols(F, MIXh, 0);
                        if (!EN_DIFF) zero_mixed_cols(F, MIXh, 512);
                        if (!EN_NA) zero_mixed_cols(F, MIXh, 1024);
                        if (!EN_S5) zero_mixed_cols(F, MIXh, 1536);
                        if (EN_S5) { __syncthreads();
                            pg8::Gemm g{UG, (const bf16_t*)(ws + W_S5P), 512, S5K, 512}; pg8::S5OrderA S{F.G, (int)blockIdx.x}; pg8::EpiS5E E{S5E};
                            pg8::gemm_phase<pg8::EpiS5E, pg8::S5OrderA, true, true>(F.lds, g, S, E, F.wave); }
                    }
                    END_PH();
                    if (IN_PH()) {
{ constexpr int rep = 0;
                        if (EN_S5) s5_scan_phase(F, half, S5E, (const float*)(ws + W_LBL), UG);
}
{ constexpr int rep = 0;
                        if (EN_NA) { na_phase(F, half, PROJ, args.in[14] + (size_t)layer * 8 * 465, MIXh); __syncthreads(); }
}
{ constexpr int rep = 0;
                        if (EN_MLSTM) mlstm_state_phase(F, PROJ, QKC, MSC, CST, NST);
}
                    }
                    END_PH();
                    if (IN_PH()) {
                        if (EN_MLSTM) mlstm_scan_phase(F, half, MSC, CST, NST);
{ constexpr int rep = 0;
                        if (EN_S5) { pg8::Gemm g{UG, (const bf16_t*)(ws + W_S5MR), S5K, S5K, S5K}; pg8::S5OrderB S{F.G, (int)blockIdx.x}; pg8::EpiS5Z E{S5Z};
                            pg8::gemm_phase<pg8::EpiS5Z, pg8::S5OrderB, true, true>(F.lds, g, S, E, F.wave); __syncthreads(); }
}
{ constexpr int rep = 0;
                        if (EN_DIFF) diffattn_phase(F, half, layer, PROJ, MIXh, args.in[12] + layer * 256, args.in[13] + layer * 128);
}
                    }
                    END_PH();
                    if (IN_PH()) {
{ constexpr int rep = 0;
                        if (EN_MLSTM) mlstm_out_phase(F, PROJ, QKC, MSC, CST, NST, args.in[11] + layer * GWID, MIXh);
}
                        if (EN_S5) { __syncthreads();
                            pg8::Gemm g{S5Z, (const bf16_t*)(ws + W_GLU), GWID, GWID, GWID}; pg8::StaticOrder S; S.init(MH / 256, GWID / 256, F.G, (int)blockIdx.x);
                            pg8::EpiGlu E{S5Z, args.in[24] + layer * GWID, MIXh};
                            pg8::gemm_phase<pg8::EpiGlu, pg8::StaticOrder, true, true>(F.lds, g, S, E, F.wave); }
                    }
                    END_PH();
                    if (half == 1) {
                    if (IN_PH()) {
                        pg8::Gemm g{MIXh, (const bf16_t*)(ws + W_OUT), DM, DM, DM};
                        pg8::StaticOrder S; S.init(MH / 256, DM / 256, F.G, (int)blockIdx.x, 32);
                        pg8::EpiDelta E{HB + (size_t)MH * DM, DM, 1.0f};
                        pg8::gemm_phase<pg8::EpiDelta, pg8::StaticOrder, true, true>(F.lds, g, S, E, F.wave);
                    }
                    END_PH();
                    }
}
{ constexpr int half = 1;
                    bf16_t* MIXh = XN + (size_t)half * MH * DM;
                    if (IN_PH()) {
{ constexpr int rep = 0;
                        pg8::Gemm g{XN + (size_t)half * MH * DM, (const bf16_t*)(ws + W_IN), DM, DM, DM};
                        pg8::StaticOrder S; S.init(MH / 256, IN_WP / 256, F.G, (int)blockIdx.x, 32);
                        pg8::EpiInProj E{PROJ, UG, GATES, args.in[10] + layer * 16, ROPE, half};
                        pg8::gemm_phase<pg8::EpiInProj, pg8::StaticOrder, true, true>(F.lds, g, S, E, F.wave);
}
                        if (half == 1) {
                            pg8::Gemm g0{XN, (const bf16_t*)(ws + W_OUT), DM, DM, DM};
                            pg8::StaticOrder S0; S0.init(MH / 256, DM / 256, F.G, (int)blockIdx.x, 32);
                            pg8::EpiDelta E0{(bf16_t*)(ws + WS_SPARE), DM, 1.0f};
                            pg8::gemm_phase<pg8::EpiDelta, pg8::StaticOrder, true, true>(F.lds, g0, S0, E0, F.wave);
                        }
                    }
                    END_PH();
                    if (IN_PH()) {
{ constexpr int rep = 0;
                        if (EN_MLSTM) { mlstm_conv_phase(F, half, PROJ, QKC, args.in[8] + layer * 5 * 1024, args.in[9] + layer * 1024); mlstm_scalar_phase(F, GATES, MSC); }
}
                        if (!EN_MLSTM) zero_mixed_cols(F, MIXh, 0);
                        if (!EN_DIFF) zero_mixed_cols(F, MIXh, 512);
                        if (!EN_NA) zero_mixed_cols(F, MIXh, 1024);
                        if (!EN_S5) zero_mixed_cols(F, MIXh, 1536);
                        if (EN_S5) { __syncthreads();
                            pg8::Gemm g{UG, (const bf16_t*)(ws + W_S5P), 512, S5K, 512}; pg8::S5OrderA S{F.G, (int)blockIdx.x}; pg8::EpiS5E E{S5E};
                            pg8::gemm_phase<pg8::EpiS5E, pg8::S5OrderA, true, true>(F.lds, g, S, E, F.wave); }
                    }
                    END_PH();
                    if (IN_PH()) {
{ constexpr int rep = 0;
                        if (EN_S5) s5_scan_phase(F, half, S5E, (const float*)(ws + W_LBL), UG);
}
{ constexpr int rep = 0;
                        if (EN_NA) { na_phase(F, half, PROJ, args.in[14] + (size_t)layer * 8 * 465, MIXh); __syncthreads(); }
}
{ constexpr int rep = 0;
                        if (EN_MLSTM) mlstm_state_phase(F, PROJ, QKC, MSC, CST, NST);
}
                    }
                    END_PH();
                    if (IN_PH()) {
                        if (EN_MLSTM) mlstm_scan_phase(F, half, MSC, CST, NST);
{ constexpr int rep = 0;
                        if (EN_S5) { pg8::Gemm g{UG, (const bf16_t*)(ws + W_S5MR), S5K, S5K, S5K}; pg8::S5OrderB S{F.G, (int)blockIdx.x}; pg8::EpiS5Z E{S5Z};
                            pg8::gemm_phase<pg8::EpiS5Z, pg8::S5OrderB, true, true>(F.lds, g, S, E, F.wave); __syncthreads(); }
}
{ constexpr int rep = 0;
                        if (EN_DIFF) diffattn_phase(F, half, layer, PROJ, MIXh, args.in[12] + layer * 256, args.in[13] + layer * 128);
}
                    }
                    END_PH();
                    if (IN_PH()) {
{ constexpr int rep = 0;
                        if (EN_MLSTM) mlstm_out_phase(F, PROJ, QKC, MSC, CST, NST, args.in[11] + layer * GWID, MIXh);
}
                        if (EN_S5) { __syncthreads();
                            pg8::Gemm g{S5Z, (const bf16_t*)(ws + W_GLU), GWID, GWID, GWID}; pg8::StaticOrder S; S.init(MH / 256, GWID / 256, F.G, (int)blockIdx.x);
                            pg8::EpiGlu E{S5Z, args.in[24] + layer * GWID, MIXh};
                            pg8::gemm_phase<pg8::EpiGlu, pg8::StaticOrder, true, true>(F.lds, g, S, E, F.wave); }
                    }
                    END_PH();
                    if (half == 1) {
                    if (IN_PH()) {
                        pg8::Gemm g{MIXh, (const bf16_t*)(ws + W_OUT), DM, DM, DM};
                        pg8::StaticOrder S; S.init(MH / 256, DM / 256, F.G, (int)blockIdx.x, 32);
                        pg8::EpiDelta E{HB + (size_t)MH * DM, DM, 1.0f};
                        pg8::gemm_phase<pg8::EpiDelta, pg8::StaticOrder, true, true>(F.lds, g, S, E, F.wave);
                    }
                    END_PH();
                    }
}
            }
}
{ constexpr int f = 1;
            if (f == 1) {
            if (IN_PH()) rms_phase(F, nullptr, nullptr, XH, (const bf16_t*)(ws + WS_SPARE), HB, args.in[26] + layer * DM, XN, XH);
            END_PH();
            }
            if (IN_PH()) {
{ constexpr int rep = 0;
                pg8::Gemm g{XN, (const bf16_t*)(ws + (f == 0 ? W_GU1 : W_GU2)), DM, DM, DM};
                pg8::StaticOrder S; S.init(MTOT / 256, 2 * DFF / 256, F.G, (int)blockIdx.x, 32);
                pg8::EpiSwiglu E{HB, DFF};
                pg8::gemm_phase<pg8::EpiSwiglu, pg8::StaticOrder, true, true>(F.lds, g, S, E, F.wave);
}
            }
            END_PH();
            if (IN_PH()) {
{ constexpr int rep = 0;
                pg8::Gemm g{HB, (const bf16_t*)(ws + (f == 0 ? W_D1 : W_D2)), DFF, DFF, DFF};
                pg8::StaticOrder S; S.init(MTOT / 256, DM / 256, F.G, (int)blockIdx.x, 4, 0);
                pg8::EpiDelta E{XN, DM, 0.5f};
                pg8::gemm_phase<pg8::EpiDelta, pg8::StaticOrder, true, true>(F.lds, g, S, E, F.wave);
}
            }
            END_PH();
            if (f == 0) {
                if (IN_PH()) { if (layer == 0) rms_phase(F, args.in[0], args.in[1], nullptr, XN, XN, args.in[6] + layer * DM, XN, XH);
                    else rms_phase(F, nullptr, nullptr, XH, XN, XN, args.in[6] + layer * DM, XN, XH); }
                END_PH();
{ constexpr int half = 0;
                    bf16_t* MIXh = XN + (size_t)half * MH * DM;
                    if (IN_PH()) {
{ constexpr int rep = 0;
                        pg8::Gemm g{XN + (size_t)half * MH * DM, (const bf16_t*)(ws + W_IN), DM, DM, DM};
                        pg8::StaticOrder S; S.init(MH / 256, IN_WP / 256, F.G, (int)blockIdx.x, 32);
                        pg8::EpiInProj E{PROJ, UG, GATES, args.in[10] + layer * 16, ROPE, half};
                        pg8::gemm_phase<pg8::EpiInProj, pg8::StaticOrder, true, true>(F.lds, g, S, E, F.wave);
}
                        if (half == 1) {
                            pg8::Gemm g0{XN, (const bf16_t*)(ws + W_OUT), DM, DM, DM};
                            pg8::StaticOrder S0; S0.init(MH / 256, DM / 256, F.G, (int)blockIdx.x, 32);
                            pg8::EpiDelta E0{(bf16_t*)(ws + WS_SPARE), DM, 1.0f};
                            pg8::gemm_phase<pg8::EpiDelta, pg8::StaticOrder, true, true>(F.lds, g0, S0, E0, F.wave);
                        }
                    }
                    END_PH();
                    if (IN_PH()) {
{ constexpr int rep = 0;
                        if (EN_MLSTM) { mlstm_conv_phase(F, half, PROJ, QKC, args.in[8] + layer * 5 * 1024, args.in[9] + layer * 1024); mlstm_scalar_phase(F, GATES, MSC); }
}
                        if (!EN_MLSTM) zero_mixed_cols(F, MIXh, 0);
                        if (!EN_DIFF) zero_mixed_cols(F, MIXh, 512);
                        if (!EN_NA) zero_mixed_cols(F, MIXh, 1024);
                        if (!EN_S5) zero_mixed_cols(F, MIXh, 1536);
                        if (EN_S5) { __syncthreads();
                            pg8::Gemm g{UG, (const bf16_t*)(ws + W_S5P), 512, S5K, 512}; pg8::S5OrderA S{F.G, (int)blockIdx.x}; pg8::EpiS5E E{S5E};
                            pg8::gemm_phase<pg8::EpiS5E, pg8::S5OrderA, true, true>(F.lds, g, S, E, F.wave); }
                    }
                    END_PH();
                    if (IN_PH()) {
{ constexpr int rep = 0;
                        if (EN_S5) s5_scan_phase(F, half, S5E, (const float*)(ws + W_LBL), UG);
}
{ constexpr int rep = 0;
                        if (EN_NA) { na_phase(F, half, PROJ, args.in[14] + (size_t)layer * 8 * 465, MIXh); __syncthreads(); }
}
{ constexpr int rep = 0;
                        if (EN_MLSTM) mlstm_state_phase(F, PROJ, QKC, MSC, CST, NST);
}
                    }
                    END_PH();
                    if (IN_PH()) {
                        if (EN_MLSTM) mlstm_scan_phase(F, half, MSC, CST, NST);
{ constexpr int rep = 0;
                        if (EN_S5) { pg8::Gemm g{UG, (const bf16_t*)(ws + W_S5MR), S5K, S5K, S5K}; pg8::S5OrderB S{F.G, (int)blockIdx.x}; pg8::EpiS5Z E{S5Z};
                            pg8::gemm_phase<pg8::EpiS5Z, pg8::S5OrderB, true, true>(F.lds, g, S, E, F.wave); __syncthreads(); }
}
{ constexpr int rep = 0;
                        if (EN_DIFF) diffattn_phase(F, half, layer, PROJ, MIXh, args.in[12] + layer * 256, args.in[13] + layer * 128);
}
                    }
                    END_PH();
                    if (IN_PH()) {
{ constexpr int rep = 0;
                        if (EN_MLSTM) mlstm_out_phase(F, PROJ, QKC, MSC, CST, NST, args.in[11] + layer * GWID, MIXh);
}
                        if (EN_S5) { __syncthreads();
                            pg8::Gemm g{S5Z, (const bf16_t*)(ws + W_GLU), GWID, GWID, GWID}; pg8::StaticOrder S; S.init(MH / 256, GWID / 256, F.G, (int)blockIdx.x);
                            pg8::EpiGlu E{S5Z, args.in[24] + layer * GWID, MIXh};
                            pg8::gemm_phase<pg8::EpiGlu, pg8::StaticOrder, true, true>(F.lds, g, S, E, F.wave); }
                    }
                    END_PH();
                    if (half == 1) {
                    if (IN_PH()) {
                        pg8::Gemm g{MIXh, (const bf16_t*)(ws + W_OUT), DM, DM, DM};
                        pg8::StaticOrder S; S.init(MH / 256, DM / 256, F.G, (int)blockIdx.x, 32);
                        pg8::EpiDelta E{HB + (size_t)MH * DM, DM, 1.0f};
                        pg8::gemm_phase<pg8::EpiDelta, pg8::StaticOrder, true, true>(F.lds, g, S, E, F.wave);
                    }
                    END_PH();
                    }
}
{ constexpr int half = 1;
                    bf16_t* MIXh = XN + (size_t)half * MH * DM;
                    if (IN_PH()) {
{ constexpr int rep = 0;
                        pg8::Gemm g{XN + (size_t)half * MH * DM, (const bf16_t*)(ws + W_IN), DM, DM, DM};
                        pg8::StaticOrder S; S.init(MH / 256, IN_WP / 256, F.G, (int)blockIdx.x, 32);
                        pg8::EpiInProj E{PROJ, UG, GATES, args.in[10] + layer * 16, ROPE, half};
                        pg8::gemm_phase<pg8::EpiInProj, pg8::StaticOrder, true, true>(F.lds, g, S, E, F.wave);
}
                        if (half == 1) {
                            pg8::Gemm g0{XN, (const bf16_t*)(ws + W_OUT), DM, DM, DM};
                            pg8::StaticOrder S0; S0.init(MH / 256, DM / 256, F.G, (int)blockIdx.x, 32);
                            pg8::EpiDelta E0{(bf16_t*)(ws + WS_SPARE), DM, 1.0f};
                            pg8::gemm_phase<pg8::EpiDelta, pg8::StaticOrder, true, true>(F.lds, g0, S0, E0, F.wave);
                        }
                    }
                    END_PH();
                    if (IN_PH()) {
{ constexpr int rep = 0;
                        if (EN_MLSTM) { mlstm_conv_phase(F, half, PROJ, QKC, args.in[8] + layer * 5 * 1024, args.in[9] + layer * 1024); mlstm_scalar_phase(F, GATES, MSC); }
}
                        if (!EN_MLSTM) zero_mixed_cols(F, MIXh, 0);
                        if (!EN_DIFF) zero_mixed_cols(F, MIXh, 512);
                        if (!EN_NA) zero_mixed_cols(F, MIXh, 1024);
                        if (!EN_S5) zero_mixed_cols(F, MIXh, 1536);
                        if (EN_S5) { __syncthreads();
                            pg8::Gemm g{UG, (const bf16_t*)(ws + W_S5P), 512, S5K, 512}; pg8::S5OrderA S{F.G, (int)blockIdx.x}; pg8::EpiS5E E{S5E};
                            pg8::gemm_phase<pg8::EpiS5E, pg8::S5OrderA, true, true>(F.lds, g, S, E, F.wave); }
                    }
                    END_PH();
                    if (IN_PH()) {
{ constexpr int rep = 0;
                        if (EN_S5) s5_scan_phase(F, half, S5E, (const float*)(ws + W_LBL), UG);
}
{ constexpr int rep = 0;
                        if (EN_NA) { na_phase(F, half, PROJ, args.in[14] + (size_t)layer * 8 * 465, MIXh); __syncthreads(); }
}
{ constexpr int rep = 0;
                        if (EN_MLSTM) mlstm_state_phase(F, PROJ, QKC, MSC, CST, NST);
}
                    }
                    END_PH();
                    if (IN_PH()) {
                        if (EN_MLSTM) mlstm_scan_phase(F, half, MSC, CST, NST);
{ constexpr int rep = 0;
                        if (EN_S5) { pg8::Gemm g{UG, (const bf16_t*)(ws + W_S5MR), S5K, S5K, S5K}; pg8::S5OrderB S{F.G, (int)blockIdx.x}; pg8::EpiS5Z E{S5Z};
                            pg8::gemm_phase<pg8::EpiS5Z, pg8::S5OrderB, true, true>(F.lds, g, S, E, F.wave); __syncthreads(); }
}
{ constexpr int rep = 0;
                        if (EN_DIFF) diffattn_phase(F, half, layer, PROJ, MIXh, args.in[12] + layer * 256, args.in[13] + layer * 128);
}
                    }
                    END_PH();
                    if (IN_PH()) {
{ constexpr int rep = 0;
                        if (EN_MLSTM) mlstm_out_phase(F, PROJ, QKC, MSC, CST, NST, args.in[11] + layer * GWID, MIXh);
}
                        if (EN_S5) { __syncthreads();
                            pg8::Gemm g{S5Z, (const bf16_t*)(ws + W_GLU), GWID, GWID, GWID}; pg8::StaticOrder S; S.init(MH / 256, GWID / 256, F.G, (int)blockIdx.x);
                            pg8::EpiGlu E{S5Z, args.in[24] + layer * GWID, MIXh};
                            pg8::gemm_phase<pg8::EpiGlu, pg8::StaticOrder, true, true>(F.lds, g, S, E, F.wave); }
                    }
                    END_PH();
                    if (half == 1) {
                    if (IN_PH()) {
                        pg8::Gemm g{MIXh, (const bf16_t*)(ws + W_OUT), DM, DM, DM};
                        pg8::StaticOrder S; S.init(MH / 256, DM / 256, F.G, (int)blockIdx.x, 32);
                        pg8::EpiDelta E{HB + (size_t)MH * DM, DM, 1.0f};
                        pg8::gemm_phase<pg8::EpiDelta, pg8::StaticOrder, true, true>(F.lds, g, S, E, F.wave);
                    }
                    END_PH();
                    }
}
            }
}
}
{ constexpr int layer = 1;
        if (IN_PH()) {
{ constexpr int rep = 0;
            convert_ffn_weights(F, args.in[3] + layer * SZ_WGATE, args.in[4] + layer * SZ_WGATE, args.in[5] + layer * SZ_WDOWN, (bf16_t*)(ws + W_GU1), (bf16_t*)(ws + W_D1));
            convert_ffn_weights(F, args.in[27] + layer * SZ_WGATE, args.in[28] + layer * SZ_WGATE, args.in[29] + layer * SZ_WDOWN, (bf16_t*)(ws + W_GU2), (bf16_t*)(ws + W_D2));
            convert_mixer_weights(F, args.in[7] + (size_t)layer * DM * IN_W, args.in[25] + (size_t)layer * DM * DM, args.in[23] + (size_t)layer * GWID * GWID,
                                  (bf16_t*)(ws + W_IN), (bf16_t*)(ws + W_OUT), (bf16_t*)(ws + W_GLU));
}
            if (layer == 0) rope_table_phase(F, ROPE);
            __syncthreads();
{ constexpr int rep = 0;
            if (EN_S5) s5_build_phase(F, layer, args.in, (bf16_t*)(ws + W_S5MR), (bf16_t*)(ws + W_S5P), (float*)(ws + W_LBL));
}
            if (layer == 0) rms_phase(F, args.in[0], args.in[1], nullptr, nullptr, nullptr, args.in[2] + layer * DM, XN, nullptr);
            else rms_phase(F, nullptr, nullptr, XH, XN, XN, args.in[2] + layer * DM, XN, XH);
        }
        END_PH();
{ constexpr int f = 0;
            if (f == 1) {
            if (IN_PH()) rms_phase(F, nullptr, nullptr, XH, (const bf16_t*)(ws + WS_SPARE), HB, args.in[26] + layer * DM, XN, XH);
            END_PH();
            }
            if (IN_PH()) {
{ constexpr int rep = 0;
                pg8::Gemm g{XN, (const bf16_t*)(ws + (f == 0 ? W_GU1 : W_GU2)), DM, DM, DM};
                pg8::StaticOrder S; S.init(MTOT / 256, 2 * DFF / 256, F.G, (int)blockIdx.x, 32);
                pg8::EpiSwiglu E{HB, DFF};
                pg8::gemm_phase<pg8::EpiSwiglu, pg8::StaticOrder, true, true>(F.lds, g, S, E, F.wave);
}
            }
            END_PH();
            if (IN_PH()) {
{ constexpr int rep = 0;
                pg8::Gemm g{HB, (const bf16_t*)(ws + (f == 0 ? W_D1 : W_D2)), DFF, DFF, DFF};
                pg8::StaticOrder S; S.init(MTOT / 256, DM / 256, F.G, (int)blockIdx.x, 4, 0);
                pg8::EpiDelta E{XN, DM, 0.5f};
                pg8::gemm_phase<pg8::EpiDelta, pg8::StaticOrder, true, true>(F.lds, g, S, E, F.wave);
}
            }
            END_PH();
            if (f == 0) {
                if (IN_PH()) { if (layer == 0) rms_phase(F, args.in[0], args.in[1], nullptr, XN, XN, args.in[6] + layer * DM, XN, XH);
                    else rms_phase(F, nullptr, nullptr, XH, XN, XN, args.in[6] + layer * DM, XN, XH); }
                END_PH();
{ constexpr int half = 0;
                    bf16_t* MIXh = XN + (size_t)half * MH * DM;
                    if (IN_PH()) {
{ constexpr int rep = 0;
                        pg8::Gemm g{XN + (size_t)half * MH * DM, (const bf16_t*)(ws + W_IN), DM, DM, DM};
                        pg8::StaticOrder S; S.init(MH / 256, IN_WP / 256, F.G, (int)blockIdx.x, 32);
                        pg8::EpiInProj E{PROJ, UG, GATES, args.in[10] + layer * 16, ROPE, half};
                        pg8::gemm_phase<pg8::EpiInProj, pg8::StaticOrder, true, true>(F.lds, g, S, E, F.wave);
}
                        if (half == 1) {
                            pg8::Gemm g0{XN, (const bf16_t*)(ws + W_OUT), DM, DM, DM};
                            pg8::StaticOrder S0; S0.init(MH / 256, DM / 256, F.G, (int)blockIdx.x, 32);
                            pg8::EpiDelta E0{(bf16_t*)(ws + WS_SPARE), DM, 1.0f};
                            pg8::gemm_phase<pg8::EpiDelta, pg8::StaticOrder, true, true>(F.lds, g0, S0, E0, F.wave);
                        }
                    }
                    END_PH();
                    if (IN_PH()) {
{ constexpr int rep = 0;
                        if (EN_MLSTM) { mlstm_conv_phase(F, half, PROJ, QKC, args.in[8] + layer * 5 * 1024, args.in[9] + layer * 1024); mlstm_scalar_phase(F, GATES, MSC); }
}
                        if (!EN_MLSTM) zero_mixed_cols(F, MIXh, 0);
                        if (!EN_DIFF) zero_mixed_cols(F, MIXh, 512);
                        if (!EN_NA) zero_mixed_cols(F, MIXh, 1024);
                        if (!EN_S5) zero_mixed_cols(F, MIXh, 1536);
                        if (EN_S5) { __syncthreads();
                            pg8::Gemm g{UG, (const bf16_t*)(ws + W_S5P), 512, S5K, 512}; pg8::S5OrderA S{F.G, (int)blockIdx.x}; pg8::EpiS5E E{S5E};
                            pg8::gemm_phase<pg8::EpiS5E, pg8::S5OrderA, true, true>(F.lds, g, S, E, F.wave); }
                    }
                    END_PH();
                    if (IN_PH()) {
{ constexpr int rep = 0;
                        if (EN_S5) s5_scan_phase(F, half, S5E, (const float*)(ws + W_LBL), UG);
}
{ constexpr int rep = 0;
                        if (EN_NA) { na_phase(F, half, PROJ, args.in[14] + (size_t)layer * 8 * 465, MIXh); __syncthreads(); }
}
{ constexpr int rep = 0;
                        if (EN_MLSTM) mlstm_state_phase(F, PROJ, QKC, MSC, CST, NST);
}
                    }
                    END_PH();
                    if (IN_PH()) {
                        if (EN_MLSTM) mlstm_scan_phase(F, half, MSC, CST, NST);
{ constexpr int rep = 0;
                        if (EN_S5) { pg8::Gemm g{UG, (const bf16_t*)(ws + W_S5MR), S5K, S5K, S5K}; pg8::S5OrderB S{F.G, (int)blockIdx.x}; pg8::EpiS5Z E{S5Z};
                            pg8::gemm_phase<pg8::EpiS5Z, pg8::S5OrderB, true, true>(F.lds, g, S, E, F.wave); __syncthreads(); }
}
{ constexpr int rep = 0;
                        if (EN_DIFF) diffattn_phase(F, half, layer, PROJ, MIXh, args.in[12] + layer * 256, args.in[13] + layer * 128);
}
                    }
                    END_PH();
                    if (IN_PH()) {
{ constexpr int rep = 0;
                        if (EN_MLSTM) mlstm_out_phase(F, PROJ, QKC, MSC, CST, NST, args.in[11] + layer * GWID, MIXh);
}
                        if (EN_S5) { __syncthreads();
                            pg8::Gemm g{S5Z, (const bf16_t*)(ws + W_GLU), GWID, GWID, GWID}; pg8::StaticOrder S; S.init(MH / 256, GWID / 256, F.G, (int)blockIdx.x);
                            pg8::EpiGlu E{S5Z, args.in[24] + layer * GWID, MIXh};
                            pg8::gemm_phase<pg8::EpiGlu, pg8::StaticOrder, true, true>(F.lds, g, S, E, F.wave); }
                    }
                    END_PH();
                    if (half == 1) {
                    if (IN_PH()) {
                        pg8::Gemm g{MIXh, (const bf16_t*)(ws + W_OUT), DM, DM, DM};
                        pg8::StaticOrder S; S.init(MH / 256, DM / 256, F.G, (int)blockIdx.x, 32);
                        pg8::EpiDelta E{HB + (size_t)MH * DM, DM, 1.0f};
                        pg8::gemm_phase<pg8::EpiDelta, pg8::StaticOrder, true, true>(F.lds, g, S, E, F.wave);
                    }
                    END_PH();
                    }
}
{ constexpr int half = 1;
                    bf16_t* MIXh = XN + (size_t)half * MH * DM;
                    if (IN_PH()) {
{ constexpr int rep = 0;
                        pg8::Gemm g{XN + (size_t)half * MH * DM, (const bf16_t*)(ws + W_IN), DM, DM, DM};
                        pg8::StaticOrder S; S.init(MH / 256, IN_WP / 256, F.G, (int)blockIdx.x, 32);
                        pg8::EpiInProj E{PROJ, UG, GATES, args.in[10] + layer * 16, ROPE, half};
                        pg8::gemm_phase<pg8::EpiInProj, pg8::StaticOrder, true, true>(F.lds, g, S, E, F.wave);
}
                        if (half == 1) {
                            pg8::Gemm g0{XN, (const bf16_t*)(ws + W_OUT), DM, DM, DM};
                            pg8::StaticOrder S0; S0.init(MH / 256, DM / 256, F.G, (int)blockIdx.x, 32);
                            pg8::EpiDelta E0{(bf16_t*)(ws + WS_SPARE), DM, 1.0f};
                            pg8::gemm_phase<pg8::EpiDelta, pg8::StaticOrder, true, true>(F.lds, g0, S0, E0, F.wave);
                        }
                    }
                    END_PH();
                    if (IN_PH()) {
{ constexpr int rep = 0;
                        if (EN_MLSTM) { mlstm_conv_phase(F, half, PROJ, QKC, args.in[8] + layer * 5 * 1024, args.in[9] + layer * 1024); mlstm_scalar_phase(F, GATES, MSC); }
}
                        if (!EN_MLSTM) zero_mixed_cols(F, MIXh, 0);
                        if (!EN_DIFF) zero_mixed_cols(F, MIXh, 512);
                        if (!EN_NA) zero_mixed_cols(F, MIXh, 1024);
                        if (!EN_S5) zero_mixed_cols(F, MIXh, 1536);
                        if (EN_S5) { __syncthreads();
                            pg8::Gemm g{UG, (const bf16_t*)(ws + W_S5P), 512, S5K, 512}; pg8::S5OrderA S{F.G, (int)blockIdx.x}; pg8::EpiS5E E{S5E};
                            pg8::gemm_phase<pg8::EpiS5E, pg8::S5OrderA, true, true>(F.lds, g, S, E, F.wave); }
                    }
                    END_PH();
                    if (IN_PH()) {
{ constexpr int rep = 0;
                        if (EN_S5) s5_scan_phase(F, half, S5E, (const float*)(ws + W_LBL), UG);
}
{ constexpr int rep = 0;
                        if (EN_NA) { na_phase(F, half, PROJ, args.in[14] + (size_t)layer * 8 * 465, MIXh); __syncthreads(); }
}
{ constexpr int rep = 0;
                        if (EN_MLSTM) mlstm_state_phase(F, PROJ, QKC, MSC, CST, NST);
}
                    }
                    END_PH();
                    if (IN_PH()) {
                        if (EN_MLSTM) mlstm_scan_phase(F, half, MSC, CST, NST);
{ constexpr int rep = 0;
                        if (EN_S5) { pg8::Gemm g{UG, (const bf16_t*)(ws + W_S5MR), S5K, S5K, S5K}; pg8::S5OrderB S{F.G, (int)blockIdx.x}; pg8::EpiS5Z E{S5Z};
                            pg8::gemm_phase<pg8::EpiS5Z, pg8::S5OrderB, true, true>(F.lds, g, S, E, F.wave); __syncthreads(); }
}
{ constexpr int rep = 0;
                        if (EN_DIFF) diffattn_phase(F, half, layer, PROJ, MIXh, args.in[12] + layer * 256, args.in[13] + layer * 128);
}
                    }
                    END_PH();
                    if (IN_PH()) {
{ constexpr int rep = 0;
                        if (EN_MLSTM) mlstm_out_phase(F, PROJ, QKC, MSC, CST, NST, args.in[11] + layer * GWID, MIXh);
}
                        if (EN_S5) { __syncthreads();
                            pg8::Gemm g{S5Z, (const bf16_t*)(ws + W_GLU), GWID, GWID, GWID}; pg8::StaticOrder S; S.init(MH / 256, GWID / 256, F.G, (int)blockIdx.x);
                            pg8::EpiGlu E{S5Z, args.in[24] + layer * GWID, MIXh};
                            pg8::gemm_phase<pg8::EpiGlu, pg8::StaticOrder, true, true>(F.lds, g, S, E, F.wave); }
                    }
                    END_PH();
                    if (half == 1) {
                    if (IN_PH()) {
                        pg8::Gemm g{MIXh, (const bf16_t*)(ws + W_OUT), DM, DM, DM};
                        pg8::StaticOrder S; S.init(MH / 256, DM / 256, F.G, (int)blockIdx.x, 32);
                        pg8::EpiDelta E{HB + (size_t)MH * DM, DM, 1.0f};
                        pg8::gemm_phase<pg8::EpiDelta, pg8::StaticOrder, true, true>(F.lds, g, S, E, F.wave);
                    }
                    END_PH();
                    }
}
            }
}
{ constexpr int f = 1;
            if (f == 1) {
            if (IN_PH()) rms_phase(F, nullptr, nullptr, XH, (const bf16_t*)(ws + WS_SPARE), HB, args.in[26] + layer * DM, XN, XH);
            END_PH();
            }
            if (IN_PH()) {
{ constexpr int rep = 0;
                pg8::Gemm g{XN, (const bf16_t*)(ws + (f == 0 ? W_GU1 : W_GU2)), DM, DM, DM};
                pg8::StaticOrder S; S.init(MTOT / 256, 2 * DFF / 256, F.G, (int)blockIdx.x, 32);
                pg8::EpiSwiglu E{HB, DFF};
                pg8::gemm_phase<pg8::EpiSwiglu, pg8::StaticOrder, true, true>(F.lds, g, S, E, F.wave);
}
            }
            END_PH();
            if (IN_PH()) {
{ constexpr int rep = 0;
                pg8::Gemm g{HB, (const bf16_t*)(ws + (f == 0 ? W_D1 : W_D2)), DFF, DFF, DFF};
                pg8::StaticOrder S; S.init(MTOT / 256, DM / 256, F.G, (int)blockIdx.x, 4, 0);
                pg8::EpiDelta E{XN, DM, 0.5f};
                pg8::gemm_phase<pg8::EpiDelta, pg8::StaticOrder, true, true>(F.lds, g, S, E, F.wave);
}
            }
            END_PH();
            if (f == 0) {
                if (IN_PH()) { if (layer == 0) rms_phase(F, args.in[0], args.in[1], nullptr, XN, XN, args.in[6] + layer * DM, XN, XH);
                    else rms_phase(F, nullptr, nullptr, XH, XN, XN, args.in[6] + layer * DM, XN, XH); }
                END_PH();
{ constexpr int half = 0;
                    bf16_t* MIXh = XN + (size_t)half * MH * DM;
                    if (IN_PH()) {
{ constexpr int rep = 0;
                        pg8::Gemm g{XN + (size_t)half * MH * DM, (const bf16_t*)(ws + W_IN), DM, DM, DM};
                        pg8::StaticOrder S; S.init(MH / 256, IN_WP / 256, F.G, (int)blockIdx.x, 32);
                        pg8::EpiInProj E{PROJ, UG, GATES, args.in[10] + layer * 16, ROPE, half};
                        pg8::gemm_phase<pg8::EpiInProj, pg8::StaticOrder, true, true>(F.lds, g, S, E, F.wave);
}
                        if (half == 1) {
                            pg8::Gemm g0{XN, (const bf16_t*)(ws + W_OUT), DM, DM, DM};
                            pg8::StaticOrder S0; S0.init(MH / 256, DM / 256, F.G, (int)blockIdx.x, 32);
                            pg8::EpiDelta E0{(bf16_t*)(ws + WS_SPARE), DM, 1.0f};
                            pg8::gemm_phase<pg8::EpiDelta, pg8::StaticOrder, true, true>(F.lds, g0, S0, E0, F.wave);
                        }
                    }
                    END_PH();
                    if (IN_PH()) {
{ constexpr int rep = 0;
                        if (EN_MLSTM) { mlstm_conv_phase(F, half, PROJ, QKC, args.in[8] + layer * 5 * 1024, args.in[9] + layer * 1024); mlstm_scalar_phase(F, GATES, MSC); }
}
                        if (!EN_MLSTM) zero_mixed_cols(F, MIXh, 0);
                        if (!EN_DIFF) zero_mixed_cols(F, MIXh, 512);
                        if (!EN_NA) zero_mixed_cols(F, MIXh, 1024);
                        if (!EN_S5) zero_mixed_cols(F, MIXh, 1536);
                        if (EN_S5) { __syncthreads();
                            pg8::Gemm g{UG, (const bf16_t*)(ws + W_S5P), 512, S5K, 512}; pg8::S5OrderA S{F.G, (int)blockIdx.x}; pg8::EpiS5E E{S5E};
                            pg8::gemm_phase<pg8::EpiS5E, pg8::S5OrderA, true, true>(F.lds, g, S, E, F.wave); }
                    }
                    END_PH();
                    if (IN_PH()) {
{ constexpr int rep = 0;
                        if (EN_S5) s5_scan_phase(F, half, S5E, (const float*)(ws + W_LBL), UG);
}
{ constexpr int rep = 0;
                        if (EN_NA) { na_phase(F, half, PROJ, args.in[14] + (size_t)layer * 8 * 465, MIXh); __syncthreads(); }
}
{ constexpr int rep = 0;
                        if (EN_MLSTM) mlstm_state_phase(F, PROJ, QKC, MSC, CST, NST);
}
                    }
                    END_PH();
                    if (IN_PH()) {
                        if (EN_MLSTM) mlstm_scan_phase(F, half, MSC, CST, NST);
{ constexpr int rep = 0;
                        if (EN_S5) { pg8::Gemm g{UG, (const bf16_t*)(ws + W_S5MR), S5K, S5K, S5K}; pg8::S5OrderB S{F.G, (int)blockIdx.x}; pg8::EpiS5Z E{S5Z};
                            pg8::gemm_phase<pg8::EpiS5Z, pg8::S5OrderB, true, true>(F.lds, g, S, E, F.wave); __syncthreads(); }
}
{ constexpr int rep = 0;
                        if (EN_DIFF) diffattn_phase(F, half, layer, PROJ, MIXh, args.in[12] + layer * 256, args.in[13] + layer * 128);
}
                    }
                    END_PH();
                    if (IN_PH()) {
{ constexpr int rep = 0;
                        if (EN_MLSTM) mlstm_out_phase(F, PROJ, QKC, MSC, CST, NST, args.in[11] + layer * GWID, MIXh);
}
                        if (EN_S5) { __syncthreads();
                            pg8::Gemm g{S5Z, (const bf16_t*)(ws + W_GLU), GWID, GWID, GWID}; pg8::StaticOrder S; S.init(MH / 256, GWID / 256, F.G, (int)blockIdx.x);
                            pg8::EpiGlu E{S5Z, args.in[24] + layer * GWID, MIXh};
                            pg8::gemm_phase<pg8::EpiGlu, pg8::StaticOrder, true, true>(F.lds, g, S, E, F.wave); }
                    }
                    END_PH();
                    if (half == 1) {
                    if (IN_PH()) {
                        pg8::Gemm g{MIXh, (const bf16_t*)(ws + W_OUT), DM, DM, DM};
                        pg8::StaticOrder S; S.init(MH / 256, DM / 256, F.G, (int)blockIdx.x, 32);
                        pg8::EpiDelta E{HB + (size_t)MH * DM, DM, 1.0f};
                        pg8::gemm_phase<pg8::EpiDelta, pg8::StaticOrder, true, true>(F.lds, g, S, E, F.wave);
                    }
                    END_PH();
                    }
}
{ constexpr int half = 1;
                    bf16_t* MIXh = XN + (size_t)half * MH * DM;
                    if (IN_PH()) {
{ constexpr int rep = 0;
                        pg8::Gemm g{XN + (size_t)half * MH * DM, (const bf16_t*)(ws + W_IN), DM, DM, DM};
                        pg8::StaticOrder S; S.init(MH / 256, IN_WP / 256, F.G, (int)blockIdx.x, 32);
                        pg8::EpiInProj E{PROJ, UG, GATES, args.in[10] + layer * 16, ROPE, half};
                        pg8::gemm_phase<pg8::EpiInProj, pg8::StaticOrder, true, true>(F.lds, g, S, E, F.wave);
}
                        if (half == 1) {
                            pg8::Gemm g0{XN, (const bf16_t*)(ws + W_OUT), DM, DM, DM};
                            pg8::StaticOrder S0; S0.init(MH / 256, DM / 256, F.G, (int)blockIdx.x, 32);
                            pg8::EpiDelta E0{(bf16_t*)(ws + WS_SPARE), DM, 1.0f};
                            pg8::gemm_phase<pg8::EpiDelta, pg8::StaticOrder, true, true>(F.lds, g0, S0, E0, F.wave);
                        }
                    }
                    END_PH();
                    if (IN_PH()) {
{ constexpr int rep = 0;
                        if (EN_MLSTM) { mlstm_conv_phase(F, half, PROJ, QKC, args.in[8] + layer * 5 * 1024, args.in[9] + layer * 1024); mlstm_scalar_phase(F, GATES, MSC); }
}
                        if (!EN_MLSTM) zero_mixed_cols(F, MIXh, 0);
                        if (!EN_DIFF) zero_mixed_cols(F, MIXh, 512);
                        if (!EN_NA) zero_mixed_cols(F, MIXh, 1024);
                        if (!EN_S5) zero_mixed_cols(F, MIXh, 1536);
                        if (EN_S5) { __syncthreads();
                            pg8::Gemm g{UG, (const bf16_t*)(ws + W_S5P), 512, S5K, 512}; pg8::S5OrderA S{F.G, (int)blockIdx.x}; pg8::EpiS5E E{S5E};
                            pg8::gemm_phase<pg8::EpiS5E, pg8::S5OrderA, true, true>(F.lds, g, S, E, F.wave); }
                    }
                    END_PH();
                    if (IN_PH()) {
{ constexpr int rep = 0;
                        if (EN_S5) s5_scan_phase(F, half, S5E, (const float*)(ws + W_LBL), UG);
}
{ constexpr int rep = 0;
                        if (EN_NA) { na_phase(F, half, PROJ, args.in[14] + (size_t)layer * 8 * 465, MIXh); __syncthreads(); }
}
{ constexpr int rep = 0;
                        if (EN_MLSTM) mlstm_state_phase(F, PROJ, QKC, MSC, CST, NST);
}
                    }
                    END_PH();
                    if (IN_PH()) {
                        if (EN_MLSTM) mlstm_scan_phase(F, half, MSC, CST, NST);
{ constexpr int rep = 0;
                        if (EN_S5) { pg8::Gemm g{UG, (const bf16_t*)(ws + W_S5MR), S5K, S5K, S5K}; pg8::S5OrderB S{F.G, (int)blockIdx.x}; pg8::EpiS5Z E{S5Z};
                            pg8::gemm_phase<pg8::EpiS5Z, pg8::S5OrderB, true, true>(F.lds, g, S, E, F.wave); __syncthreads(); }
}
{ constexpr int rep = 0;
                        if (EN_DIFF) diffattn_phase(F, half, layer, PROJ, MIXh, args.in[12] + layer * 256, args.in[13] + layer * 128);
}
                    }
                    END_PH();
                    if (IN_PH()) {
{ constexpr int rep = 0;
                        if (EN_MLSTM) mlstm_out_phase(F, PROJ, QKC, MSC, CST, NST, args.in[11] + layer * GWID, MIXh);
}
                        if (EN_S5) { __syncthreads();
                            pg8::Gemm g{S5Z, (const bf16_t*)(ws + W_GLU), GWID, GWID, GWID}; pg8::StaticOrder S; S.init(MH / 256, GWID / 256, F.G, (int)blockIdx.x);
                            pg8::EpiGlu E{S5Z, args.in[24] + layer * GWID, MIXh};
                            pg8::gemm_phase<pg8::EpiGlu, pg8::StaticOrder, true, true>(F.lds, g, S, E, F.wave); }
                    }
                    END_PH();
                    if (half == 1) {
                    if (IN_PH()) {
                        pg8::Gemm g{MIXh, (const bf16_t*)(ws + W_OUT), DM, DM, DM};
                        pg8::StaticOrder S; S.init(MH / 256, DM / 256, F.G, (int)blockIdx.x, 32);
                        pg8::EpiDelta E{HB + (size_t)MH * DM, DM, 1.0f};
                        pg8::gemm_phase<pg8::EpiDelta, pg8::StaticOrder, true, true>(F.lds, g, S, E, F.wave);
                    }
                    END_PH();
                    }
}
            }
}
}
    if (IN_PH()) {
        constexpr int FT = 3072, A_END = MH - FT;
        _Float16* XT = (_Float16*)(ws + WS_SPARE);
        { const long gt = (long)F.vcu * (NWAVES * 64) + opaque_tid(F.wave), NT = (long)F.G * NWAVES * 64;
          for (long i = gt; i < (long)FT * DM / 8; i += NT) *(u32x4*)(XT + i * 8) = *(const u32x4*)(XH + (size_t)(MTOT - FT) * DM + i * 8); }
        final_norm_rows(F, X, XH, XN, args.in[30], 0, MH, 0);
        for (int a0 = 0; a0 < A_END; ) {
            xcd_barrier(bar, F.wave);
            const int a1 = (a0 + MH) / 2;
            final_norm_rows(F, X, XH, XN, args.in[30], MH + a0, MH + a1, 0);
            a0 = a1;
        }
        xcd_barrier(bar, F.wave);
        final_norm_rows(F, X, XT, XN, args.in[30], MTOT - FT, MTOT, MTOT - FT);
        if (xb_ld(ctl + CW_BAR + XB_TMO) != 0u) {
            const int gw = F.vcu * NWAVES + F.wave, NGW = F.G * NWAVES, ln = opaque_tid(F.wave) & 63; const float q = __builtin_nanf("");
            for (int m = gw; m < MTOT; m += NGW) X[(size_t)m * DM + ln] = q;
        }
    }
    ++ph;
#undef IN_PH
#undef END_PH
}

extern "C" void kernel_launch(void* const* d_in, const int* in_sizes, int n_in, void* d_out, int out_size, void* d_ws, size_t ws_size, hipStream_t stream) {
    static int grid = 0;
    if (grid == 0) {
        if (n_in != 31 || out_size != MTOT * DM || ws_size < WS_END) { fprintf(stderr, "kernel_launch: shape mismatch: n_in %d out %d ws %zu (need %zu)\n", n_in, out_size, ws_size, (size_t)WS_END); grid = -1; return; }
        int dev = 0, cus = 0, per_cu = 0;
        if (hipGetDevice(&dev) != hipSuccess || hipDeviceGetAttribute(&cus, hipDeviceAttributeMultiprocessorCount, dev) != hipSuccess) { grid = -1; return; }
        if (hipFuncSetAttribute((const void*)mk_fwd, hipFuncAttributeMaxDynamicSharedMemorySize, LDS_BYTES) != hipSuccess) { fprintf(stderr, "kernel_launch: hipFuncSetAttribute failed\n"); grid = -1; return; }
        if (hipOccupancyMaxActiveBlocksPerMultiprocessor(&per_cu, (const void*)mk_fwd, NWAVES * 64, LDS_BYTES) != hipSuccess || per_cu < 1) { fprintf(stderr, "kernel_launch: occupancy query says %d\n", per_cu); (void)hipGetLastError(); grid = -1; return; }
        grid = cus;
    }
    if (grid < 0) return;
    (void)hipMemsetAsync((char*)d_ws + WS_CTL, 0, CTL_ZERO_BYTES, stream);
    Args a{};
    for (int i = 0; i < 31; ++i) a.in[i] = (const float*)d_in[i];
    a.out = (float*)d_out; a.ws = (unsigned char*)d_ws; a.ph_lo = 0; a.ph_hi = 1 << 30;
    hipLaunchKernelGGL(mk_fwd, dim3(grid), dim3(NWAVES * 64), LDS_BYTES, stream, a);
    const hipError_t le = hipPeekAtLastError();
    if (le != hipSuccess) fprintf(stderr, "kernel_launch: launch failed: %s\n", hipGetErrorName(le));
}
```
